# Optimizing an MI355X kernel written in HIP

```python
import jax, jax.numpy as jnp
from jax import lax
import numpy as np

D_MODEL = 4096
BATCH = 2
SEQ = 8192
DEPTH = 1
DEC_BATCH = 8
DEC_SEQ = 16
PAST_LEN = 2048

CHUNK = 64
GLA_HEADS = 4
GLA_DK = D_MODEL // (2 * GLA_HEADS)
GLA_DV = D_MODEL // GLA_HEADS
GLA_KEY = GLA_HEADS * GLA_DK
GLA_VAL = GLA_HEADS * GLA_DV
GLA_GATE_RANK = 16
GLA_GATE_NORM = 16.0
SWA_HEADS = 64
SWA_KV_HEADS = 8
SWA_HEAD_DIM = D_MODEL // SWA_HEADS
SWA_GROUP = SWA_HEADS // SWA_KV_HEADS
WINDOW = 128
WINDOW_CHUNKS = WINDOW // CHUNK
ROPE_THETA = 10000.0
D_FF = -(-8 * D_MODEL // (3 * 256)) * 256
NORM_EPS = 1e-6
IN_SPLITS = (GLA_KEY, GLA_KEY, GLA_VAL, GLA_VAL, GLA_GATE_RANK,
             SWA_HEADS * SWA_HEAD_DIM, SWA_KV_HEADS * SWA_HEAD_DIM, SWA_KV_HEADS * SWA_HEAD_DIM,
             D_MODEL, D_MODEL)
N_IN = sum(IN_SPLITS)

kernel_name = 'gated_gla_swa_sink_streaming_step'


def rmsnorm(x, g):
    xf = x.astype(jnp.float32)
    y = xf * lax.rsqrt(jnp.mean(xf * xf, axis=-1, keepdims=True) + NORM_EPS)
    return (y * g.astype(jnp.float32)).astype(x.dtype)


def rope(x, pos):
    half = x.shape[-1] // 2
    inv = ROPE_THETA ** (-jnp.arange(half, dtype=jnp.float32) / half)
    ang = pos.astype(jnp.float32)[:, None] * inv[None, :]
    cos = jnp.cos(ang)[:, None, :]
    sin = jnp.sin(ang)[:, None, :]
    x1 = x[..., :half].astype(jnp.float32)
    x2 = x[..., half:].astype(jnp.float32)
    return jnp.concatenate([x1 * cos - x2 * sin, x2 * cos + x1 * sin], axis=-1).astype(x.dtype)


def gla_blocks(q, k, v, log_a, s0):
    C = q.shape[2]
    b = jnp.cumsum(log_a, axis=2)
    b_mid = b[:, :, C // 2:C // 2 + 1]
    b_last = b[:, :, -1]
    scores = jnp.einsum('bnihd,bnjhd->bnhij', q * jnp.exp(b - b_mid), k * jnp.exp(b_mid - b))
    scores = jnp.where(jnp.tril(jnp.ones((C, C), dtype=bool)), scores, 0.0)
    o_intra = jnp.einsum('bnhij,bnjhe->bnihe', scores, v)
    q_dec = q * jnp.exp(b)
    k_dec = k * jnp.exp(b_last[:, :, None] - b)

    def step(s, xs):
        qc, kc, vc, blc = xs
        o = jnp.einsum('bihd,bhde->bihe', qc, s)
        s = jnp.exp(blc)[..., None] * s + jnp.einsum('bjhd,bjhe->bhde', kc, vc)
        return s, o

    xs = (jnp.moveaxis(q_dec, 1, 0), jnp.moveaxis(k_dec, 1, 0), jnp.moveaxis(v, 1, 0), jnp.moveaxis(b_last, 1, 0))
    s_final, o_inter = lax.scan(step, s0.astype(jnp.float32), xs)
    return o_intra + jnp.moveaxis(o_inter, 0, 1), s_final


def sink_attention(q, k, v, sinks, mask):
    logits = jnp.einsum('bnqhgd,bnshd->bnhgqs', q, k).astype(jnp.float32) * (SWA_HEAD_DIM ** -0.5)
    if mask is not None:
        logits = jnp.where(mask, logits, -jnp.inf)
    sink = sinks.astype(jnp.float32).reshape(SWA_KV_HEADS, SWA_GROUP)[:, :, None, None]
    m = jnp.maximum(jnp.max(logits, axis=-1, keepdims=True), sink)
    p = jnp.exp(logits - m)
    p = p / (jnp.sum(p, axis=-1, keepdims=True) + jnp.exp(sink - m))
    return jnp.einsum('bnhgqs,bnshd->bnqhgd', p.astype(v.dtype), v)


def swa_banded(q, k, v, sinks):
    B, S = q.shape[:2]
    N = S // CHUNK
    qc = q.reshape(B, N, CHUNK, SWA_KV_HEADS, SWA_GROUP, SWA_HEAD_DIM)
    pad = ((0, 0), (WINDOW_CHUNKS, 0), (0, 0), (0, 0), (0, 0))
    kp = jnp.pad(k.reshape(B, N, CHUNK, SWA_KV_HEADS, SWA_HEAD_DIM), pad)
    vp = jnp.pad(v.reshape(B, N, CHUNK, SWA_KV_HEADS, SWA_HEAD_DIM), pad)
    kb = jnp.concatenate([kp[:, j:j + N] for j in range(WINDOW_CHUNKS + 1)], axis=2)
    vb = jnp.concatenate([vp[:, j:j + N] for j in range(WINDOW_CHUNKS + 1)], axis=2)
    key_pos = jnp.arange(N)[:, None] * CHUNK + jnp.arange((WINDOW_CHUNKS + 1) * CHUNK)[None, :] - WINDOW
    mask = (key_pos >= 0)[None, :, None, None, None, :]
    return sink_attention(qc, kb, vb, sinks, mask).reshape(B, S, D_MODEL)


def swa_cached(q, k_new, v_new, k_past, v_past, sinks):
    B, S = q.shape[:2]
    qc = q.reshape(B, 1, S, SWA_KV_HEADS, SWA_GROUP, SWA_HEAD_DIM)
    kb = jnp.concatenate([k_past, k_new.astype(k_past.dtype)], axis=1)[:, None]
    vb = jnp.concatenate([v_past, v_new.astype(v_past.dtype)], axis=1)[:, None]
    return sink_attention(qc, kb, vb, sinks, None).reshape(B, S, D_MODEL)


def trunk_layer(x, c, pos, s0, k_past, v_past, w_ada, b_ada, g_norm1, w_in, w_gk_up, b_gk,
                g_gla_out, swa_sinks, w_out, g_norm2, w_gate_up, w_down):
    dt = x.dtype
    B, S = x.shape[:2]
    mod = jnp.einsum('bd,de->be', jax.nn.silu(c), w_ada) + b_ada
    sh1, sc1, gt1, sh2, sc2, gt2 = [m[:, None, :] for m in jnp.split(mod, 6, axis=-1)]
    h = rmsnorm(x, g_norm1) * (1.0 + sc1) + sh1
    proj = jnp.einsum('bsd,de->bse', h, w_in)
    split_pts = [int(i) for i in np.cumsum(IN_SPLITS)[:-1]]
    qa, ka, va, ga, ra, qb, kb, vb, za, zb = jnp.split(proj, split_pts, axis=-1)

    log_a = jax.nn.log_sigmoid((jnp.einsum('bsr,rk->bsk', ra, w_gk_up) + b_gk).astype(jnp.float32)) / GLA_GATE_NORM
    blk_len = min(CHUNK, S)
    n_blk = S // blk_len

    def blk(t, dh):
        return t.reshape(B, n_blk, blk_len, GLA_HEADS, dh).astype(jnp.float32)

    o_a, s_new = gla_blocks(blk(qa * (GLA_DK ** -0.5), GLA_DK), blk(ka, GLA_DK), blk(va, GLA_DV),
                            blk(log_a, GLA_DK), s0)
    o_a = rmsnorm(o_a.reshape(B, S, GLA_HEADS, GLA_DV), g_gla_out) * jax.nn.silu(ga).reshape(B, S, GLA_HEADS, GLA_DV)
    o_a = o_a.reshape(B, S, D_MODEL)

    qb = rope(qb.reshape(B, S, SWA_HEADS, SWA_HEAD_DIM), pos)
    kb = rope(kb.reshape(B, S, SWA_KV_HEADS, SWA_HEAD_DIM), pos)
    vb = vb.reshape(B, S, SWA_KV_HEADS, SWA_HEAD_DIM)
    if k_past is None:
        o_b = swa_banded(qb, kb, vb, swa_sinks)
        k_keep, v_keep = kb[:, -WINDOW:], vb[:, -WINDOW:]
    else:
        o_b = swa_cached(qb, kb, vb, k_past, v_past, swa_sinks)
        k_keep, v_keep = kb, vb

    merged = jax.nn.sigmoid(za) * o_a + jax.nn.sigmoid(zb) * o_b
    x = x + gt1 * jnp.einsum('bsd,de->bse', merged, w_out)

    h2 = rmsnorm(x, g_norm2) * (1.0 + sc2) + sh2
    gate, up = jnp.split(jnp.einsum('bsd,df->bsf', h2, w_gate_up), 2, axis=-1)
    x = x + gt2 * jnp.einsum('bsf,fd->bsd', jax.nn.silu(gate) * up, w_down)
    return x.astype(dt), s_new, k_keep, v_keep


def setup_inputs(seed: int = 0) -> dict:
    key = jax.random.key(seed)
    ks = jax.random.split(key, 24)
    f32 = jnp.float32

    def nrm(k, shape, scale):
        return jax.random.normal(k, shape, f32) * scale

    D = D_MODEL
    return {
        'x_prompt': nrm(ks[0], (BATCH, SEQ, D), 1.0),
        'x_sample': nrm(ks[1], (DEC_BATCH, DEC_SEQ, D), 1.0),
        'state_gla': nrm(ks[2], (DEPTH, DEC_BATCH, GLA_HEADS, GLA_DK, GLA_DV), 1.0),
        'cache_swa_k': nrm(ks[3], (DEPTH, DEC_BATCH, WINDOW, SWA_KV_HEADS, SWA_HEAD_DIM), 1.0),
        'cache_swa_v': nrm(ks[4], (DEPTH, DEC_BATCH, WINDOW, SWA_KV_HEADS, SWA_HEAD_DIM), 1.0),
        'c_prompt': nrm(ks[5], (BATCH, D), 1.0),
        'c_sample': nrm(ks[6], (DEC_BATCH, D), 1.0),
        'w_ada': nrm(ks[7], (DEPTH, D, 6 * D), 0.5 * D ** -0.5),
        'b_ada': nrm(ks[8], (DEPTH, 6 * D), 0.01),
        'g_norm1': 1.0 + nrm(ks[9], (DEPTH, D), 0.01),
        'w_in': nrm(ks[10], (DEPTH, D, N_IN), D ** -0.5),
        'w_gk_up': nrm(ks[11], (DEPTH, GLA_GATE_RANK, GLA_KEY), GLA_GATE_RANK ** -0.5),
        'b_gk': nrm(ks[12], (DEPTH, GLA_KEY), 0.01),
        'g_gla_out': 1.0 + nrm(ks[13], (DEPTH, GLA_DV), 0.01),
        'swa_sinks': nrm(ks[14], (DEPTH, SWA_HEADS), 1.0),
        'w_out': nrm(ks[15], (DEPTH, D, D), D ** -0.5),
        'g_norm2': 1.0 + nrm(ks[16], (DEPTH, D), 0.01),
        'w_gate_up': nrm(ks[17], (DEPTH, D, 2 * D_FF), D ** -0.5),
        'w_down': nrm(ks[18], (DEPTH, D_FF, D), D_FF ** -0.5),
        'g_final': 1.0 + nrm(ks[19], (D,), 0.01),
    }


def reference(x_prompt, x_sample, state_gla, cache_swa_k, cache_swa_v, c_prompt, c_sample,
              w_ada, b_ada, g_norm1, w_in, w_gk_up, b_gk, g_gla_out, swa_sinks, w_out,
              g_norm2, w_gate_up, w_down, g_final):
    pos_p = jnp.arange(x_prompt.shape[1])
    pos_s = PAST_LEN + jnp.arange(x_sample.shape[1])
    s0_p = jnp.zeros((x_prompt.shape[0], GLA_HEADS, GLA_DK, GLA_DV), jnp.float32)
    hp, hs = x_prompt, x_sample
    sg_p, kc_p, vc_p, sg_s, kc_s, vc_s = [], [], [], [], [], []
    for l in range(DEPTH):
        hp, s_p, k_p, v_p = trunk_layer(hp, c_prompt, pos_p, s0_p, None, None,
                                        w_ada[l], b_ada[l], g_norm1[l], w_in[l], w_gk_up[l], b_gk[l],
                                        g_gla_out[l], swa_sinks[l], w_out[l], g_norm2[l],
                                        w_gate_up[l], w_down[l])
        hs, s_s, k_s, v_s = trunk_layer(hs, c_sample, pos_s, state_gla[l], cache_swa_k[l], cache_swa_v[l],
                                        w_ada[l], b_ada[l], g_norm1[l], w_in[l], w_gk_up[l], b_gk[l],
                                        g_gla_out[l], swa_sinks[l], w_out[l], g_norm2[l],
                                        w_gate_up[l], w_down[l])
        sg_p.append(s_p); kc_p.append(k_p); vc_p.append(v_p)
        sg_s.append(s_s); kc_s.append(k_s); vc_s.append(v_s)
    y_prompt = rmsnorm(hp, g_final)
    y_sample = rmsnorm(hs, g_final)
    return (y_prompt, y_sample, jnp.stack(sg_p), jnp.stack(kc_p), jnp.stack(vc_p),
            jnp.stack(sg_s), jnp.stack(kc_s), jnp.stack(vc_s))
```

```cpp
#include <hip/hip_runtime.h>
#include <cstdio>

#ifndef DBG_CHECK
#define DBG_CHECK 0
#endif
#ifndef PROBE_TWICE
#define PROBE_TWICE 0
#endif
#ifndef ZERO_FILL
#define ZERO_FILL 0
#endif

#define LAS __attribute__((address_space(3)))
#define GAS __attribute__((address_space(1)))
typedef GAS unsigned gu32;
typedef unsigned short bf16;
typedef short bf16x8 __attribute__((ext_vector_type(8)));
typedef float f32x2 __attribute__((ext_vector_type(2)));
typedef float f32x4 __attribute__((ext_vector_type(4)));
typedef float f32x16 __attribute__((ext_vector_type(16)));
typedef unsigned u32x2 __attribute__((ext_vector_type(2)));
typedef unsigned u32x4 __attribute__((ext_vector_type(4)));
typedef __bf16 bf16x2_t __attribute__((ext_vector_type(2)));
#define RLX_AGENT __ATOMIC_RELAXED, __HIP_MEMORY_SCOPE_AGENT
#define LDS_WAIT() asm volatile("s_waitcnt lgkmcnt(0)" ::: "memory")
#define VM_WAIT() asm volatile("s_waitcnt vmcnt(0)" ::: "memory")

__device__ __forceinline__ unsigned cvtpk(float lo, float hi) { f32x2 v = {lo, hi}; bf16x2_t b = __builtin_convertvector(v, bf16x2_t); return __builtin_bit_cast(unsigned, b); }
__device__ __forceinline__ float bf2f(unsigned short b) { return __uint_as_float(((unsigned)b) << 16); }
__device__ __forceinline__ float bflo(unsigned w) { return __uint_as_float(w << 16); }
__device__ __forceinline__ float bfhi(unsigned w) { return __uint_as_float(w & 0xffff0000u); }
__device__ __forceinline__ float wave_sum(float v) {
#pragma unroll
    for (int o = 1; o < 64; o <<= 1) v += __shfl_xor(v, o);
    return v;
}

constexpr int NWAVES = 8, NTHR = 512;
constexpr int D = 4096, SEQ = 8192, MP = 16384, MS = 128, MREAL = 16512, MPAD = 16640;
constexpr int N_IN = 25616, NP_IN = 25856, DFF = 11008, N_GU = 22016, NMOD = 24576;
constexpr int C_QA = 0, C_KA = 2048, C_VA = 4096, C_GA = 8192, C_QB = 12288, C_KB = 16384, C_VB = 16896, C_ZA = 17408, C_ZB = 21504, C_RA = 25600;
constexpr int O_RA = 12288, O_QB = 12304, O_KB = 16400, O_VB = 16912;
constexpr float NORM_EPS = 1e-6f;
constexpr float QSCALE = 0.125f * 1.4426950408889634f;
constexpr long OUT_YP = 0, OUT_YS = 67108864L, OUT_SGP = 67633152L, OUT_KP = 71827456L, OUT_VP = 71958528L, OUT_SGS = 72089600L, OUT_KS = 88866816L, OUT_VS = 88932352L, OUT_TOTAL = 88997888L;

constexpr size_t MiB = 1u << 20;
constexpr size_t WS_CTL = 0, CTL_ZERO_BYTES = 2 * MiB;
constexpr size_t WS_MOD = 1 * MiB, WS_ROPE = 2 * MiB, WS_VEC = 4 * MiB, WS_AMAT = 9 * MiB, WS_SC = 18 * MiB, WS_DBG = 19 * MiB;
constexpr size_t WS_WIN = 20 * MiB, WS_WOUT = 222 * MiB, WS_WGU = 254 * MiB, WS_WDN = 426 * MiB, WS_H = 512 * MiB, WS_PROJ = 642 * MiB, WS_FRAG = 1463 * MiB, WS_END = 1595 * MiB;
static_assert(WS_WIN + (size_t)NP_IN * D * 2 <= WS_WOUT && WS_WGU + (size_t)N_GU * D * 2 <= WS_WDN && WS_WDN + (size_t)D * DFF * 2 <= WS_H, "ws map");
static_assert(WS_H + (size_t)MPAD * D * 2 <= WS_PROJ && WS_PROJ + (size_t)MPAD * NP_IN * 2 <= WS_FRAG && WS_FRAG + (size_t)264 * 4 * 131072 <= WS_END, "ws map");
constexpr int CW_Q0 = 64, CW_BAR = 4096;

constexpr int LDS_BYTES = 160 * 1024;
constexpr int MISC_OFF = LDS_BYTES - 256;

#define XB_TMO      128
#define XB_XCNT(j)  (256  + 64 * (j))
#define XB_XSUB(j)  (1280 + 64 * (j))
#define XB_XGEN(j)  (2304 + 64 * (j))
#define XB_TOP      3328
#define XB_TOPGEN   3392
#define XCD_BAR_WORDS 3456
#define XB_SPIN_CAP (1u << 24)
__device__ __forceinline__ unsigned xb_ld(unsigned* p)              { return __hip_atomic_load(p, __ATOMIC_RELAXED, __HIP_MEMORY_SCOPE_AGENT); }
__device__ __forceinline__ unsigned xb_add(unsigned* p, unsigned v) { return __hip_atomic_fetch_add(p, v, __ATOMIC_RELAXED, __HIP_MEMORY_SCOPE_AGENT); }
__device__ __forceinline__ unsigned xb_xcc_id() { return (unsigned)__builtin_amdgcn_s_getreg((3 << 11) | 20) & 0xFu; }
#define XB_SPIN(cond, bar) do { unsigned _sp = 0; while (cond) { __builtin_amdgcn_s_sleep(1); \
    if ((++_sp & 255u) == 0u) { if (xb_ld(&(bar)[XB_TMO])) break; if (_sp > XB_SPIN_CAP) { atomicAdd(&(bar)[XB_TMO], 1u); break; } } } } while (0)
struct XcdBarrier { unsigned* bar; unsigned x; volatile LAS unsigned* st; };
__device__ __forceinline__ XcdBarrier xcd_barrier_post(unsigned* bar, volatile LAS unsigned* st) {
    XcdBarrier b; b.bar = bar; b.x = xb_xcc_id(); b.st = st;
    if (threadIdx.x == 0) (void)xb_add(&bar[XB_XCNT(b.x)], 1u);
    return b;
}
__device__ __forceinline__ void xcd_barrier_complete(unsigned* bar, unsigned x, unsigned& nloc, unsigned& nx) {
    const unsigned G = gridDim.x * gridDim.y * gridDim.z;
    unsigned sum, cnt, mine, sp = 0u;
    for (;;) {
        sum = 0u; cnt = 0u; mine = 0u;
#pragma unroll
        for (unsigned j = 0; j < 16; ++j) { const unsigned c = xb_ld(&bar[XB_XCNT(j)]); sum += c; cnt += (c > 0u) ? 1u : 0u; mine = (j == x) ? c : mine; }
        if (sum == G) break;
        __builtin_amdgcn_s_sleep(1);
        if ((++sp & 255u) == 0u) { if (xb_ld(&bar[XB_TMO])) break; if (sp > XB_SPIN_CAP) { atomicAdd(&bar[XB_TMO], 1u); break; } }
    }
    nloc = mine > 0u ? mine : 1u; nx = cnt > 0u ? cnt : 1u;
}
__device__ __forceinline__ void xcd_barrier(const XcdBarrier& b) {
    asm volatile("s_waitcnt vmcnt(0)" ::: "memory");
    __syncthreads();
    if (threadIdx.x == 0) {
        unsigned* bar = b.bar;
        __builtin_amdgcn_s_waitcnt(0);
        unsigned nloc = b.st[0], nx = b.st[1];
        if (nloc == 0u) { xcd_barrier_complete(bar, b.x, nloc, nx); b.st[0] = nloc; b.st[1] = nx; }
        const unsigned old = xb_add(&bar[XB_XSUB(b.x)], 1u);
        const unsigned gen = old / nloc;
        if (old + 1u == (gen + 1u) * nloc) {
            __builtin_amdgcn_fence(__ATOMIC_RELEASE, "agent");
            asm volatile("s_waitcnt vmcnt(0)" ::: "memory");
            const unsigned og = xb_add(&bar[XB_TOP], 1u);
            const unsigned tg = og / nx;
            if (og + 1u == (tg + 1u) * nx) xb_add(&bar[XB_TOPGEN], 1u);
            else XB_SPIN(xb_ld(&bar[XB_TOPGEN]) == tg, bar);
            __builtin_amdgcn_fence(__ATOMIC_ACQUIRE, "agent");
            xb_add(&bar[XB_XGEN(b.x)], 1u);
            asm volatile("s_waitcnt vmcnt(0)" ::: "memory");
        } else {
            XB_SPIN(xb_ld(&bar[XB_XGEN(b.x)]) == gen, bar);
            __builtin_amdgcn_fence(__ATOMIC_ACQUIRE, "agent");
            asm volatile("s_waitcnt vmcnt(0)" ::: "memory");
        }
    }
    __syncthreads();
}

namespace pg8 {
constexpr int BM = 256, BK = 64, HALF = 128, HTB = HALF * BK * 2, STAGE_BYTES = 8 * HTB, NXCD = 8, WGM = 8;
__host__ __device__ __forceinline__ int lds_byte(int r, int c) { const int st = (r >> 4) * 2 + (c >> 5), rr = r & 15, cc = c & 31, ob = rr * 64 + cc * 2; return st * 1024 + (ob ^ (((ob >> 9) & 1) << 5)); }
__host__ __device__ __forceinline__ void stage_rc(int b, int& R, int& C) { const int st = b / 1024, sb = b % 1024, swz = sb ^ (((sb >> 9) & 1) << 5); R = (st >> 1) * 16 + swz / 64; C = (st & 1) * 32 + (swz % 64) / 2; }
__host__ __device__ __forceinline__ int perm32(int rho) { const int n = rho >> 4, i = rho & 15; return 8 * (i >> 2) + 4 * n + (i & 3); }
struct Unit { int pm, pn; };
struct Gemm { const bf16* A; const bf16* Bt; int M, N, K; };
struct StaticOrder {
    int nM, nN, nwg, G, c; int force0 = 0;
    __host__ __device__ void init(int M, int N, int G_, int c_) { nM = M / BM; nN = N / BM; nwg = nM * nN; G = G_; c = c_; }
    __host__ __device__ bool next(int i, Unit& u) const {
        const long L = (long)i * G + c; if (L >= nwg) return false;
        int wgid = (int)L; { const int q = nwg / NXCD, r = nwg % NXCD, xcd = wgid % NXCD, off = wgid / NXCD; wgid = (xcd < r ? xcd * (q + 1) : r * (q + 1) + (xcd - r) * q) + off; }
        const int nig = WGM * nN, gid = wgid / nig, fm = gid * WGM, gsz = (nM - fm) < WGM ? (nM - fm) : WGM;
        u.pm = fm + ((wgid % nig) % gsz); u.pn = (wgid % nig) / gsz; if (force0) { u.pm = 0; u.pn = 0; } return true;
    }
};
template <class Epi, bool AIMG = false, bool BIMG = false>
__device__ __forceinline__ void gemm_phase(LAS unsigned char* lds, const Gemm g, const StaticOrder& S, const Epi& E) {
    int tid_ = threadIdx.x; asm volatile("" : "+v"(tid_));
    const int tid = tid_, wid = __builtin_amdgcn_readfirstlane(tid >> 6), lane = tid & 63, wr = wid >> 2, wc = wid & 3, fr = lane & 15, fq = lane >> 4;
    const int K = g.K, nt = K / BK;
    unsigned voffA[2], voffB[2];
#pragma unroll
    for (int i = 0; i < 2; ++i) { int R, C; stage_rc(tid * 16 + i * 8192, R, C); const int Rb = Epi::PERM ? ((R & ~31) + perm32(R & 31)) : R;
        voffA[i] = AIMG ? (unsigned)(tid * 16 + i * 8192) : (unsigned)(R * K + C) * 2u; voffB[i] = BIMG ? (unsigned)(tid * 16 + i * 8192) : (unsigned)(Rb * K + C) * 2u; }
    const size_t kstepA = AIMG ? (size_t)HTB : (size_t)(BK * 2), kstepB = BIMG ? (size_t)HTB : (size_t)(BK * 2);
    const size_t hstepA = AIMG ? (size_t)nt * HTB : (size_t)HALF * K * 2, hstepB = BIMG ? (size_t)nt * HTB : (size_t)HALF * K * 2;
    const size_t tstepA = 2 * hstepA, tstepB = 2 * hstepB;
    const unsigned ldsw = (unsigned)wid * 1024u;
    const int aoff = lds_byte(wr * 64 + fr, fq * 8), boff = lds_byte(wc * 32 + fr, fq * 8);
#define PG8_SA(b, h) (((b) * 2 + (h)) * HTB)
#define PG8_SB(b, h) ((4 + (b) * 2 + (h)) * HTB)
#define PG8_STAGE(bufoff, gbase, voff) do { _Pragma("unroll") for (int _i = 0; _i < 2; ++_i) \
        __builtin_amdgcn_global_load_lds((const unsigned*)((const char*)(gbase) + (voff)[_i]), (LAS unsigned*)(lds + (bufoff) + ldsw + _i * 8192), 16, 0, 0); } while (0)
#define PG8_LDA(dst, b, h) do { _Pragma("unroll") for (int m = 0; m < 4; ++m) _Pragma("unroll") for (int k = 0; k < 2; ++k) dst[m][k] = *(const LAS bf16x8*)(lds + PG8_SA(b, h) + aoff + m * 2048 + k * 1024); } while (0)
#define PG8_LDB(dst, b, h) do { _Pragma("unroll") for (int n = 0; n < 2; ++n) _Pragma("unroll") for (int k = 0; k < 2; ++k) dst[n][k] = *(const LAS bf16x8*)(lds + PG8_SB(b, h) + boff + n * 2048 + k * 1024); } while (0)
#define PG8_MMA(ai, bj, At, Bt) do { __builtin_amdgcn_s_setprio(1); _Pragma("unroll") for (int m = 0; m < 4; ++m) _Pragma("unroll") for (int n = 0; n < 2; ++n) _Pragma("unroll") for (int k = 0; k < 2; ++k) \
        acc[ai][bj][m][n] = __builtin_amdgcn_mfma_f32_16x16x32_bf16(Bt[n][k], At[m][k], acc[ai][bj][m][n], 0, 0, 0); __builtin_amdgcn_s_setprio(0); } while (0)
#define PG8_WAIT_V(n) asm volatile("s_waitcnt vmcnt(" #n ")" ::: "memory")
#define PG8_WAIT_L(n) asm volatile("s_waitcnt lgkmcnt(" #n ")" ::: "memory")
#define PG8_BAR __builtin_amdgcn_s_barrier()
#define PG8_SCHED __builtin_amdgcn_sched_barrier(0)
    Unit cur, nxt; int ui = 0;
    if (!S.next(0, cur)) return;
    f32x4 acc[2][2][4][2];
#pragma unroll
    for (int a = 0; a < 2; ++a)
#pragma unroll
        for (int b = 0; b < 2; ++b)
#pragma unroll
            for (int m = 0; m < 4; ++m)
#pragma unroll
                for (int n = 0; n < 2; ++n) acc[a][b][m][n] = (f32x4){0.f, 0.f, 0.f, 0.f};
    bf16x8 At[4][2], B0[2][2], B1[2][2];
    const char* cA = (const char*)g.A + (size_t)cur.pm * tstepA; const char* cB = (const char*)g.Bt + (size_t)cur.pn * tstepB;
    PG8_STAGE(PG8_SB(0, 0), cB, voffB); PG8_STAGE(PG8_SB(0, 1), cB + hstepB, voffB); PG8_STAGE(PG8_SA(0, 0), cA, voffA); PG8_STAGE(PG8_SA(0, 1), cA + hstepA, voffA);
    if (wr == 1) PG8_BAR;
    PG8_WAIT_V(2); PG8_BAR;
    PG8_STAGE(PG8_SB(1, 0), cB + kstepB, voffB); PG8_STAGE(PG8_SA(1, 0), cA + kstepA, voffA); PG8_STAGE(PG8_SB(1, 1), cB + hstepB + kstepB, voffB);
    PG8_WAIT_V(6); PG8_BAR;
    for (;;) {
        const bool has_next = S.next(ui + 1, nxt);
        const char* nA = has_next ? (const char*)g.A + (size_t)nxt.pm * tstepA : cA; const char* nB = has_next ? (const char*)g.Bt + (size_t)nxt.pn * tstepB : cB;
        for (int t = 0; t < nt; t += 2) {
            const bool last = (t == nt - 2);
            const char* a1 = cA + (size_t)(t + 1) * kstepA;
            const char* a2 = last ? nA : cA + (size_t)(t + 2) * kstepA; const char* b2 = last ? nB : cB + (size_t)(t + 2) * kstepB;
            const char* a3 = a2 + kstepA; const char* b3 = b2 + kstepB;
            PG8_LDB(B0, 0, 0); PG8_LDB(B1, 0, 1); PG8_SCHED; PG8_LDA(At, 0, 0); PG8_STAGE(PG8_SA(1, 1), a1 + hstepA, voffA);
            PG8_WAIT_V(8); PG8_WAIT_L(0); PG8_BAR; PG8_MMA(0, 0, At, B0); PG8_MMA(0, 1, At, B1); PG8_BAR; PG8_SCHED;
            PG8_LDA(At, 0, 1); PG8_STAGE(PG8_SB(0, 0), b2, voffB); PG8_STAGE(PG8_SB(0, 1), b2 + hstepB, voffB); PG8_STAGE(PG8_SA(0, 0), a2, voffA);
            PG8_WAIT_V(8); PG8_WAIT_L(0); PG8_BAR; PG8_MMA(1, 0, At, B0); PG8_MMA(1, 1, At, B1); PG8_BAR; PG8_SCHED;
            PG8_LDB(B0, 1, 0); PG8_LDB(B1, 1, 1); PG8_SCHED; PG8_LDA(At, 1, 0); PG8_STAGE(PG8_SA(0, 1), a2 + hstepA, voffA);
            PG8_WAIT_V(8); PG8_WAIT_L(0); PG8_BAR; PG8_MMA(0, 0, At, B0); PG8_MMA(0, 1, At, B1); PG8_BAR; PG8_SCHED;
            PG8_LDA(At, 1, 1); PG8_STAGE(PG8_SB(1, 0), b3, voffB); PG8_STAGE(PG8_SB(1, 1), b3 + hstepB, voffB); PG8_STAGE(PG8_SA(1, 0), a3, voffA);
            PG8_WAIT_V(8); PG8_WAIT_L(0); PG8_BAR; PG8_MMA(1, 0, At, B0); PG8_MMA(1, 1, At, B1); PG8_BAR; PG8_SCHED;
        }
        if (wr == 0) PG8_BAR;
        E(acc, cur, wr, wc, fr, fq);
        if (!has_next) break;
#pragma unroll
        for (int a = 0; a < 2; ++a)
#pragma unroll
            for (int b = 0; b < 2; ++b)
#pragma unroll
                for (int m = 0; m < 4; ++m)
#pragma unroll
                    for (int n = 0; n < 2; ++n) acc[a][b][m][n] = (f32x4){0.f, 0.f, 0.f, 0.f};
        cur = nxt; cA = nA; cB = nB; ++ui;
        if (wr == 1) PG8_BAR;
    }
    PG8_WAIT_V(0);
    PG8_BAR;
#undef PG8_SA
#undef PG8_SB
#undef PG8_STAGE
#undef PG8_LDA
#undef PG8_LDB
#undef PG8_MMA
#undef PG8_WAIT_V
#undef PG8_WAIT_L
#undef PG8_BAR
#undef PG8_SCHED
}
__device__ __forceinline__ size_t img_off(int row, int k, int nt, bool permb) {
    int r = row & 127; if (permb) { const int m = r & 31; r = (r & ~31) + 16 * ((m >> 2) & 1) + 4 * (m >> 3) + (m & 3); }
    return ((size_t)(row >> 7) * nt + (k >> 6)) * (size_t)HTB + (size_t)lds_byte(r, k & 63);
}
}

struct Args { const float* in[20]; float* out; unsigned char* ws; };
enum { I_XP = 0, I_XS, I_SG, I_CK, I_CV, I_CP, I_CS, I_WADA, I_BADA, I_G1, I_WIN, I_WGK, I_BGK, I_GGLA, I_SINK, I_WOUT, I_G2, I_WGU, I_WDN, I_GF };

struct Frame {
    LAS unsigned char* lds;
    volatile LAS unsigned* MISC;
    gu32* ctl;
    int tid, lane, wave, G, bid;
    const float* in[20];
    float* out; unsigned char* ws;
    float* MOD; float* ROPEC; float* ROPES; float* SC; float* DBG;
    bf16 *WIN, *WOUT, *WGU, *WDN, *H, *PROJ;
};

__device__ __forceinline__ int row_batch(int row) { return row < MP ? (row >> 13) : 2 + ((row - MP) >> 4); }
__device__ __forceinline__ int row_pos(int row) { return row < MP ? (row & 8191) : 2048 + (row & 15); }
__device__ __forceinline__ const float* x_row(const Frame& F, int row) { return row < MP ? F.in[I_XP] + (size_t)row * D : F.in[I_XS] + (size_t)(row - MP) * D; }

__device__ __forceinline__ int win_src_col(int n) {
    if (n < 8192) return n;
    if (n < 12288 || (n >= 17408 && n < 21504)) {
        const int ct = n < 12288 ? (n - 8192) >> 8 : 16 + ((n - 17408) >> 8), j = n & 255; return j < 128 ? 8192 + 128 * ct + j : 17424 + 128 * ct + (j - 128); }
    if (n < 16896) { const bool isq = n < 16384; const int r = n - (isq ? 12288 : 16384), hh = r >> 6, p = r & 63, t = p >> 3, e = p & 7;
        const int d = (e < 4) ? (4 * t + e) : (32 + 4 * t + (e - 4)); return (isq ? O_QB : O_KB) + 64 * hh + d; }
    if (n < 25600) return n + 16;
    if (n < 25616) return O_RA + (n - 25600);
    return -1;
}
__device__ __forceinline__ int wgu_src_col(int n) { const int pn = n >> 8, j = n & 255; return j < 128 ? 128 * pn + j : DFF + 128 * pn + (j - 128); }

__device__ __forceinline__ void p0_transpose(const float* W, int K, int N, bf16* WT, int mode, LAS float* scr, int n0, int k0, int lane, int imgnt = 0, bool permb = false) {
    const int cg = lane & 15, kr = lane >> 4;
    const int n = n0 + 4 * cg; const int src = mode == 1 ? win_src_col(n) : (mode == 2 ? wgu_src_col(n) : n);
    const float* wp = W + (size_t)(k0 + kr) * N + (src < 0 ? 0 : src);
    f32x4 v[16];
#pragma unroll
    for (int j = 0; j < 16; ++j) v[j] = src >= 0 ? *(const f32x4*)(wp + (size_t)(4 * j) * N) : (f32x4){0.f, 0.f, 0.f, 0.f};
#pragma unroll
    for (int j = 0; j < 16; ++j) { LAS float* d = scr + (4 * j + kr) * 65 + 4 * cg; d[0] = v[j].x; d[1] = v[j].y; d[2] = v[j].z; d[3] = v[j].w; }
    LDS_WAIT(); asm volatile("" ::: "memory");
    const int c = lane & 7;
#pragma unroll
    for (int j = 0; j < 8; ++j) { const int nn = (lane >> 3) + 8 * j; const LAS float* q = scr + (8 * c) * 65 + nn;
        u32x4 o; o.x = cvtpk(q[0], q[65]); o.y = cvtpk(q[2 * 65], q[3 * 65]); o.z = cvtpk(q[4 * 65], q[5 * 65]); o.w = cvtpk(q[6 * 65], q[7 * 65]);
        if (imgnt) *(u32x4*)((unsigned char*)WT + pg8::img_off(n0 + nn, k0 + 8 * c, imgnt, permb)) = o;
        else *(u32x4*)(WT + (size_t)(n0 + nn) * K + k0 + 8 * c) = o; }
    LDS_WAIT(); asm volatile("" ::: "memory");
}

constexpr int I_MOD = 384, I_TWIN = (NP_IN / 64) * 8, I_TWOUT = (D / 64) * 8, I_TWGU = (N_GU / 64) * 8, I_TWDN = (D / 64) * 22, I_ROPE = 32;
constexpr int P0_ITEMS = I_MOD + I_ROPE + I_TWIN;
constexpr int CW_QGU = 192, CW_QDN = 320;

__device__ __forceinline__ void p0_mod_item(Frame& F, int item) {
    const int w = F.wave, lane = F.lane, cg = item >> 2, kq = item & 3;
    f32x4 acc[10];
#pragma unroll
    for (int b = 0; b < 10; ++b) acc[b] = (f32x4){0.f, 0.f, 0.f, 0.f};
    const int kbase = 1024 * kq + 128 * w;
    const float* wp = F.in[I_WADA] + (size_t)kbase * NMOD + 256 * cg + 4 * lane;
#pragma unroll 1
    for (int kc = 0; kc < 2; ++kc) {
        float scv[10];
#pragma unroll
        for (int b = 0; b < 10; ++b) { const int k = kbase + 64 * kc + lane; const float c = b < 2 ? F.in[I_CP][b * D + k] : F.in[I_CS][(b - 2) * D + k]; scv[b] = c / (1.f + __expf(-c)); }
#pragma unroll
        for (int kk = 0; kk < 64; ++kk) {
            const f32x4 wv = *(const f32x4*)(wp + (size_t)(64 * kc + kk) * NMOD);
#pragma unroll
            for (int b = 0; b < 10; ++b) { const float sv = __builtin_bit_cast(float, __builtin_amdgcn_readlane(__builtin_bit_cast(int, scv[b]), kk)); acc[b] += wv * sv; }
        }
    }
    LAS float* red = (LAS float*)F.lds;
#pragma unroll
    for (int b = 0; b < 10; ++b) *(LAS f32x4*)(red + (w * 10 + b) * 256 + 4 * lane) = acc[b];
    __syncthreads();
    for (int o = F.tid; o < 2560; o += NTHR) { const int b = o >> 8, c = o & 255; float sacc = kq == 0 ? F.in[I_BADA][256 * cg + c] : 0.f;
#pragma unroll
        for (int ww = 0; ww < 8; ++ww) sacc += red[(ww * 10 + b) * 256 + c];
        atomicAdd(F.MOD + b * NMOD + 256 * cg + c, sacc); }
    __syncthreads();
}
__device__ __forceinline__ void p0_rope_item(Frame& F, int it) {
    const int pos = 256 * it + (F.tid >> 1), fh = F.tid & 1;
#pragma unroll 1
    for (int f = 16 * fh; f < 16 * fh + 16; ++f) {
        const float inv = (float)exp2(-(double)f * (13.287712379549449 / 32.0));
        const float ang = (float)pos * inv;
        const double a = (double)ang, r = a - 6.283185307179586 * rint(a * 0.15915494309189535);
        F.ROPEC[pos * 32 + f] = (float)cos(r); F.ROPES[pos * 32 + f] = (float)sin(r);
    }
}
__device__ __forceinline__ void p0_phase(Frame& F, int qw) {
    LAS float* scr = (LAS float*)(F.lds + F.wave * 16640);
    for (;;) {
        __syncthreads();
        if (F.tid == 0) F.MISC[0] = __hip_atomic_fetch_add(F.ctl + qw, 1u, RLX_AGENT);
        __syncthreads();
        int it = (int)F.MISC[0];
        if (it >= P0_ITEMS) break;
        if (it < I_MOD) { p0_mod_item(F, it); continue; } it -= I_MOD;
        if (it < I_ROPE) { p0_rope_item(F, it); continue; } it -= I_ROPE;
        const int w = F.wave;
        p0_transpose(F.in[I_WIN], D, N_IN, F.WIN, 1, scr, 64 * (it >> 3), 512 * (it & 7) + 64 * w, F.lane, D / 64, true);
    }
}
template <int KIND>
__device__ __forceinline__ void drain_weights(Frame& F) {
    LAS float* scr = (LAS float*)(F.lds + F.wave * 16640);
    for (;;) {
        __syncthreads();
        if (F.tid == 0) F.MISC[0] = __hip_atomic_fetch_add(F.ctl + (KIND == 0 ? CW_QGU : CW_QDN), 1u, RLX_AGENT);
        __syncthreads();
        int it = (int)F.MISC[0];
        if (it >= (KIND == 0 ? I_TWOUT + I_TWGU : I_TWDN)) break;
        const int w = F.wave;
        if (KIND == 0 && it < I_TWOUT) p0_transpose(F.in[I_WOUT], D, D, F.WOUT, 0, scr, 64 * (it >> 3), 512 * (it & 7) + 64 * w, F.lane, D / 64, true);
        else if (KIND == 0) { it -= I_TWOUT; p0_transpose(F.in[I_WGU], D, N_GU, F.WGU, 2, scr, 64 * (it >> 3), 512 * (it & 7) + 64 * w, F.lane, D / 64, true); }
        else { const int nb = it / 22, kb = it % 22, k0 = 512 * kb + 64 * w; if (k0 < DFF) p0_transpose(F.in[I_WDN], DFF, D, F.WDN, 0, scr, 64 * nb, k0, F.lane, DFF / 64, true); }
    }
}

template <bool SRCB>
__device__ __forceinline__ void norm_mod_rows(Frame& F, const float* xp, const float* xs, const bf16* xb, const float* g, int off_sh, int off_sc, bf16* Hout) {
    const int gw = F.bid * NWAVES + F.wave, NGW = F.G * NWAVES;
    for (int row = gw; row < MPAD; row += NGW) {
        unsigned char* hb = (unsigned char*)Hout + (size_t)(row >> 7) * (D / 64) * (size_t)pg8::HTB + 8 * (F.lane & 1);
        const int kt0 = F.lane >> 4, cc = (4 * F.lane) & 56, o_lo = pg8::lds_byte(row & 127, cc);
#define H_ST8(j, val) (*(GAS unsigned long long*)(hb + (size_t)(4 * (j) + kt0) * pg8::HTB + o_lo) = (val))
        if (row >= MREAL) {
#pragma unroll
            for (int j = 0; j < 16; ++j) H_ST8(j, 0ull);
            continue; }
        f32x4 v[16]; float s = 0.f;
        if (!SRCB) { const float* xrow = row < MP ? xp + (size_t)row * D : xs + (size_t)(row - MP) * D;
            const GAS f32x4* xr = (const GAS f32x4*)xrow + F.lane;
#pragma unroll
            for (int j = 0; j < 16; ++j) v[j] = xr[64 * j]; }
        else { const GAS u32x2* xr = (const GAS u32x2*)(xb + (size_t)row * D) + F.lane;
#pragma unroll
            for (int j = 0; j < 16; ++j) { const u32x2 w = xr[64 * j]; v[j] = (f32x4){bflo(w.x), bfhi(w.x), bflo(w.y), bfhi(w.y)}; } }
#pragma unroll
        for (int j = 0; j < 16; ++j) s += (v[j].x * v[j].x + v[j].y * v[j].y) + (v[j].z * v[j].z + v[j].w * v[j].w);
        const float r = 1.0f / sqrtf(wave_sum(s) * (1.f / D) + NORM_EPS);
        const float* mod = F.MOD + (size_t)row_batch(row) * NMOD;
#pragma unroll
        for (int j = 0; j < 16; ++j) { const int c = 256 * j + 4 * F.lane;
            const f32x4 gg = *(const f32x4*)(g + c), sh = *(const f32x4*)(mod + off_sh + c), sc = *(const f32x4*)(mod + off_sc + c);
            const f32x4 y = (v[j] * r) * gg * (sc + 1.0f) + sh;
            H_ST8(j, (unsigned long long)cvtpk(y.x, y.y) | ((unsigned long long)cvtpk(y.z, y.w) << 32)); }
    }
}

__device__ __forceinline__ float sigmoidf_(float x) { return __builtin_amdgcn_rcpf(1.f + __expf(-x)); }
struct EpiIn {
    static constexpr bool PERM = true;
    bf16* P; const float* ropec; const float* ropes; float* out;
    __device__ __forceinline__ void operator()(const f32x4 (&acc)[2][2][4][2], const pg8::Unit& u, int wr, int wc, int fr, int fq) const {
        const int pn = u.pn, pm = u.pm;
        const bool is_q = pn >= 48 && pn < 64, is_k = pn >= 64 && pn < 66, is_v = pn >= 66 && pn < 68;
        const bool is_gz = (pn >= 32 && pn < 48) || (pn >= 68 && pn < 84), is_zb = pn >= 84 && pn < 100;
        const int t = 4 * (wc & 1) + fq;
        if (is_gz) {
            const int ct = pn < 48 ? pn - 32 : 16 + (pn - 68);
#pragma unroll
            for (int ai = 0; ai < 2; ++ai)
#pragma unroll
                for (int m = 0; m < 4; ++m) { const int row = pm * 256 + ai * 128 + wr * 64 + m * 16 + fr;
                    const f32x4 g0 = acc[ai][0][m][0], g1 = acc[ai][0][m][1], z0 = acc[ai][1][m][0], z1 = acc[ai][1][m][1]; float a[8];
#pragma unroll
                    for (int x = 0; x < 4; ++x) { a[x] = g0[x] * sigmoidf_(g0[x]) * sigmoidf_(z0[x]); a[4 + x] = g1[x] * sigmoidf_(g1[x]) * sigmoidf_(z1[x]); }
                    u32x4 w; w.x = cvtpk(a[0], a[1]); w.y = cvtpk(a[2], a[3]); w.z = cvtpk(a[4], a[5]); w.w = cvtpk(a[6], a[7]);
                    *(u32x4*)(P + (size_t)row * NP_IN + C_GA + ct * 128 + wc * 32 + 8 * fq) = w; }
            return; }
#pragma unroll
        for (int ai = 0; ai < 2; ++ai)
#pragma unroll
            for (int m = 0; m < 4; ++m) {
                const int row = pm * 256 + ai * 128 + wr * 64 + m * 16 + fr;
                bf16* rowp = P + (size_t)row * NP_IN + pn * 256 + wc * 32 + 8 * fq;
                long kbase = -1;
                if (is_k || is_v) {
                    if (row < MP) { const int tt = row & 8191; if (tt >= 8064) kbase = (is_k ? OUT_KP : OUT_VP) + ((long)((row >> 13) * 128 + (tt - 8064)) * 8) * 64; }
                    else if (row < MREAL) { const int r2 = row - MP; kbase = (is_k ? OUT_KS : OUT_VS) + ((long)((r2 >> 4) * 16 + (r2 & 15)) * 8) * 64; }
                }
                f32x4 cs, sn;
                if (is_q || is_k) { const int pos = row_pos(row); cs = *(const f32x4*)(ropec + pos * 32 + 4 * t); sn = *(const f32x4*)(ropes + pos * 32 + 4 * t); }
#pragma unroll
                for (int bj = 0; bj < 2; ++bj) {
                    f32x4 v0 = acc[ai][bj][m][0], v1 = acc[ai][bj][m][1];
                    if (is_q || is_k) { const f32x4 o1 = v0 * cs - v1 * sn, o2 = v1 * cs + v0 * sn; v0 = o1; v1 = o2;
                        if (is_q) { v0 = v0 * QSCALE; v1 = v1 * QSCALE; } }
                    if (is_zb) {
#pragma unroll
                        for (int x = 0; x < 4; ++x) { v0[x] = sigmoidf_(v0[x]); v1[x] = sigmoidf_(v1[x]); } }
                    if (kbase >= 0) {
                        const int g = 4 * (pn - (is_k ? 64 : 66)) + 2 * bj + (wc >> 1);
                        float* kp = out + kbase + g * 64;
                        if (is_k) { *(f32x4*)(kp + 4 * t) = v0; *(f32x4*)(kp + 32 + 4 * t) = v1; }
                        else { *(f32x4*)(kp + 8 * t) = v0; *(f32x4*)(kp + 8 * t + 4) = v1; }
                    }
                    u32x4 w; w.x = cvtpk(v0[0], v0[1]); w.y = cvtpk(v0[2], v0[3]); w.z = cvtpk(v1[0], v1[1]); w.w = cvtpk(v1[2], v1[3]);
                    *(u32x4*)(rowp + bj * 128) = w;
                }
            }
    }
};

constexpr int CL_PITCH = 520;
constexpr float GLA_QSCALE = 0.04419417382415922f;
__device__ __forceinline__ int crow(int reg, int h) { return (reg & 3) + 8 * (reg >> 2) + 4 * h; }
#define MFMA32(a, b, c) __builtin_amdgcn_mfma_f32_32x32x16_bf16((a), (b), (c), 0, 0, 0)
__device__ __forceinline__ bf16x8 pack8(const f32x16& x, int s) {
    u32x4 p; p.x = cvtpk(x[8 * s], x[8 * s + 1]); p.y = cvtpk(x[8 * s + 2], x[8 * s + 3]); p.z = cvtpk(x[8 * s + 4], x[8 * s + 5]); p.w = cvtpk(x[8 * s + 6], x[8 * s + 7]);
    return __builtin_bit_cast(bf16x8, p);
}
constexpr float LOG2E_ = 1.4426950408889634f;
__device__ __forceinline__ float logsig(float x) { return fminf(x, 0.f) - __logf(1.f + __expf(-fabsf(x))); }

__device__ __forceinline__ void gla_chunk_local(Frame& F, int cid, int hd) {
    const int tid = F.tid, lane = F.lane, wv = F.wave, h = lane >> 5;
    LAS bf16* QL = (LAS bf16*)F.lds; LAS bf16* KL = QL + 64 * CL_PITCH;
    LAS float* RA = (LAS float*)(F.lds + 133120); LAS float* RED = (LAS float*)(F.lds + 137216);
    int row0, ntok; if (cid < 256) { row0 = cid * 64; ntok = 64; } else { row0 = MP + 16 * (cid - 256); ntok = 16; }
    const int d = tid;
    float wg[16];
#pragma unroll
    for (int r = 0; r < 16; ++r) wg[r] = F.in[I_WGK][r * 2048 + hd * 512 + d];
    const float bias = F.in[I_BGK][hd * 512 + d];
    u32x4 rq[8], rk[8];
#pragma unroll
    for (int j = 0; j < 8; ++j) { const int id = tid + 512 * j, rr = id >> 6, c16 = id & 63; rq[j] = (u32x4){0u, 0u, 0u, 0u}; rk[j] = rq[j];
        if (rr < ntok) { const bf16* pr = F.PROJ + (size_t)(row0 + rr) * NP_IN + hd * 512 + 8 * c16; rq[j] = *(const u32x4*)(pr + C_QA); rk[j] = *(const u32x4*)(pr + C_KA); } }
    if (tid < 128) { const int i = tid >> 1, half = tid & 1; u32x4 w = (u32x4){0u, 0u, 0u, 0u};
        if (i < ntok) w = *(const u32x4*)(F.PROJ + (size_t)(row0 + i) * NP_IN + C_RA + 8 * half);
        LAS float* r = RA + i * 16 + 8 * half;
        r[0] = bflo(w.x); r[1] = bfhi(w.x); r[2] = bflo(w.y); r[3] = bfhi(w.y); r[4] = bflo(w.z); r[5] = bfhi(w.z); r[6] = bflo(w.w); r[7] = bfhi(w.w); }
#pragma unroll
    for (int j = 0; j < 8; ++j) { const int id = tid + 512 * j, rr = id >> 6, c16 = id & 63; *(LAS u32x4*)(QL + rr * CL_PITCH + 8 * c16) = rq[j]; *(LAS u32x4*)(KL + rr * CL_PITCH + 8 * c16) = rk[j]; }
    __syncthreads();
    float B[64]; float bc = 0.f;
    unsigned ra_base = (unsigned)(size_t)RA; asm volatile("" : "+v"(ra_base));
    const f32x2 w01 = {wg[0], wg[1]}, w23 = {wg[2], wg[3]}, w45 = {wg[4], wg[5]}, w67 = {wg[6], wg[7]}, w89 = {wg[8], wg[9]}, wab = {wg[10], wg[11]}, wcd = {wg[12], wg[13]}, wef = {wg[14], wg[15]};
#pragma unroll
    for (int i = 0; i < 64; ++i) {
        const LAS f32x4* rp = (const LAS f32x4*)(size_t)(ra_base + (unsigned)(i * 64));
        const f32x4 r0 = rp[0], r1 = rp[1], r2 = rp[2], r3 = rp[3];
        f32x2 a2 = (f32x2){r0.x, r0.y} * w01; a2 += (f32x2){r0.z, r0.w} * w23; a2 += (f32x2){r1.x, r1.y} * w45; a2 += (f32x2){r1.z, r1.w} * w67;
        a2 += (f32x2){r2.x, r2.y} * w89; a2 += (f32x2){r2.z, r2.w} * wab; a2 += (f32x2){r3.x, r3.y} * wcd; a2 += (f32x2){r3.z, r3.w} * wef;
        const float gk = bias + (a2.x + a2.y);
        const float l2 = __builtin_amdgcn_logf(1.f + __builtin_amdgcn_exp2f(-fabsf(gk) * LOG2E_));
        float g = (fminf(gk, 0.f) - l2 * 0.6931471805599453f) * (1.f / 16.f); if (i >= ntok) g = 0.f;
        bc += g; B[i] = bc; }
    const float bmid = (ntok == 64) ? B[32] : B[8], blast = B[63];
    float* VEC = (float*)(F.ws + WS_VEC) + (size_t)(cid * 4 + hd) * 1024;
    VEC[d] = __expf(bmid); VEC[512 + d] = __expf(blast - bmid);
    unsigned kpk[32]; float kprev = 0.f;
#pragma unroll
    for (int i = 0; i < 64; ++i) {
        const float q = bf2f(QL[i * CL_PITCH + d]), k = bf2f(KL[i * CL_PITCH + d]);
        const float qt = q * GLA_QSCALE * __expf(B[i] - bmid), kt = k * __expf(bmid - B[i]);
        QL[i * CL_PITCH + d] = (bf16)(cvtpk(qt, 0.f) & 0xffffu);
        KL[i * CL_PITCH + d] = (bf16)(cvtpk(kt, 0.f) & 0xffffu);
        if (i & 1) kpk[i >> 1] = cvtpk(kprev, kt); else kprev = kt; }
    __syncthreads();
    unsigned char* fq = F.ws + WS_FRAG + (size_t)(cid * 4 + hd) * 131072; unsigned char* fk = fq + 65536;
    { const int dt = (d >> 5) & 1, dl = d & 31;
#pragma unroll
      for (int sp = 0; sp < 4; ++sp)
#pragma unroll
          for (int hh = 0; hh < 2; ++hh) { u32x4 o; o.x = kpk[8 * sp + 4 * hh]; o.y = kpk[8 * sp + 4 * hh + 1]; o.z = kpk[8 * sp + 4 * hh + 2]; o.w = kpk[8 * sp + 4 * hh + 3];
              *(u32x4*)(fk + ((wv * 2 + dt) * 4 + sp) * 1024 + (dl + 32 * hh) * 16) = o; } }
#pragma unroll
    for (int mt = 0; mt < 2; ++mt)
#pragma unroll
        for (int dt = 0; dt < 2; ++dt)
#pragma unroll
            for (int s = 0; s < 2; ++s) { const int i = 32 * mt + (lane & 31), d0 = 64 * wv + 32 * dt + 16 * s + 4 * h;
                const u32x2 a = *(const LAS u32x2*)(QL + i * CL_PITCH + d0), b = *(const LAS u32x2*)(QL + i * CL_PITCH + d0 + 8);
                u32x4 o; o.x = a.x; o.y = a.y; o.z = b.x; o.w = b.y;
                *(u32x4*)(fq + (((wv * 2 + mt) * 2 + dt) * 2 + s) * 1024 + lane * 16) = o; }
    const int tile = wv & 3, jt = tile >> 1, it = tile & 1, kh = wv >> 2;
    f32x16 acc;
#pragma unroll
    for (int r = 0; r < 16; ++r) acc[r] = 0.f;
#pragma unroll
    for (int ks = 0; ks < 16; ++ks) { const int dk = 256 * kh + 16 * ks + 8 * h;
        const bf16x8 a = *(const LAS bf16x8*)(KL + (32 * jt + (lane & 31)) * CL_PITCH + dk);
        const bf16x8 b = *(const LAS bf16x8*)(QL + (32 * it + (lane & 31)) * CL_PITCH + dk);
        acc = MFMA32(a, b, acc); }
    if (kh == 1) {
#pragma unroll
        for (int r = 0; r < 16; ++r) RED[(tile * 16 + r) * 64 + lane] = acc[r]; }
    __syncthreads();
    if (kh == 0) {
        const int i = 32 * it + (lane & 31);
#pragma unroll
        for (int r = 0; r < 16; ++r) { const float v = acc[r] + RED[(tile * 16 + r) * 64 + lane]; const int j = 32 * jt + crow(r, h); acc[r] = (j > i) ? 0.f : v; }
        unsigned char* am = F.ws + WS_AMAT + (size_t)(cid * 4 + hd) * 8192;
#pragma unroll
        for (int s = 0; s < 2; ++s) { const bf16x8 p = pack8(acc, s); *(bf16x8*)(am + (it + 2 * (2 * jt + s)) * 1024 + lane * 16) = p; }
    }
    __syncthreads();
}

constexpr int KS_PITCH = 72, VT_PITCH = 196;
constexpr float LOG2E = 1.4426950408889634f;
constexpr size_t WS_DUMMY = 1600 * MiB;
template <bool SAMPLE, bool DUMMY = false>
__device__ __forceinline__ void swa_unit(Frame& F, int b, int n, int g) {
    const int tid = F.tid, lane = F.lane, wv = F.wave, h = lane >> 5;
    LAS bf16* KS = (LAS bf16*)F.lds; LAS bf16* VT = KS + 192 * KS_PITCH;
    int nk, ntile;
    if (!SAMPLE) {
        nk = 64 * (n + 1 < 3 ? n + 1 : 3); ntile = nk >> 5;
        const int kr0 = b * SEQ + 64 * (n > 2 ? n - 2 : 0);
        for (int task = tid; task < nk * 8; task += NTHR) { const int key = task >> 3, c8 = task & 7;
            *(LAS u32x4*)(KS + key * KS_PITCH + 8 * c8) = *(const u32x4*)(F.PROJ + (size_t)(kr0 + key) * NP_IN + C_KB + g * 64 + 8 * c8); }
        for (int task = tid; task < nk * 8; task += NTHR) { const int kp = task >> 4, dq = task & 15;
            const bf16* vp = F.PROJ + (size_t)(kr0 + 2 * kp) * NP_IN + C_VB + g * 64 + 4 * dq;
            const u32x2 a = *(const u32x2*)vp, c = *(const u32x2*)(vp + NP_IN);
            LAS unsigned* o = (LAS unsigned*)(VT + (4 * dq) * VT_PITCH + 2 * kp);
            o[0] = (a.x & 0xffffu) | (c.x << 16); o[VT_PITCH / 2] = (a.x >> 16) | (c.x & 0xffff0000u);
            o[VT_PITCH] = (a.y & 0xffffu) | (c.y << 16); o[3 * (VT_PITCH / 2)] = (a.y >> 16) | (c.y & 0xffff0000u); }
    } else {
        nk = 144; ntile = 5;
        const float* ck = F.in[I_CK]; const float* cv = F.in[I_CV];
        for (int task = tid; task < 160 * 8; task += NTHR) { const int key = task >> 3, t = task & 7; u32x4 o = (u32x4){0u, 0u, 0u, 0u};
            if (key < 128) { const float* p = ck + ((size_t)(b * 128 + key) * 8 + g) * 64; const f32x4 x1 = *(const f32x4*)(p + 4 * t), x2 = *(const f32x4*)(p + 32 + 4 * t);
                o.x = cvtpk(x1.x, x1.y); o.y = cvtpk(x1.z, x1.w); o.z = cvtpk(x2.x, x2.y); o.w = cvtpk(x2.z, x2.w); }
            else if (key < 144) o = *(const u32x4*)(F.PROJ + (size_t)(MP + 16 * b + (key - 128)) * NP_IN + C_KB + g * 64 + 8 * t);
            *(LAS u32x4*)(KS + key * KS_PITCH + 8 * t) = o; }
        for (int task = tid; task < 80 * 16; task += NTHR) { const int kp = task >> 4, dq = task & 15; unsigned w0 = 0u, w1 = 0u, w2 = 0u, w3 = 0u;
            if (kp < 64) { const float* p = cv + ((size_t)(b * 128 + 2 * kp) * 8 + g) * 64 + 4 * dq; const f32x4 a = *(const f32x4*)p, c = *(const f32x4*)(p + 512);
                w0 = cvtpk(a.x, c.x); w1 = cvtpk(a.y, c.y); w2 = cvtpk(a.z, c.z); w3 = cvtpk(a.w, c.w); }
            else if (kp < 72) { const bf16* vp = F.PROJ + (size_t)(MP + 16 * b + 2 * (kp - 64)) * NP_IN + C_VB + g * 64 + 4 * dq;
                const u32x2 a = *(const u32x2*)vp, c = *(const u32x2*)(vp + NP_IN);
                w0 = (a.x & 0xffffu) | (c.x << 16); w1 = (a.x >> 16) | (c.x & 0xffff0000u); w2 = (a.y & 0xffffu) | (c.y << 16); w3 = (a.y >> 16) | (c.y & 0xffff0000u); }
            LAS unsigned* o = (LAS unsigned*)(VT + (4 * dq) * VT_PITCH + 2 * kp);
            o[0] = w0; o[VT_PITCH / 2] = w1; o[VT_PITCH] = w2; o[3 * (VT_PITCH / 2)] = w3; }
    }
    __syncthreads();
    const int npass = SAMPLE ? 1 : 2;
    if (!SAMPLE || wv < 4) {
#pragma unroll 1
        for (int pass = 0; pass < npass; ++pass) {
            const int r = lane & 31;
            int head, row;
            if (!SAMPLE) { head = g * 8 + wv; row = b * SEQ + 64 * n + 32 * pass + r; }
            else { head = g * 8 + 2 * wv + (r >> 4); row = MP + 16 * b + (r & 15); }
            const float sink2 = F.in[I_SINK][head] * LOG2E;
            bf16* qptr = F.PROJ + (size_t)row * NP_IN + C_QB + head * 64;
            bf16x8 qf[4];
#pragma unroll
            for (int t = 0; t < 4; ++t) qf[t] = *(const bf16x8*)(qptr + 16 * t + 8 * h);
            f32x16 st[6];
#pragma unroll
            for (int kt = 0; kt < 6; ++kt) {
#pragma unroll
                for (int rr = 0; rr < 16; ++rr) st[kt][rr] = -INFINITY;
                if (kt < ntile) { f32x16 a;
#pragma unroll
                    for (int rr = 0; rr < 16; ++rr) a[rr] = 0.f;
#pragma unroll
                    for (int t = 0; t < 4; ++t) { const bf16x8 kf = *(const LAS bf16x8*)(KS + (32 * kt + r) * KS_PITCH + 16 * t + 8 * h); a = MFMA32(kf, qf[t], a); }
                    st[kt] = a; } }
            if (SAMPLE) {
#pragma unroll
                for (int rr = 0; rr < 16; ++rr) if (crow(rr, h) >= 16) st[4][rr] = -INFINITY; }
            float m = sink2;
#pragma unroll
            for (int kt = 0; kt < 6; ++kt)
#pragma unroll
                for (int rr = 0; rr < 16; ++rr) m = fmaxf(m, st[kt][rr]);
            m = fmaxf(m, __shfl_xor(m, 32));
            float sum = 0.f;
#pragma unroll
            for (int kt = 0; kt < 6; ++kt)
#pragma unroll
                for (int rr = 0; rr < 16; ++rr) { const float p = __builtin_amdgcn_exp2f(st[kt][rr] - m); st[kt][rr] = p; sum += p; }
            sum += __shfl_xor(sum, 32);
            const float inv = 1.f / (sum + __builtin_amdgcn_exp2f(sink2 - m));
            f32x16 o0, o1;
#pragma unroll
            for (int rr = 0; rr < 16; ++rr) { o0[rr] = 0.f; o1[rr] = 0.f; }
#pragma unroll
            for (int kt = 0; kt < 6; ++kt) if (kt < ntile) {
#pragma unroll
                for (int s = 0; s < 2; ++s) { const bf16x8 pb = pack8(st[kt], s);
                    const LAS bf16* v0 = VT + r * VT_PITCH + 32 * kt + 16 * s + 4 * h; const LAS bf16* v1 = v0 + 32 * VT_PITCH;
                    const u32x2 a0 = *(const LAS u32x2*)v0, a1 = *(const LAS u32x2*)(v0 + 8), c0 = *(const LAS u32x2*)v1, c1 = *(const LAS u32x2*)(v1 + 8);
                    u32x4 va; va.x = a0.x; va.y = a0.y; va.z = a1.x; va.w = a1.y; u32x4 vc; vc.x = c0.x; vc.y = c0.y; vc.z = c1.x; vc.w = c1.y;
                    o0 = MFMA32(__builtin_bit_cast(bf16x8, va), pb, o0); o1 = MFMA32(__builtin_bit_cast(bf16x8, vc), pb, o1); } }
#pragma unroll
            for (int rg = 0; rg < 4; ++rg) { u32x2 w0, w1;
                w0.x = cvtpk(o0[4 * rg] * inv, o0[4 * rg + 1] * inv); w0.y = cvtpk(o0[4 * rg + 2] * inv, o0[4 * rg + 3] * inv);
                w1.x = cvtpk(o1[4 * rg] * inv, o1[4 * rg + 1] * inv); w1.y = cvtpk(o1[4 * rg + 2] * inv, o1[4 * rg + 3] * inv);
                bf16* optr = DUMMY ? (bf16*)(F.ws + WS_DUMMY) + (size_t)(row & 1023) * 4096 + head * 64 : qptr;
                *(u32x2*)(optr + 8 * rg + 4 * h) = w0; *(u32x2*)(optr + 32 + 8 * rg + 4 * h) = w1; }
        }
    }
    __syncthreads();
}

constexpr int P3_CL = 264 * 4, P3_SWAP = 2048, P3_SWAS = 64, P3_UNITS = P3_CL + P3_SWAP + P3_SWAS;
__device__ __forceinline__ void p3_phase(Frame& F) {
    for (int u = F.bid; u < P3_CL; u += F.G) gla_chunk_local(F, u >> 2, u & 3);
#if PROBE_TWICE == 105
    for (int u = F.bid; u < P3_CL; u += F.G) gla_chunk_local(F, u >> 2, u & 3);
#endif
#if PROBE_TWICE == 103
    for (int v = (F.bid + F.G - (P3_CL % F.G)) % F.G; v < P3_SWAP; v += F.G) swa_unit<false, true>(F, v >> 10, (v >> 3) & 127, v & 7);
#endif
    const bool bal = F.G == 256;
    for (int v = (F.bid + F.G - (P3_CL % F.G)) % F.G, k = 0; v < P3_SWAP; v += F.G, ++k) { if (bal && F.bid < 32 && k >= 6) break; swa_unit<false>(F, v >> 10, (v >> 3) & 127, v & 7); }
    if (bal && F.bid >= 96 && F.bid < 160) { const int src = (F.bid - 96) >> 1, v = ((src + F.G - (P3_CL % F.G)) % F.G) + F.G * (6 + ((F.bid - 96) & 1)); swa_unit<false>(F, v >> 10, (v >> 3) & 127, v & 7); }
    for (int v = (F.bid + 2 * F.G - ((P3_CL + P3_SWAP) % F.G)) % F.G; v < P3_SWAS; v += F.G) swa_unit<true>(F, v >> 3, 0, v & 7);
}

__device__ __forceinline__ u32x2 tr_read8(unsigned addr) { u32x2 r; asm volatile("ds_read_b64_tr_b16 %0, %1\n\ts_waitcnt lgkmcnt(0)" : "=&v"(r) : "v"(addr) : "memory"); return r; }
struct ScanQ { bf16x8 qf[2][2][2], af; };
__device__ __forceinline__ void scan_load_q(ScanQ& P, const unsigned char* ws, int cid, int hd, int wv, int lane) {
    const unsigned char* fq = ws + WS_FRAG + (size_t)(cid * 4 + hd) * 131072;
#pragma unroll
    for (int mt = 0; mt < 2; ++mt)
#pragma unroll
        for (int dt = 0; dt < 2; ++dt)
#pragma unroll
            for (int s = 0; s < 2; ++s) P.qf[mt][dt][s] = *(const bf16x8*)(fq + (((wv * 2 + mt) * 2 + dt) * 2 + s) * 1024 + lane * 16);
    P.af = *(const bf16x8*)(ws + WS_AMAT + (size_t)(cid * 4 + hd) * 8192 + wv * 1024 + lane * 16);
}
__device__ __forceinline__ void scan_load_v(u32x4& vt, f32x4& vec, const unsigned char* ws, const bf16* PROJ, int cid, int hd, int row0, int ntok, int e0, int tid) {
    vt = (u32x4){0u, 0u, 0u, 0u}; vec = (f32x4){0.f, 0.f, 0.f, 0.f};
    if (tid < 256) { const int i = tid >> 2, c4 = tid & 3;
        if (i < ntok) vt = *(const u32x4*)(PROJ + (size_t)(row0 + i) * NP_IN + C_VA + hd * 1024 + e0 + 8 * c4);
        vec = *(const f32x4*)((const float*)(ws + WS_VEC) + (size_t)(cid * 4 + hd) * 1024 + 4 * tid); }
}
__device__ __forceinline__ void scan_store_v(LAS unsigned char* base, const u32x4& vt, const f32x4& vec, int tid) {
    if (tid < 256) { *(LAS u32x4*)((LAS bf16*)base + (tid >> 2) * 32 + 8 * (tid & 3)) = vt; *(LAS f32x4*)((LAS float*)(base + 4096) + 4 * tid) = vec; }
}
struct ScanK { bf16x8 kf[2][4]; };
__device__ __forceinline__ void scan_load_k(ScanK& P, const unsigned char* ws, int cid, int hd, int wv, int lane) {
    const unsigned char* fk = ws + WS_FRAG + (size_t)(cid * 4 + hd) * 131072 + 65536;
#pragma unroll
    for (int dt = 0; dt < 2; ++dt)
#pragma unroll
        for (int sp = 0; sp < 4; ++sp) P.kf[dt][sp] = *(const bf16x8*)(fk + ((wv * 2 + dt) * 4 + sp) * 1024 + lane * 16);
}
constexpr int SC_BUF = 73728, SC_VEC = 4096, SC_RED = 8192;
struct ScanTr { u32x2 n[8]; };
__device__ __forceinline__ void scan_tr_reads_p(u32x2& p0, u32x2& p1, unsigned aP) {
    asm volatile("ds_read_b64_tr_b16 %0, %2\n\tds_read_b64_tr_b16 %1, %2 offset:512\n\ts_waitcnt lgkmcnt(0)" : "=&v"(p0), "=&v"(p1) : "v"(aP) : "memory");
}
__device__ __forceinline__ void scan_tr_reads_n(ScanTr& T, unsigned aN) {
    asm volatile("ds_read_b64_tr_b16 %0, %8\n\tds_read_b64_tr_b16 %1, %8 offset:256\n\t"
                 "ds_read_b64_tr_b16 %2, %8 offset:1024\n\tds_read_b64_tr_b16 %3, %8 offset:1280\n\t"
                 "ds_read_b64_tr_b16 %4, %8 offset:2048\n\tds_read_b64_tr_b16 %5, %8 offset:2304\n\t"
                 "ds_read_b64_tr_b16 %6, %8 offset:3072\n\tds_read_b64_tr_b16 %7, %8 offset:3328\n\ts_waitcnt lgkmcnt(0)"
                 : "=&v"(T.n[0]), "=&v"(T.n[1]), "=&v"(T.n[2]), "=&v"(T.n[3]), "=&v"(T.n[4]), "=&v"(T.n[5]), "=&v"(T.n[6]), "=&v"(T.n[7])
                 : "v"(aN) : "memory");
}
template <bool DUMMY, int BUF>
__device__ __forceinline__ void scan_reduce(Frame& F, int hd, int row0, int ntok, int e0) {
    const int tid = F.tid; LAS float* RED = (LAS float*)(F.lds + BUF * SC_BUF + SC_RED);
    const int i = tid >> 3, e4 = 4 * (tid & 7); f32x4 sacc = *(const LAS f32x4*)(RED + i * 32 + e4);
#pragma unroll
    for (int w = 1; w < 8; ++w) sacc += *(const LAS f32x4*)(RED + w * 2048 + i * 32 + e4);
    if (i < ntok) { u32x2 o; o.x = cvtpk(sacc.x, sacc.y); o.y = cvtpk(sacc.z, sacc.w);
        bf16* op_ = DUMMY ? (bf16*)(F.ws + WS_DUMMY) + (size_t)((row0 + i) & 1023) * 4096 + hd * 1024 + e0 + e4 : F.PROJ + (size_t)(row0 + i) * NP_IN + C_VA + hd * 1024 + e0 + e4;
        *(u32x2*)op_ = o; }
}
template <bool SAMPLE, bool DUMMY, int BUF>
__device__ __forceinline__ void scan_step(Frame& F, f32x16& S0, f32x16& S1, ScanQ& cq, ScanK& ck, int cidn, int hd, int rowp, int rown, int ntok, int e0) {
    const int tid = F.tid, lane = F.lane, wv = F.wave, h = lane >> 5, el = lane & 31;
    LAS unsigned char* base = F.lds + BUF * SC_BUF;
    LAS bf16* VB = (LAS bf16*)base; LAS float* VECL = (LAS float*)(base + SC_VEC); LAS float* RED = (LAS float*)(base + SC_RED);
    __syncthreads();
    u32x4 nvt; f32x4 nvec;
    if (!SAMPLE) scan_load_v(nvt, nvec, F.ws, F.PROJ, cidn, hd, rown, ntok, e0, tid);
    if (!SAMPLE && rowp >= 0) scan_reduce<DUMMY, BUF ^ 1>(F, hd, rowp, ntok, e0);
    const int i16 = lane & 15; const unsigned tro = (unsigned)(size_t)VB + (unsigned)((i16 >> 2) * 64 + 32 * ((lane >> 4) & 1) + 8 * (i16 & 3));
    u32x2 tp0, tp1; scan_tr_reads_p(tp0, tp1, tro + (unsigned)((16 * (wv >> 1) + 4 * h) * 64));
#pragma unroll
    for (int rg = 0; rg < 4; ++rg) { const f32x4 e0v = *(const LAS f32x4*)(VECL + 64 * wv + 8 * rg + 4 * h), e1v = *(const LAS f32x4*)(VECL + 64 * wv + 32 + 8 * rg + 4 * h);
#pragma unroll
        for (int x = 0; x < 4; ++x) { S0[4 * rg + x] *= e0v[x]; S1[4 * rg + x] *= e1v[x]; } }
    bf16x8 vP; { u32x4 vv; vv.x = tp0.x; vv.y = tp0.y; vv.z = tp1.x; vv.w = tp1.y; vP = __builtin_bit_cast(bf16x8, vv); }
    LAS float* rw = RED + wv * 2048;
#pragma unroll
    for (int mt = 0; mt < 2; ++mt) {
        f32x16 op;
#pragma unroll
        for (int r = 0; r < 16; ++r) op[r] = 0.f;
        op = MFMA32(cq.qf[mt][0][0], pack8(S0, 0), op); op = MFMA32(cq.qf[mt][0][1], pack8(S0, 1), op); op = MFMA32(cq.qf[mt][1][0], pack8(S1, 0), op); op = MFMA32(cq.qf[mt][1][1], pack8(S1, 1), op);
        if ((wv & 1) == mt) op = MFMA32(cq.af, vP, op);
#pragma unroll
        for (int r = 0; r < 16; ++r) rw[(32 * mt + crow(r, h)) * 32 + el] = op[r];
    }
    asm volatile("" ::: "memory");
    if (!SAMPLE) scan_load_q(cq, F.ws, cidn, hd, wv, lane);
    ScanTr T; scan_tr_reads_n(T, tro + (unsigned)(8 * h * 64));
#pragma unroll
    for (int sp = 0; sp < 4; ++sp) { u32x4 vv; vv.x = T.n[2 * sp].x; vv.y = T.n[2 * sp].y; vv.z = T.n[2 * sp + 1].x; vv.w = T.n[2 * sp + 1].y;
        const bf16x8 vN = __builtin_bit_cast(bf16x8, vv);
        S0 = MFMA32(ck.kf[0][sp], vN, S0); S1 = MFMA32(ck.kf[1][sp], vN, S1); }
    asm volatile("" ::: "memory");
    if (!SAMPLE) scan_load_k(ck, F.ws, cidn, hd, wv, lane);
#pragma unroll
    for (int rg = 0; rg < 4; ++rg) { const f32x4 e0v = *(const LAS f32x4*)(VECL + 512 + 64 * wv + 8 * rg + 4 * h), e1v = *(const LAS f32x4*)(VECL + 512 + 64 * wv + 32 + 8 * rg + 4 * h);
#pragma unroll
        for (int x = 0; x < 4; ++x) { S0[4 * rg + x] *= e0v[x]; S1[4 * rg + x] *= e1v[x]; } }
    if (!SAMPLE) scan_store_v(F.lds + (BUF ^ 1) * SC_BUF, nvt, nvec, tid);
}
template <bool SAMPLE, bool DUMMY = false>
__device__ __forceinline__ void scan_item(Frame& F, int seq, int slice) {
    const int tid = F.tid, lane = F.lane, wv = F.wave, h = lane >> 5, el = lane & 31;
    const int hd = seq & 3, b = seq >> 2, e0 = slice * 32;
    const int nchunks = SAMPLE ? 1 : 128, cid0 = SAMPLE ? 256 + b : b * 128, ntok = SAMPLE ? 16 : 64, row00 = SAMPLE ? MP + 16 * b : b * SEQ;
    ScanQ qa; ScanK ka;
    scan_load_q(qa, F.ws, cid0, hd, wv, lane);
    scan_load_k(ka, F.ws, cid0, hd, wv, lane);
    { u32x4 vt; f32x4 vec; scan_load_v(vt, vec, F.ws, F.PROJ, cid0, hd, row00, ntok, e0, tid); scan_store_v(F.lds, vt, vec, tid); }
    f32x16 S0, S1;
#pragma unroll
    for (int r = 0; r < 16; ++r) { S0[r] = 0.f; S1[r] = 0.f; }
    if (SAMPLE) { const float* sp = F.in[I_SG] + ((size_t)(b * 4 + hd) * 512 + 64 * wv + 4 * h) * 1024 + e0 + el;
#pragma unroll
        for (int rg = 0; rg < 4; ++rg) {
#pragma unroll
            for (int x = 0; x < 4; ++x) { S0[4 * rg + x] = sp[(size_t)(8 * rg + x) * 1024]; S1[4 * rg + x] = sp[(size_t)(32 + 8 * rg + x) * 1024]; }
            asm volatile("" ::: "memory"); } }
    if (SAMPLE) { scan_step<true, DUMMY, 0>(F, S0, S1, qa, ka, cid0, hd, -1, row00, ntok, e0); __syncthreads(); scan_reduce<DUMMY, 0>(F, hd, row00, ntok, e0); __syncthreads(); }
    else {
#pragma unroll 1
        for (int c = 0; c < nchunks; c += 2) {
            const int c2 = c + 2 < nchunks ? c + 2 : c + 1;
            scan_step<false, DUMMY, 0>(F, S0, S1, qa, ka, cid0 + c + 1, hd, c > 0 ? row00 + 64 * (c - 1) : -1, row00 + 64 * (c + 1), ntok, e0);
            scan_step<false, DUMMY, 1>(F, S0, S1, qa, ka, cid0 + c2, hd, row00 + 64 * c, row00 + 64 * c2, ntok, e0);
        }
        __syncthreads();
        scan_reduce<DUMMY, 1>(F, hd, row00 + 64 * (nchunks - 1), ntok, e0);
        __syncthreads();
    }
    { int h2 = h; asm volatile("" : "+v"(h2));
      float* so = F.out + (SAMPLE ? OUT_SGS : OUT_SGP) + ((size_t)(b * 4 + hd) * 512) * 1024 + e0 + (lane & 31) + (size_t)(64 * wv + 4 * h2) * 1024;
#pragma unroll
      for (int r = 0; r < 16; ++r) { so[(size_t)((r & 3) + 8 * (r >> 2)) * 1024] = S0[r]; so[(size_t)(32 + (r & 3) + 8 * (r >> 2)) * 1024] = S1[r]; } }
}
__device__ __forceinline__ void p4_phase(Frame& F) {
#if PROBE_TWICE == 104
    for (int it = F.bid; it < 256; it += F.G) scan_item<false, true>(F, it >> 5, it & 31);
#endif
    for (int it = F.bid; it < 256; it += F.G) scan_item<false>(F, it & 7, (it >> 3) & 31);
    { int t_ = threadIdx.x; asm volatile("" : "+v"(t_)); F.tid = t_; F.lane = t_ & 63; F.wave = __builtin_amdgcn_readfirstlane(t_ >> 6); }
    for (int it = F.bid; it < 1024; it += F.G) scan_item<true>(F, (it & 7) + 8 * (it >> 8), (it >> 3) & 31);
}

__device__ __forceinline__ void unpack8(const u32x4 w, float (&f)[8]) { f[0] = bflo(w.x); f[1] = bfhi(w.x); f[2] = bflo(w.y); f[3] = bfhi(w.y); f[4] = bflo(w.z); f[5] = bfhi(w.z); f[6] = bflo(w.w); f[7] = bfhi(w.w); }
__device__ __forceinline__ void p5_merge(Frame& F) {
    const int gw = F.bid * NWAVES + F.wave, NGW = F.G * NWAVES, lane = F.lane;
    const float* gg = F.in[I_GGLA] + 16 * lane;
    for (int row = gw; row < MPAD; row += NGW) {
        if (row >= MREAL) {
#pragma unroll
            for (int j = 0; j < 8; ++j) *(u32x4*)((unsigned char*)F.H + pg8::img_off(row, 512 * j + 8 * lane, D / 64, false)) = (u32x4){0u, 0u, 0u, 0u};
            continue; }
        const bf16* pr = F.PROJ + (size_t)row * NP_IN;
#pragma unroll 2
        for (int hd = 0; hd < 4; ++hd) {
            const int c = hd * 1024 + 16 * lane;
            const u32x4 wo0 = *(const u32x4*)(pr + C_VA + c), wo1 = *(const u32x4*)(pr + C_VA + c + 8);
            const u32x4 wg0 = *(const u32x4*)(pr + C_GA + c), wg1 = *(const u32x4*)(pr + C_GA + c + 8);
            const u32x4 wb0 = *(const u32x4*)(pr + C_ZB + c), wb1 = *(const u32x4*)(pr + C_ZB + c + 8);
            const u32x4 wq0 = *(const u32x4*)(pr + C_QB + c), wq1 = *(const u32x4*)(pr + C_QB + c + 8);
            float o[16], ga[16], zb[16], ob[16];
#define UP16(dst, w0, w1) { float t[8]; unpack8(w0, t); _Pragma("unroll") for (int x = 0; x < 8; ++x) dst[x] = t[x]; unpack8(w1, t); _Pragma("unroll") for (int x = 0; x < 8; ++x) dst[8 + x] = t[x]; }
            UP16(o, wo0, wo1)
            float ss = 0.f;
#pragma unroll
            for (int x = 0; x < 16; ++x) ss += o[x] * o[x];
            const float r = 1.0f / sqrtf(wave_sum(ss) * (1.f / 1024.f) + NORM_EPS);
            UP16(ga, wg0, wg1) UP16(zb, wb0, wb1) UP16(ob, wq0, wq1)
#undef UP16
            float mg[16];
#pragma unroll
            for (int x = 0; x < 16; ++x) mg[x] = (o[x] * r * gg[x]) * ga[x] + zb[x] * ob[x];
            u32x4 w0, w1; w0.x = cvtpk(mg[0], mg[1]); w0.y = cvtpk(mg[2], mg[3]); w0.z = cvtpk(mg[4], mg[5]); w0.w = cvtpk(mg[6], mg[7]);
            w1.x = cvtpk(mg[8], mg[9]); w1.y = cvtpk(mg[10], mg[11]); w1.z = cvtpk(mg[12], mg[13]); w1.w = cvtpk(mg[14], mg[15]);
            *(u32x4*)((unsigned char*)F.H + pg8::img_off(row, c, D / 64, false)) = w0; *(u32x4*)((unsigned char*)F.H + pg8::img_off(row, c + 8, D / 64, false)) = w1;
        }
    }
}

template <int MODE> struct EpiRes {
    static constexpr bool PERM = true;
    const float* srcf; const bf16* srcb; float* outf; bf16* outb; const float* mod; int off_gt;
    __device__ __forceinline__ void operator()(const f32x4 (&acc)[2][2][4][2], const pg8::Unit& u, int wr, int wc, int fr, int fq) const {
        const int col0 = u.pn * 256 + wc * 32 + 8 * fq;
        const float* gt = mod + (size_t)(u.pm >> 5) * NMOD + off_gt + col0;
        f32x4 g[2][2];
#pragma unroll
        for (int bj = 0; bj < 2; ++bj)
#pragma unroll
            for (int n = 0; n < 2; ++n) g[bj][n] = *(const f32x4*)(gt + bj * 128 + n * 4);
#pragma unroll
        for (int ai = 0; ai < 2; ++ai) {
            const size_t rbase = (size_t)(u.pm * 256 + ai * 128 + wr * 64 + fr) * D + col0;
            if (MODE == 0) {
                f32x4 x[4][2][2];
#pragma unroll
                for (int m = 0; m < 4; ++m)
#pragma unroll
                    for (int bj = 0; bj < 2; ++bj)
#pragma unroll
                        for (int n = 0; n < 2; ++n) x[m][bj][n] = *(const f32x4*)(srcf + rbase + (size_t)(m * 16) * D + bj * 128 + n * 4);
#pragma unroll
                for (int m = 0; m < 4; ++m)
#pragma unroll
                    for (int bj = 0; bj < 2; ++bj) { const f32x4 a = x[m][bj][0] + g[bj][0] * acc[ai][bj][m][0], b = x[m][bj][1] + g[bj][1] * acc[ai][bj][m][1];
                        u32x4 w; w.x = cvtpk(a.x, a.y); w.y = cvtpk(a.z, a.w); w.z = cvtpk(b.x, b.y); w.w = cvtpk(b.z, b.w);
                        *(u32x4*)(outb + rbase + (size_t)(m * 16) * D + bj * 128) = w; }
            } else {
                u32x4 x[4][2];
#pragma unroll
                for (int m = 0; m < 4; ++m)
#pragma unroll
                    for (int bj = 0; bj < 2; ++bj) x[m][bj] = *(const u32x4*)(srcb + rbase + (size_t)(m * 16) * D + bj * 128);
#pragma unroll
                for (int m = 0; m < 4; ++m)
#pragma unroll
                    for (int bj = 0; bj < 2; ++bj) { const u32x4 w = x[m][bj];
                        const f32x4 xa = (f32x4){bflo(w.x), bfhi(w.x), bflo(w.y), bfhi(w.y)}, xb = (f32x4){bflo(w.z), bfhi(w.z), bflo(w.w), bfhi(w.w)};
                        const f32x4 a = xa + g[bj][0] * acc[ai][bj][m][0], b = xb + g[bj][1] * acc[ai][bj][m][1];
                        u32x4 o; o.x = cvtpk(a.x, a.y); o.y = cvtpk(a.z, a.w); o.z = cvtpk(b.x, b.y); o.w = cvtpk(b.z, b.w);
                        *(u32x4*)(outb + rbase + (size_t)(m * 16) * D + bj * 128) = o; }
            }
        }
    }
};
template <int K, int MODE, bool BIMG, bool AIMG>
__device__ __forceinline__ void skinny_res(Frame& F, const bf16* A, const bf16* Bt, const float* srcf, const bf16* srcb, float* dstf, bf16* dstb, int off_gt) {
    const int lane = F.lane, wv = F.wave, fr = lane & 15, fq = lane >> 4;
    for (int nb = F.bid; nb < D / 16; nb += F.G) {
        const bf16* ap = A + (size_t)(MP + 16 * wv + fr) * K + 8 * fq;
        const int nrow = 16 * nb + fr;
        int sl = nrow & 127; { const int m = sl & 31; sl = (sl & ~31) + 16 * ((m >> 2) & 1) + 4 * (m >> 3) + (m & 3); }
        const unsigned char* bimg = (const unsigned char*)Bt + (size_t)(nrow >> 7) * (K / 64) * (size_t)pg8::HTB;
        const int oc0 = pg8::lds_byte(sl, 8 * fq), oc1 = pg8::lds_byte(sl, 32 + 8 * fq);
        const bf16* bp = Bt + (size_t)nrow * K + 8 * fq;
        const int arow = MP + 16 * wv + fr;
        const unsigned char* aimg = (const unsigned char*)A + (size_t)(arow >> 7) * (K / 64) * (size_t)pg8::HTB;
        const int ac0 = pg8::lds_byte(arow & 127, 8 * fq), ac1 = pg8::lds_byte(arow & 127, 32 + 8 * fq);
#define SK_ALOAD(kk, u) (AIMG ? *(const bf16x8*)(aimg + (size_t)(((kk) >> 6) + ((u) >> 1)) * pg8::HTB + (((u) & 1) ? ac1 : ac0)) : *(const bf16x8*)(ap + (kk) + 32 * (u)))
#define SK_BLOAD(kk, u) (BIMG ? *(const bf16x8*)(bimg + (size_t)(((kk) >> 6) + ((u) >> 1)) * pg8::HTB + (((u) & 1) ? oc1 : oc0)) : *(const bf16x8*)(bp + (kk) + 32 * (u)))
        f32x4 acc0 = (f32x4){0.f, 0.f, 0.f, 0.f}, acc1 = acc0;
        bf16x8 a[8], b[8], a2[8], b2[8];
#pragma unroll
        for (int u = 0; u < 8; ++u) { a[u] = SK_ALOAD(0, u); b[u] = SK_BLOAD(0, u); }
#pragma unroll 1
        for (int k = 0; k < K; k += 512) {
            const int k1 = k + 256 < K ? k + 256 : k, k2 = k + 512 < K ? k + 512 : k1;
#pragma unroll
            for (int u = 0; u < 8; ++u) { a2[u] = SK_ALOAD(k1, u); b2[u] = SK_BLOAD(k1, u); }
#pragma unroll
            for (int u = 0; u < 8; u += 2) { acc0 = __builtin_amdgcn_mfma_f32_16x16x32_bf16(b[u], a[u], acc0, 0, 0, 0); acc1 = __builtin_amdgcn_mfma_f32_16x16x32_bf16(b[u + 1], a[u + 1], acc1, 0, 0, 0); }
#pragma unroll
            for (int u = 0; u < 8; ++u) { a[u] = SK_ALOAD(k2, u); b[u] = SK_BLOAD(k2, u); }
            if (k + 256 < K) {
#pragma unroll
                for (int u = 0; u < 8; u += 2) { acc0 = __builtin_amdgcn_mfma_f32_16x16x32_bf16(b2[u], a2[u], acc0, 0, 0, 0); acc1 = __builtin_amdgcn_mfma_f32_16x16x32_bf16(b2[u + 1], a2[u + 1], acc1, 0, 0, 0); } }
        }
        const int row = MP + 16 * wv + fr, col = 16 * nb + 4 * fq;
        const f32x4 g = *(const f32x4*)(F.MOD + (size_t)row_batch(row) * NMOD + off_gt + col), r = g * (acc0 + acc1);
        if (MODE == 0) { const f32x4 x = *(const f32x4*)(srcf + (size_t)(row - MP) * D + col) + r; u32x2 w; w.x = cvtpk(x.x, x.y); w.y = cvtpk(x.z, x.w); *(u32x2*)(dstb + (size_t)row * D + col) = w; }
        else { const u32x2 w = *(const u32x2*)(srcb + (size_t)row * D + col); const f32x4 x = (f32x4){bflo(w.x), bfhi(w.x), bflo(w.y), bfhi(w.y)} + r;
            u32x2 o; o.x = cvtpk(x.x, x.y); o.y = cvtpk(x.z, x.w); *(u32x2*)(dstb + (size_t)row * D + col) = o; }
    }
}

struct EpiGU {
    static constexpr bool PERM = true;
    bf16* ACT;
    __device__ __forceinline__ void operator()(const f32x4 (&acc)[2][2][4][2], const pg8::Unit& u, int wr, int wc, int fr, int fq) const {
#pragma unroll
        for (int ai = 0; ai < 2; ++ai)
#pragma unroll
            for (int m = 0; m < 4; ++m) {
                const int row = u.pm * 256 + ai * 128 + wr * 64 + m * 16 + fr;
                const f32x4 g0 = acc[ai][0][m][0], g1 = acc[ai][0][m][1], u0 = acc[ai][1][m][0], u1 = acc[ai][1][m][1];
                float a[8];
#pragma unroll
                for (int x = 0; x < 4; ++x) { a[x] = g0[x] * sigmoidf_(g0[x]) * u0[x]; a[4 + x] = g1[x] * sigmoidf_(g1[x]) * u1[x]; }
                u32x4 w; w.x = cvtpk(a[0], a[1]); w.y = cvtpk(a[2], a[3]); w.z = cvtpk(a[4], a[5]); w.w = cvtpk(a[6], a[7]);
                *(u32x4*)((unsigned char*)ACT + pg8::img_off(row, u.pn * 128 + wc * 32 + 8 * fq, DFF / 64, false)) = w;
            }
    }
};
__device__ __forceinline__ void p10_final(Frame& F, const bf16* X2B) {
    const int gw = F.bid * NWAVES + F.wave, NGW = F.G * NWAVES;
    for (int row = gw; row < MREAL; row += NGW) {
        const GAS u32x2* xr = (const GAS u32x2*)(X2B + (size_t)row * D) + F.lane;
        GAS f32x4* yr = (GAS f32x4*)(F.out + (size_t)row * D) + F.lane;
        f32x4 v[16]; float s = 0.f;
#pragma unroll
        for (int j = 0; j < 16; ++j) { const u32x2 w = xr[64 * j]; v[j] = (f32x4){bflo(w.x), bfhi(w.x), bflo(w.y), bfhi(w.y)}; s += (v[j].x * v[j].x + v[j].y * v[j].y) + (v[j].z * v[j].z + v[j].w * v[j].w); }
        const float r = 1.0f / sqrtf(wave_sum(s) * (1.f / D) + NORM_EPS);
#pragma unroll
        for (int j = 0; j < 16; ++j) { const f32x4 gg = *(const f32x4*)(F.in[I_GF] + 256 * j + 4 * F.lane); yr[64 * j] = (v[j] * r) * gg; }
    }
}

#if DBG_CHECK
__device__ __forceinline__ unsigned hash32(unsigned x) { x ^= x >> 16; x *= 0x7feb352du; x ^= x >> 15; x *= 0x846ca68bu; x ^= x >> 16; return x; }
__device__ __forceinline__ void dbg_report(Frame& F, int k, float e) { if (!(e == e) || e > 1e30f) e = 1e30f; atomicMax((unsigned*)F.DBG + k, __float_as_uint(e)); }
__device__ __forceinline__ float relerr(float got, float ref, float floor_) { return fabsf(got - ref) / (fabsf(ref) + floor_); }
__device__ __forceinline__ int win_fwd(int c) {
    if (c < 12288) return c;
    if (c < 12304) return 25600 + (c - 12288);
    if (c < 16912) { const bool isq = c < 16400; const int r = c - (isq ? 12304 : 16400), hh = r >> 6, d = r & 63;
        const int t = (d & 31) >> 2, e = (d & 3) + 4 * (d >> 5); return (isq ? 12288 : 16384) + 64 * hh + 8 * t + e; }
    return c - 16;
}
__device__ __forceinline__ int win_fwd_w(int c) {
    if (c >= 8192 && c < 12288) { const int i = c - 8192, ct = i >> 7; return (ct < 16 ? 8192 + 256 * ct : 17408 + 256 * (ct - 16)) + (i & 127); }
    if (c >= 17424 && c < 21520) { const int i = c - 17424, ct = i >> 7; return (ct < 16 ? 8192 + 256 * ct : 17408 + 256 * (ct - 16)) + 128 + (i & 127); }
    return win_fwd(c);
}
__device__ __forceinline__ int wgu_fwd(int c) { if (c < DFF) return 256 * (c >> 7) + (c & 127); const int c2 = c - DFF; return 256 * (c2 >> 7) + 128 + (c2 & 127); }
__device__ __forceinline__ float silu_ref(float x) { return x / (1.f + expf(-x)); }
__device__ __forceinline__ float cvec(const Frame& F, int b, int k) { return b < 2 ? F.in[I_CP][b * D + k] : F.in[I_CS][(b - 2) * D + k]; }
__device__ __forceinline__ float bfround(float x) { return bflo(cvtpk(x, 0.f)); }
__device__ __forceinline__ float dbg_h(const Frame& F, int row, int k) { return bf2f(*(const bf16*)((const unsigned char*)F.H + pg8::img_off(row, k & ~7, D / 64, false) + 2 * (k & 7))); }

__device__ __forceinline__ void dbg_check_p0p1(Frame& F) {
    const int gt = F.bid * NTHR + F.tid;
    if (gt < 512) {
        const unsigned h = hash32(gt * 7919u + 13u); const int b = gt % 10, col = (int)(h % NMOD);
        float s = 0.f; for (int k = 0; k < D; ++k) s += silu_ref(cvec(F, b, k)) * F.in[I_WADA][(size_t)k * NMOD + col];
        s += F.in[I_BADA][col];
        dbg_report(F, 0, relerr(F.MOD[b * NMOD + col], s, 0.05f));
    } else if (gt < 1024) {
        const unsigned h = hash32(gt * 31u + 5u); const int pos = (int)(h % 8192u), f = (int)((h >> 16) % 32u);
        const double inv = pow(10000.0, -(double)f / 32.0), a = (double)pos * inv;
        dbg_report(F, 1, fmaxf(fabsf(F.ROPEC[pos * 32 + f] - (float)cos(a)), fabsf(F.ROPES[pos * 32 + f] - (float)sin(a))) * 0.2f);
    } else if (gt < 1024 + 4096) {
        const int i = gt - 1024; const unsigned h = hash32(i * 2654435761u + 77u), h2 = hash32(h + 12345u);
        const int which = 0; float ref, got;
        if (which == 0) { const int k = (int)(h % D), c = (int)(h2 % N_IN); ref = bfround(F.in[I_WIN][(size_t)k * N_IN + c]); got = bf2f(*(const bf16*)((const unsigned char*)F.WIN + pg8::img_off(win_fwd_w(c), k & ~7, D / 64, true) + 2 * (k & 7))); }
        else if (which == 1) { const int k = (int)(h % D), c = (int)(h2 % D); ref = bfround(F.in[I_WOUT][(size_t)k * D + c]); got = bf2f(*(const bf16*)((const unsigned char*)F.WOUT + pg8::img_off(c, k & ~7, D / 64, true) + 2 * (k & 7))); }
        else if (which == 2) { const int k = (int)(h % D), c = (int)(h2 % N_GU); ref = bfround(F.in[I_WGU][(size_t)k * N_GU + c]); got = bf2f(*(const bf16*)((const unsigned char*)F.WGU + pg8::img_off(wgu_fwd(c), k & ~7, D / 64, true) + 2 * (k & 7))); }
        else { const int k = (int)(h % DFF), c = (int)(h2 % D); ref = bfround(F.in[I_WDN][(size_t)k * D + c]); got = bf2f(*(const bf16*)((const unsigned char*)F.WDN + pg8::img_off(c, k & ~7, DFF / 64, true) + 2 * (k & 7))); }
        dbg_report(F, 2, fabsf(got - ref) * 100.f);
        if (i < 240) { const int k = (int)(h % D); dbg_report(F, 2, fabsf(bf2f(*(const bf16*)((const unsigned char*)F.WIN + pg8::img_off(25616 + i, k & ~7, D / 64, true) + 2 * (k & 7)))) * 100.f); }
    } else if (gt < 1024 + 4096 + 96) {
        const int i = gt - 5120; const unsigned h = hash32(i * 977u + 3u);
        const int row = i < 64 ? (int)(h % MP) : (i < 88 ? MP + (int)(h % MS) : MREAL + (int)(h % 128u));
        if (row >= MREAL) { float m = 0.f; for (int c = 0; c < D; ++c) m = fmaxf(m, fabsf(dbg_h(F, row, c))); dbg_report(F, 3, m); }
        else { const float* x = x_row(F, row); float s = 0.f; for (int c = 0; c < D; ++c) s += x[c] * x[c];
            const float r = 1.f / sqrtf(s / D + NORM_EPS); const float* mod = F.MOD + row_batch(row) * NMOD; float e = 0.f;
            for (int c = 0; c < D; ++c) { const float y = x[c] * r * F.in[I_G1][c] * (1.f + mod[D + c]) + mod[c]; e = fmaxf(e, relerr(dbg_h(F, row, c), y, 0.2f)); }
            dbg_report(F, 3, e); }
    }
}
__device__ __forceinline__ float dbg_dot_h_win(Frame& F, int row, int c) { float s = 0.f; const float* w = F.in[I_WIN] + c; for (int k = 0; k < D; ++k) s += dbg_h(F, row, k) * w[(size_t)k * N_IN]; return s; }
__device__ __forceinline__ void dbg_check_p2(Frame& F) {
    const int gt = F.bid * NTHR + F.tid;
    if (gt >= 2048) return;
    const unsigned h = hash32(gt * 2246822519u + 99u), h2 = hash32(h ^ 0x9e3779b9u);
    int row = (gt & 7) == 7 ? MP + (int)(h % MS) : (int)(h % MP);
    int c;
    const int cls = gt % 5;
    if (cls == 0) c = (int)(h2 % N_IN); else if (cls == 1) c = O_QB + (int)(h2 % 4096u); else if (cls == 2) c = O_KB + (int)(h2 % 512u); else if (cls == 3) c = O_VB + (int)(h2 % 512u); else c = O_RA + (int)(h2 % 16u);
    if (gt >= 1024) {
        if (cls != 2 && cls != 3) return;
        if (gt & 8) { const int b = (h >> 3) & 1, tt = 8064 + (int)((h >> 8) % 128u); row = b * 8192 + tt; } else row = MP + (int)(h % MS);
    }
    const bool isq = c >= O_QB && c < O_KB, isk = c >= O_KB && c < O_VB, isv = c >= O_VB && c < O_VB + 512;
    float ref;
    if (isq || isk) { const int base = isq ? O_QB : O_KB, r = c - base, hh = r >> 6, d = r & 63, dl = d & 31;
        const float x1 = dbg_dot_h_win(F, row, base + 64 * hh + dl), x2 = dbg_dot_h_win(F, row, base + 64 * hh + dl + 32);
        const double inv = pow(10000.0, -(double)dl / 32.0), a = (double)row_pos(row) * inv; const float cs = (float)cos(a), sn = (float)sin(a);
        ref = d < 32 ? x1 * cs - x2 * sn : x2 * cs + x1 * sn; }
    else ref = dbg_dot_h_win(F, row, c);
    if (gt < 1024) {
        int pc = win_fwd(c);
        if ((c >= 8192 && c < 12288) || (c >= 17424 && c < 21520)) { const int i = c >= 17424 ? c - 17424 : c - 8192; const float gv = dbg_dot_h_win(F, row, 8192 + i), zv = dbg_dot_h_win(F, row, 17424 + i);
            ref = silu_ref(gv) / (1.f + expf(-zv)); pc = C_GA + i; }
        else if (c >= 21520) ref = 1.f / (1.f + expf(-ref));
        const float got = bf2f(F.PROJ[(size_t)row * NP_IN + pc]); dbg_report(F, 4, relerr(got, isq ? ref * QSCALE : ref, 1.0f)); }
    else { const int r = c - (isk ? O_KB : O_VB), g = r >> 6, d = r & 63; long o;
        if (row < MP) o = (isk ? OUT_KP : OUT_VP) + ((long)(((row >> 13) * 128 + ((row & 8191) - 8064)) * 8 + g)) * 64 + d;
        else { const int r2 = row - MP; o = (isk ? OUT_KS : OUT_VS) + ((long)(((r2 >> 4) * 16 + (r2 & 15)) * 8 + g)) * 64 + d; }
        dbg_report(F, 5, relerr(F.out[o], ref, 1.0f)); }
}
__device__ __forceinline__ float logsig_ref(float x) { return x < 0.f ? x - log1pf(expf(x)) : -log1pf(expf(-x)); }
__device__ __forceinline__ float dbg_bcum(Frame& F, int row0, int ntok, int hd, int d, int upto) {
    float bc = 0.f; const float bias = F.in[I_BGK][hd * 512 + d];
    for (int t = 0; t <= upto && t < ntok; ++t) { float gk = bias; const bf16* ra = F.PROJ + (size_t)(row0 + t) * NP_IN + C_RA;
        for (int r = 0; r < 16; ++r) gk += bf2f(ra[r]) * F.in[I_WGK][r * 2048 + hd * 512 + d];
        bc += logsig_ref(gk) * (1.f / 16.f); }
    return bc;
}
__device__ __forceinline__ float dbg_qfrag(Frame& F, int cid, int hd, int i, int d) { const int w = d >> 6, dl = d & 63, dt = dl >> 5, r32 = dl & 31, s = r32 >> 4, r16 = r32 & 15, h = (r16 >> 2) & 1, jj = (r16 & 3) + 4 * (r16 >> 3);
    const int mt = i >> 5, ln = (i & 31) + 32 * h, fb = ((w * 2 + mt) * 2 + dt) * 2 + s; return bf2f(((const bf16*)(F.ws + WS_FRAG + (size_t)(cid * 4 + hd) * 131072))[fb * 512 + ln * 8 + jj]); }
__device__ __forceinline__ float dbg_kfrag(Frame& F, int cid, int hd, int j, int d) { const int w = d >> 6, dt = (d >> 5) & 1, dl = d & 31, sp = j >> 4, h = (j >> 3) & 1, jj = j & 7;
    const int ln = dl + 32 * h, fb = (w * 2 + dt) * 4 + sp; return bf2f(((const bf16*)(F.ws + WS_FRAG + (size_t)(cid * 4 + hd) * 131072 + 65536))[fb * 512 + ln * 8 + jj]); }
__device__ __forceinline__ float dbg_afrag(Frame& F, int cid, int hd, int i, int j) { const int it = i >> 5, jt = j >> 5, jl = j & 31, s = jl >> 4, r16 = jl & 15, h = (r16 >> 2) & 1, jj = (r16 & 3) + 4 * (r16 >> 3);
    const int blk = it + 2 * (2 * jt + s), ln = (i & 31) + 32 * h; return bf2f(((const bf16*)(F.ws + WS_AMAT + (size_t)(cid * 4 + hd) * 8192))[blk * 512 + ln * 8 + jj]); }
__device__ __forceinline__ void dbg_check_cl(Frame& F) {
    const int gt = F.bid * NTHR + F.tid;
    if (gt >= 2048) return;
    const unsigned hs = hash32(gt * 40503u + 17u), h2 = hash32(hs + 0x51ed27u);
    const int cid = (gt & 7) == 7 ? 256 + (int)(hs % 8u) : (int)(hs % 256u), hd = (int)((hs >> 8) & 3u);
    const int ntok = cid < 256 ? 64 : 16, row0 = cid < 256 ? cid * 64 : MP + 16 * (cid - 256), mid = ntok >> 1;
    const int i = (int)((hs >> 10) % (unsigned)ntok), j = (int)((h2) % (unsigned)ntok), d = (int)((h2 >> 8) % 512u);
    if (gt >= 256) {
        const float bi = dbg_bcum(F, row0, ntok, hd, d, i), bj = dbg_bcum(F, row0, ntok, hd, d, j), bm = dbg_bcum(F, row0, ntok, hd, d, mid), bl = dbg_bcum(F, row0, ntok, hd, d, 63);
        const float q = bf2f(F.PROJ[(size_t)(row0 + i) * NP_IN + C_QA + hd * 512 + d]), k = bf2f(F.PROJ[(size_t)(row0 + j) * NP_IN + C_KA + hd * 512 + d]);
        dbg_report(F, 6, relerr(dbg_qfrag(F, cid, hd, i, d), q * GLA_QSCALE * expf(bi - bm), 0.02f));
        dbg_report(F, 6, relerr(dbg_kfrag(F, cid, hd, j, d), k * expf(bm - bj), 0.3f));
        const float* VEC = (const float*)(F.ws + WS_VEC) + (size_t)(cid * 4 + hd) * 1024;
        dbg_report(F, 6, relerr(VEC[d], expf(bm), 0.01f)); dbg_report(F, 6, relerr(VEC[512 + d], expf(bl - bm), 0.01f));
        if (cid >= 256) { dbg_report(F, 6, fabsf(dbg_qfrag(F, cid, hd, 16 + (i % 48), d))); dbg_report(F, 6, fabsf(dbg_kfrag(F, cid, hd, 16 + (j % 48), d))); }
    } else {
        float s = 0.f;
        for (int dd = 0; dd < 512; ++dd) { float bi = 0.f, bj = 0.f, bm = 0.f, bc = 0.f; const float bias = F.in[I_BGK][hd * 512 + dd];
            for (int t = 0; t < ntok; ++t) { float gk = bias; const bf16* ra = F.PROJ + (size_t)(row0 + t) * NP_IN + C_RA;
                for (int r = 0; r < 16; ++r) gk += bf2f(ra[r]) * F.in[I_WGK][r * 2048 + hd * 512 + dd];
                bc += logsig_ref(gk) * (1.f / 16.f); if (t == i) bi = bc; if (t == j) bj = bc; if (t == mid) bm = bc; }
            const float q = bf2f(F.PROJ[(size_t)(row0 + i) * NP_IN + C_QA + hd * 512 + dd]), k = bf2f(F.PROJ[(size_t)(row0 + j) * NP_IN + C_KA + hd * 512 + dd]);
            s += bfround(q * GLA_QSCALE * expf(bi - bm)) * bfround(k * expf(bm - bj)); }
        if (j > i) s = 0.f;
        dbg_report(F, 6, relerr(dbg_afrag(F, cid, hd, i, j), s, 0.1f));
    }
}
__device__ __forceinline__ void dbg_check_swa(Frame& F) {
    LAS float* part = (LAS float*)F.lds;
    LAS float* qh = part + 512;
    LAS float* lg = qh + 64;
    LAS float* sm = lg + 192;
    const int tid = F.tid; const unsigned hs = hash32(F.bid * 7349u + 1234567u);
    const bool smp = (F.bid & 3) == 3;
    int row, b, tt;
    if (!smp) { b = hs & 1; tt = (F.bid & 7) == 0 ? (int)((hs >> 4) % 128u) : (int)((hs >> 4) % 8192u); row = b * SEQ + tt; } else { b = (hs >> 1) & 7; tt = (hs >> 4) & 15; row = MP + 16 * b + tt; }
    const int head = (int)((hs >> 20) & 63u), g = head >> 3;
    { const int d = tid >> 3, pt = tid & 7; float s = 0.f; const float* w = F.in[I_WIN] + O_QB + head * 64 + d;
      for (int k = 512 * pt; k < 512 * pt + 512; ++k) s += dbg_h(F, row, k) * w[(size_t)k * N_IN];
      part[d * 8 + pt] = s; }
    __syncthreads();
    float xq = 0.f; if (tid < 64) { for (int p = 0; p < 8; ++p) xq += part[tid * 8 + p]; }
    __syncthreads();
    if (tid < 64) part[tid] = xq;
    __syncthreads();
    if (tid < 64) { const int dl = tid & 31; const double inv = pow(10000.0, -(double)dl / 32.0), a = (double)row_pos(row) * inv; const float cs = (float)cos(a), sn = (float)sin(a);
        const float x1 = part[dl], x2 = part[dl + 32]; qh[tid] = (tid < 32 ? x1 * cs - x2 * sn : x2 * cs + x1 * sn) * QSCALE; }
    __syncthreads();
    int nk, kr0 = 0;
    if (!smp) { const int n = tt >> 6; nk = 64 * (n + 1 < 3 ? n + 1 : 3); kr0 = b * SEQ + 64 * (n > 2 ? n - 2 : 0); } else nk = 144;
    if (tid < nk) { float s = 0.f;
        for (int d = 0; d < 64; ++d) { float kv;
            if (smp && tid < 128) kv = bfround(F.in[I_CK][((size_t)(b * 128 + tid) * 8 + g) * 64 + d]);
            else { const int krow = smp ? MP + 16 * b + (tid - 128) : kr0 + tid; const int p = 8 * ((d & 31) >> 2) + (d & 3) + 4 * (d >> 5); kv = bf2f(F.PROJ[(size_t)krow * NP_IN + C_KB + g * 64 + p]); }
            s += qh[d] * kv; }
        lg[tid] = s; }
    __syncthreads();
    if (tid == 0) { const float sk = F.in[I_SINK][head] * LOG2E; float m = sk; for (int k = 0; k < nk; ++k) m = fmaxf(m, lg[k]); float su = exp2f(sk - m); for (int k = 0; k < nk; ++k) su += exp2f(lg[k] - m); sm[0] = m; sm[1] = su; }
    __syncthreads();
    if (tid < 64) { float o = 0.f; const float m = sm[0];
        for (int k = 0; k < nk; ++k) { float vv;
            if (smp && k < 128) vv = bfround(F.in[I_CV][((size_t)(b * 128 + k) * 8 + g) * 64 + tid]);
            else { const int krow = smp ? MP + 16 * b + (k - 128) : kr0 + k; vv = bf2f(F.PROJ[(size_t)krow * NP_IN + C_VB + g * 64 + tid]); }
            o += exp2f(lg[k] - m) * vv; }
        o /= sm[1];
        dbg_report(F, 7, relerr(bf2f(F.PROJ[(size_t)row * NP_IN + C_QB + head * 64 + tid]), o, 0.3f)); }
    __syncthreads();
}
constexpr size_t WS_DBGV = 1596 * MiB;
__device__ __forceinline__ void dbg_check_scan(Frame& F) {
    LAS float* red = (LAS float*)F.lds;
    const int tid = F.tid; const unsigned hs = hash32(F.bid * 92821u + 777u);
    const bool smp = (F.bid & 1) == 1;
    const int b = smp ? (int)((hs >> 2) & 7u) : (int)((hs >> 2) & 1u), hd = (int)((hs >> 6) & 3u), e = (int)((hs >> 8) & 1023u);
    const int T = smp ? 16 : SEQ, row00 = smp ? MP + 16 * b : b * SEQ;
    float* vcol = (float*)(F.ws + WS_DBGV) + (size_t)F.bid * SEQ;
    for (int t = tid; t < T; t += NTHR) { float s = 0.f; const float* w = F.in[I_WIN] + C_VA + hd * 1024 + e;
        for (int k = 0; k < D; ++k) s += dbg_h(F, row00 + t, k) * w[(size_t)k * N_IN];
        vcol[t] = s; }
    __syncthreads();
    const int d = tid; float wg[16];
#pragma unroll
    for (int r = 0; r < 16; ++r) wg[r] = F.in[I_WGK][r * 2048 + hd * 512 + d];
    const float bias = F.in[I_BGK][hd * 512 + d];
    float S = smp ? F.in[I_SG][((size_t)(b * 4 + hd) * 512 + d) * 1024 + e] : 0.f;
    for (int t = 0; t < T; ++t) {
        const int row = row00 + t; const bf16* pr = F.PROJ + (size_t)row * NP_IN;
        const u32x4 ra0 = *(const u32x4*)(pr + C_RA), ra1 = *(const u32x4*)(pr + C_RA + 8);
        float gk = bias + bflo(ra0.x) * wg[0] + bfhi(ra0.x) * wg[1] + bflo(ra0.y) * wg[2] + bfhi(ra0.y) * wg[3] + bflo(ra0.z) * wg[4] + bfhi(ra0.z) * wg[5] + bflo(ra0.w) * wg[6] + bfhi(ra0.w) * wg[7]
                 + bflo(ra1.x) * wg[8] + bfhi(ra1.x) * wg[9] + bflo(ra1.y) * wg[10] + bfhi(ra1.y) * wg[11] + bflo(ra1.z) * wg[12] + bfhi(ra1.z) * wg[13] + bflo(ra1.w) * wg[14] + bfhi(ra1.w) * wg[15];
        const float a = expf(logsig_ref(gk) * (1.f / 16.f));
        S = a * S + bf2f(pr[C_KA + hd * 512 + d]) * vcol[t];
        const bool chk = smp || t < 2 || t == 31 || t == 63 || t == 64 || t == 65 || t == 127 || t == 128 || t == 1000 || t == 4095 || t == 8191;
        if (chk) { red[tid] = bf2f(pr[C_QA + hd * 512 + d]) * GLA_QSCALE * S; __syncthreads();
            if (tid == 0) { float o = 0.f; for (int x = 0; x < 512; ++x) o += red[x]; const float got = bf2f(pr[C_VA + hd * 1024 + e]); dbg_report(F, 8, relerr(got, o, 5.0f)); atomicAdd(F.DBG + 32, (got - o) * (got - o)); atomicAdd(F.DBG + 33, o * o); }
            __syncthreads(); }
    }
    { const float got = F.out[(smp ? OUT_SGS : OUT_SGP) + ((size_t)(b * 4 + hd) * 512 + d) * 1024 + e]; dbg_report(F, 8, relerr(got, S, 5.0f));
      const float se = wave_sum((got - S) * (got - S)), sr = wave_sum(S * S); if (F.lane == 0) { atomicAdd(F.DBG + 34, se); atomicAdd(F.DBG + 35, sr); } }
}

constexpr int DBG_NCHECK = 11;
__device__ __forceinline__ void dbg_final(Frame& F) {
    if (F.bid != 0 || F.tid != 0) return;
    const float tol[DBG_NCHECK] = {2e-3f, 1e-3f, 1e-3f, 1e-2f, 3e-2f, 3e-2f, 2e-2f, 3e-2f, 3e-2f, 1e-2f, 1e-2f};
    for (int k = 0; k < DBG_NCHECK; ++k) { float e = __uint_as_float(__hip_atomic_load((unsigned*)F.DBG + k, RLX_AGENT));
        if (k == 9) e = sqrtf(F.DBG[32] / F.DBG[33]); if (k == 10) e = sqrtf(F.DBG[34] / F.DBG[35]);
        if (!(e <= tol[k])) { const int m = e >= 1.f ? 9 : e >= 0.3f ? 8 : e >= 0.1f ? 7 : e >= 0.03f ? 6 : e >= 0.01f ? 5 : e >= 0.003f ? 4 : e >= 0.001f ? 3 : e >= 3e-4f ? 2 : 1;
            float x = (1.f + 0.1f * m) * 1e4f; for (int j = 0; j < k; ++j) x *= 10.f; F.out[0] = x; return; } }
}
#endif

#define PHASE_BEGIN() do { int t_ = threadIdx.x; asm volatile("" : "+v"(t_)); F.tid = t_; F.lane = t_ & 63; F.wave = __builtin_amdgcn_readfirstlane(t_ >> 6); } while (0)
__global__ void __launch_bounds__(NTHR, 2) mega_fwd(Args args) {
    extern __shared__ __attribute__((aligned(16))) unsigned char lds[];
    Frame F;
    F.lds = (LAS unsigned char*)lds;
    F.MISC = (volatile LAS unsigned*)(F.lds + MISC_OFF);
    F.tid = threadIdx.x; F.lane = F.tid & 63; F.wave = __builtin_amdgcn_readfirstlane(F.tid >> 6);
    F.G = gridDim.x; F.bid = blockIdx.x;
    unsigned char* ws = args.ws; F.ws = ws; F.out = args.out;
#pragma unroll
    for (int i = 0; i < 20; ++i) F.in[i] = args.in[i];
    F.ctl = (gu32*)(ws + WS_CTL);
    F.MOD = (float*)(ws + WS_MOD); F.ROPEC = (float*)(ws + WS_ROPE); F.ROPES = (float*)(ws + WS_ROPE + MiB); F.SC = (float*)(ws + WS_SC); F.DBG = (float*)(ws + WS_DBG);
    F.WIN = (bf16*)(ws + WS_WIN); F.WOUT = (bf16*)(ws + WS_WOUT); F.WGU = (bf16*)(ws + WS_WGU); F.WDN = (bf16*)(ws + WS_WDN); F.H = (bf16*)(ws + WS_H); F.PROJ = (bf16*)(ws + WS_PROJ);
    for (int u = F.tid; u < 64; u += NTHR) ((LAS unsigned*)(F.lds + MISC_OFF))[u] = 0u;
    __syncthreads();
    XcdBarrier bar = xcd_barrier_post((unsigned*)(F.ctl + CW_BAR), F.MISC + 8);
    const int gtid = F.bid * NTHR + F.tid;

#if DBG_CHECK
    if (gtid < 64) F.DBG[gtid] = 0.f;
    xcd_barrier(bar);
#endif
    PHASE_BEGIN();
    p0_phase(F, CW_Q0);
#if PROBE_TWICE == 100
    xcd_barrier(bar); p0_phase(F, CW_Q0 + 64);
#endif
    xcd_barrier(bar);
    PHASE_BEGIN();
    norm_mod_rows<false>(F, F.in[I_XP], F.in[I_XS], nullptr, F.in[I_G1], 0, D, F.H);
#if PROBE_TWICE == 101
    xcd_barrier(bar); norm_mod_rows<false>(F, F.in[I_XP], F.in[I_XS], nullptr, F.in[I_G1], 0, D, F.H);
#endif
    xcd_barrier(bar);
#if DBG_CHECK
    dbg_check_p0p1(F);
#endif
    PHASE_BEGIN();
    { pg8::Gemm g{F.H, F.WIN, MPAD, NP_IN, D}; pg8::StaticOrder S; S.init(MPAD, NP_IN, F.G, F.bid);
      EpiIn E{F.PROJ, F.ROPEC, F.ROPES, F.out};
#if PROBE_TWICE == 110
      S.force0 = 1; pg8::gemm_phase<EpiIn, true, true>(F.lds, g, S, E); S.force0 = 0; xcd_barrier(bar);
#endif
      pg8::gemm_phase<EpiIn, true, true>(F.lds, g, S, E);
      drain_weights<0>(F);
#if PROBE_TWICE == 102
      xcd_barrier(bar); pg8::gemm_phase<EpiIn, true, true>(F.lds, g, S, E);
#endif
    }
    xcd_barrier(bar);
#if DBG_CHECK
    dbg_check_p2(F);
    xcd_barrier(bar);
#endif
    PHASE_BEGIN();
    p3_phase(F);
    xcd_barrier(bar);
#if DBG_CHECK
    dbg_check_cl(F);
    dbg_check_swa(F);
    xcd_barrier(bar);
#endif
    PHASE_BEGIN();
    p4_phase(F);
    xcd_barrier(bar);
#if DBG_CHECK
    dbg_check_scan(F);
    xcd_barrier(bar);
#endif
    PHASE_BEGIN();
    p5_merge(F);
#if PROBE_TWICE == 105
    xcd_barrier(bar); p5_merge(F);
#endif
    xcd_barrier(bar);
    PHASE_BEGIN();
    bf16* const X1B = (bf16*)(F.ws + WS_FRAG);
    { pg8::Gemm g{F.H, F.WOUT, MP, D, D}; pg8::StaticOrder S; S.init(MP, D, F.G, F.bid);
      EpiRes<0> E{F.in[I_XP], nullptr, nullptr, X1B, F.MOD, 2 * D};
      pg8::gemm_phase<EpiRes<0>, true, true>(F.lds, g, S, E); }
    skinny_res<D, 0, true, true>(F, F.H, F.WOUT, F.in[I_XS], nullptr, nullptr, X1B, 2 * D);
    xcd_barrier(bar);
    PHASE_BEGIN();
    norm_mod_rows<true>(F, nullptr, nullptr, X1B, F.in[I_G2], 3 * D, 4 * D, F.H);
#if PROBE_TWICE == 101
    xcd_barrier(bar); norm_mod_rows<true>(F, nullptr, nullptr, X1B, F.in[I_G2], 3 * D, 4 * D, F.H);
#endif
    xcd_barrier(bar);
    PHASE_BEGIN();
    { pg8::Gemm g{F.H, F.WGU, MPAD, N_GU, D}; pg8::StaticOrder S; S.init(MPAD, N_GU, F.G, F.bid);
      EpiGU E{F.PROJ};
      pg8::gemm_phase<EpiGU, true, true>(F.lds, g, S, E);
      drain_weights<1>(F); }
    xcd_barrier(bar);
    PHASE_BEGIN();
    { pg8::Gemm g{F.PROJ, F.WDN, MP, D, DFF}; pg8::StaticOrder S; S.init(MP, D, F.G, F.bid);
      EpiRes<1> E{nullptr, X1B, nullptr, X1B, F.MOD, 5 * D};
      pg8::gemm_phase<EpiRes<1>, true, true>(F.lds, g, S, E); }
    skinny_res<DFF, 1, true, true>(F, F.PROJ, F.WDN, nullptr, X1B, nullptr, X1B, 5 * D);
    xcd_barrier(bar);
    PHASE_BEGIN();
    p10_final(F, X1B);
#if DBG_CHECK
    xcd_barrier(bar);
    dbg_final(F);
#endif
}

extern "C" void kernel_launch(void* const* d_in, const int* in_sizes, int n_in, void* d_out, int out_size, void* d_ws, size_t ws_size, hipStream_t stream) {
    static int grid = 0;
    if (grid == 0) {
        int dev = 0, cus = 0, per_cu = 0;
        if (n_in != 20 || out_size != (int)OUT_TOTAL || ws_size < WS_END + 32 * MiB) { fprintf(stderr, "kernel_launch: unexpected sizes n_in %d out %d ws %zu (need %zu); nothing launched\n", n_in, out_size, ws_size, (size_t)WS_END); grid = -1; return; }
        if (hipGetDevice(&dev) != hipSuccess || hipDeviceGetAttribute(&cus, hipDeviceAttributeMultiprocessorCount, dev) != hipSuccess) { fprintf(stderr, "kernel_launch: device query failed\n"); grid = -1; return; }
        if (hipFuncSetAttribute((const void*)mega_fwd, hipFuncAttributeMaxDynamicSharedMemorySize, LDS_BYTES) != hipSuccess) { fprintf(stderr, "kernel_launch: hipFuncSetAttribute failed\n"); grid = -1; return; }
        if (hipOccupancyMaxActiveBlocksPerMultiprocessor(&per_cu, (const void*)mega_fwd, NTHR, LDS_BYTES) != hipSuccess || per_cu < 1)
            fprintf(stderr, "kernel_launch: occupancy query reports %d blocks per CU\n", per_cu);
        (void)hipGetLastError();
        grid = cus;
    }
    if (grid < 0) return;
    if (hipMemsetAsync((char*)d_ws + WS_CTL, 0, CTL_ZERO_BYTES, stream) != hipSuccess) { fprintf(stderr, "kernel_launch: memset failed\n"); return; }
    Args a{};
    for (int i = 0; i < 20; ++i) a.in[i] = (const float*)d_in[i];
    a.out = (float*)d_out; a.ws = (unsigned char*)d_ws;
    hipLaunchKernelGGL(mega_fwd, dim3(grid), dim3(NTHR), LDS_BYTES, stream, a);
}
```

```cpp
#include <hip/hip_runtime.h>
#include <cstdio>

#ifndef DBG_CHECK
#define DBG_CHECK 0
#endif
#ifndef PROBE_TWICE
#define PROBE_TWICE 0
#endif
#ifndef ZERO_FILL
#define ZERO_FILL 0
#endif

#define LAS __attribute__((address_space(3)))
#define GAS __attribute__((address_space(1)))
typedef GAS unsigned gu32;
typedef unsigned short bf16;
typedef short bf16x8 __attribute__((ext_vector_type(8)));
typedef float f32x2 __attribute__((ext_vector_type(2)));
typedef float f32x4 __attribute__((ext_vector_type(4)));
typedef float f32x16 __attribute__((ext_vector_type(16)));
typedef unsigned u32x2 __attribute__((ext_vector_type(2)));
typedef unsigned u32x4 __attribute__((ext_vector_type(4)));
typedef __bf16 bf16x2_t __attribute__((ext_vector_type(2)));
#define RLX_AGENT __ATOMIC_RELAXED, __HIP_MEMORY_SCOPE_AGENT
#define LDS_WAIT() asm volatile("s_waitcnt lgkmcnt(0)" ::: "memory")
#define VM_WAIT() asm volatile("s_waitcnt vmcnt(0)" ::: "memory")

__device__ __forceinline__ unsigned cvtpk(float lo, float hi) { f32x2 v = {lo, hi}; bf16x2_t b = __builtin_convertvector(v, bf16x2_t); return __builtin_bit_cast(unsigned, b); }
__device__ __forceinline__ float bf2f(unsigned short b) { return __uint_as_float(((unsigned)b) << 16); }
__device__ __forceinline__ float bflo(unsigned w) { return __uint_as_float(w << 16); }
__device__ __forceinline__ float bfhi(unsigned w) { return __uint_as_float(w & 0xffff0000u); }
__device__ __forceinline__ float wave_sum(float v) {
#pragma unroll
    for (int o = 1; o < 64; o <<= 1) v += __shfl_xor(v, o);
    return v;
}

constexpr int NWAVES = 8, NTHR = 512;
constexpr int D = 4096, SEQ = 8192, MP = 16384, MS = 128, MREAL = 16512, MPAD = 16640;
constexpr int N_IN = 25616, NP_IN = 25856, DFF = 11008, N_GU = 22016, NMOD = 24576;
constexpr int C_QA = 0, C_KA = 2048, C_VA = 4096, C_GA = 8192, C_QB = 12288, C_KB = 16384, C_VB = 16896, C_ZA = 17408, C_ZB = 21504, C_RA = 25600;
constexpr int O_RA = 12288, O_QB = 12304, O_KB = 16400, O_VB = 16912;
constexpr float NORM_EPS = 1e-6f;
__host__ __device__ __forceinline__ size_t pj(int row, int col) { return ((size_t)((row >> 8) * 101 + (col >> 8)) << 16) + (size_t)(((row & 255) << 8) + (col & 255)); }
constexpr float QSCALE = 0.125f * 1.4426950408889634f;
constexpr long OUT_YP = 0, OUT_YS = 67108864L, OUT_SGP = 67633152L, OUT_KP = 71827456L, OUT_VP = 71958528L, OUT_SGS = 72089600L, OUT_KS = 88866816L, OUT_VS = 88932352L, OUT_TOTAL = 88997888L;

constexpr size_t MiB = 1u << 20;
constexpr size_t WS_CTL = 0, CTL_ZERO_BYTES = 2 * MiB;
constexpr size_t WS_MOD = 1 * MiB, WS_ROPE = 2 * MiB, WS_VEC = 4 * MiB, WS_AMAT = 9 * MiB, WS_SC = 18 * MiB, WS_DBG = 19 * MiB;
constexpr size_t WS_WIN = 20 * MiB, WS_WOUT = 222 * MiB, WS_WGU = 254 * MiB, WS_WDN = 426 * MiB, WS_H = 512 * MiB, WS_PROJ = 642 * MiB, WS_FRAG = 1463 * MiB, WS_END = 1595 * MiB;
static_assert(WS_WIN + (size_t)NP_IN * D * 2 <= WS_WOUT && WS_WGU + (size_t)N_GU * D * 2 <= WS_WDN && WS_WDN + (size_t)D * DFF * 2 <= WS_H, "ws map");
static_assert(WS_H + (size_t)MPAD * D * 2 <= WS_PROJ && WS_PROJ + (size_t)MPAD * NP_IN * 2 <= WS_FRAG && WS_FRAG + (size_t)264 * 4 * 131072 <= WS_END, "ws map");
constexpr int CW_Q0 = 64, CW_BAR = 4096;

constexpr int LDS_BYTES = 160 * 1024;
constexpr int MISC_OFF = LDS_BYTES - 256;

#define XB_TMO      128
#define XB_XCNT(j)  (256  + 64 * (j))
#define XB_XSUB(j)  (1280 + 64 * (j))
#define XB_XGEN(j)  (2304 + 64 * (j))
#define XB_TOP      3328
#define XB_TOPGEN   3392
#define XCD_BAR_WORDS 3456
#define XB_SPIN_CAP (1u << 24)
__device__ __forceinline__ unsigned xb_ld(unsigned* p)              { return __hip_atomic_load(p, __ATOMIC_RELAXED, __HIP_MEMORY_SCOPE_AGENT); }
__device__ __forceinline__ unsigned xb_add(unsigned* p, unsigned v) { return __hip_atomic_fetch_add(p, v, __ATOMIC_RELAXED, __HIP_MEMORY_SCOPE_AGENT); }
__device__ __forceinline__ unsigned xb_xcc_id() { return (unsigned)__builtin_amdgcn_s_getreg((3 << 11) | 20) & 0xFu; }
#define XB_SPIN(cond, bar) do { unsigned _sp = 0; while (cond) { __builtin_amdgcn_s_sleep(1); \
    if ((++_sp & 255u) == 0u) { if (xb_ld(&(bar)[XB_TMO])) break; if (_sp > XB_SPIN_CAP) { atomicAdd(&(bar)[XB_TMO], 1u); break; } } } } while (0)
struct XcdBarrier { unsigned* bar; unsigned x; volatile LAS unsigned* st; };
__device__ __forceinline__ XcdBarrier xcd_barrier_post(unsigned* bar, volatile LAS unsigned* st) {
    XcdBarrier b; b.bar = bar; b.x = xb_xcc_id(); b.st = st;
    if (threadIdx.x == 0) (void)xb_add(&bar[XB_XCNT(b.x)], 1u);
    return b;
}
__device__ __forceinline__ void xcd_barrier_complete(unsigned* bar, unsigned x, unsigned& nloc, unsigned& nx) {
    const unsigned G = gridDim.x * gridDim.y * gridDim.z;
    unsigned sum, cnt, mine, sp = 0u;
    for (;;) {
        sum = 0u; cnt = 0u; mine = 0u;
#pragma unroll
        for (unsigned j = 0; j < 16; ++j) { const unsigned c = xb_ld(&bar[XB_XCNT(j)]); sum += c; cnt += (c > 0u) ? 1u : 0u; mine = (j == x) ? c : mine; }
        if (sum == G) break;
        __builtin_amdgcn_s_sleep(1);
        if ((++sp & 255u) == 0u) { if (xb_ld(&bar[XB_TMO])) break; if (sp > XB_SPIN_CAP) { atomicAdd(&bar[XB_TMO], 1u); break; } }
    }
    nloc = mine > 0u ? mine : 1u; nx = cnt > 0u ? cnt : 1u;
}
__device__ __forceinline__ void xcd_barrier(const XcdBarrier& b) {
    asm volatile("s_waitcnt vmcnt(0)" ::: "memory");
    __syncthreads();
    if (threadIdx.x == 0) {
        unsigned* bar = b.bar;
        __builtin_amdgcn_s_waitcnt(0);
        unsigned nloc = b.st[0], nx = b.st[1];
        if (nloc == 0u) { xcd_barrier_complete(bar, b.x, nloc, nx); b.st[0] = nloc; b.st[1] = nx; }
        const unsigned old = xb_add(&bar[XB_XSUB(b.x)], 1u);
        const unsigned gen = old / nloc;
        if (old + 1u == (gen + 1u) * nloc) {
            __builtin_amdgcn_fence(__ATOMIC_RELEASE, "agent");
            asm volatile("s_waitcnt vmcnt(0)" ::: "memory");
            const unsigned og = xb_add(&bar[XB_TOP], 1u);
            const unsigned tg = og / nx;
            if (og + 1u == (tg + 1u) * nx) xb_add(&bar[XB_TOPGEN], 1u);
            else XB_SPIN(xb_ld(&bar[XB_TOPGEN]) == tg, bar);
            __builtin_amdgcn_fence(__ATOMIC_ACQUIRE, "agent");
            xb_add(&bar[XB_XGEN(b.x)], 1u);
            asm volatile("s_waitcnt vmcnt(0)" ::: "memory");
        } else {
            XB_SPIN(xb_ld(&bar[XB_XGEN(b.x)]) == gen, bar);
            __builtin_amdgcn_fence(__ATOMIC_ACQUIRE, "agent");
            asm volatile("s_waitcnt vmcnt(0)" ::: "memory");
        }
    }
    __syncthreads();
}

namespace pg8 {
constexpr int BM = 256, BK = 64, HALF = 128, HTB = HALF * BK * 2, STAGE_BYTES = 8 * HTB, NXCD = 8, WGM = 8;
__host__ __device__ __forceinline__ int lds_byte(int r, int c) { const int st = (r >> 4) * 2 + (c >> 5), rr = r & 15, cc = c & 31, ob = rr * 64 + cc * 2; return st * 1024 + (ob ^ (((ob >> 9) & 1) << 5)); }
__host__ __device__ __forceinline__ void stage_rc(int b, int& R, int& C) { const int st = b / 1024, sb = b % 1024, swz = sb ^ (((sb >> 9) & 1) << 5); R = (st >> 1) * 16 + swz / 64; C = (st & 1) * 32 + (swz % 64) / 2; }
__host__ __device__ __forceinline__ int perm32(int rho) { const int n = rho >> 4, i = rho & 15; return 8 * (i >> 2) + 4 * n + (i & 3); }
struct Unit { int pm, pn; };
struct Gemm { const bf16* A; const bf16* Bt; int M, N, K; };
struct StaticOrder {
    int nM, nN, nwg, G, c; int force0 = 0;
    __host__ __device__ void init(int M, int N, int G_, int c_) { nM = M / BM; nN = N / BM; nwg = nM * nN; G = G_; c = c_; }
    __host__ __device__ bool next(int i, Unit& u) const {
        const long L = (long)i * G + c; if (L >= nwg) return false;
        int wgid = (int)L; { const int q = nwg / NXCD, r = nwg % NXCD, xcd = wgid % NXCD, off = wgid / NXCD; wgid = (xcd < r ? xcd * (q + 1) : r * (q + 1) + (xcd - r) * q) + off; }
        const int nig = WGM * nN, gid = wgid / nig, fm = gid * WGM, gsz = (nM - fm) < WGM ? (nM - fm) : WGM;
        u.pm = fm + ((wgid % nig) % gsz); u.pn = (wgid % nig) / gsz; if (force0) { u.pm = 0; u.pn = 0; } return true;
    }
};
template <class Epi, bool AIMG = false, bool BIMG = false>
__device__ __forceinline__ void gemm_phase(LAS unsigned char* lds, const Gemm g, const StaticOrder& S, const Epi& E) {
    int tid_ = threadIdx.x; asm volatile("" : "+v"(tid_));
    const int tid = tid_, wid = __builtin_amdgcn_readfirstlane(tid >> 6), lane = tid & 63, wr = wid >> 2, wc = wid & 3, fr = lane & 15, fq = lane >> 4;
    const int K = g.K, nt = K / BK;
    unsigned voffA[2], voffB[2];
#pragma unroll
    for (int i = 0; i < 2; ++i) { int R, C; stage_rc(tid * 16 + i * 8192, R, C); const int Rb = Epi::PERM ? ((R & ~31) + perm32(R & 31)) : R;
        voffA[i] = AIMG ? (unsigned)(tid * 16 + i * 8192) : (unsigned)(R * K + C) * 2u; voffB[i] = BIMG ? (unsigned)(tid * 16 + i * 8192) : (unsigned)(Rb * K + C) * 2u; }
    const size_t kstepA = AIMG ? (size_t)HTB : (size_t)(BK * 2), kstepB = BIMG ? (size_t)HTB : (size_t)(BK * 2);
    const size_t hstepA = AIMG ? (size_t)nt * HTB : (size_t)HALF * K * 2, hstepB = BIMG ? (size_t)nt * HTB : (size_t)HALF * K * 2;
    const size_t tstepA = 2 * hstepA, tstepB = 2 * hstepB;
    const unsigned ldsw = (unsigned)wid * 1024u;
    const int aoff = lds_byte(wr * 64 + fr, fq * 8), boff = lds_byte(wc * 32 + fr, fq * 8);
#define PG8_SA(b, h) (((b) * 2 + (h)) * HTB)
#define PG8_SB(b, h) ((4 + (b) * 2 + (h)) * HTB)
#define PG8_STAGE(bufoff, gbase, voff) do { _Pragma("unroll") for (int _i = 0; _i < 2; ++_i) \
        __builtin_amdgcn_global_load_lds((const unsigned*)((const char*)(gbase) + (voff)[_i]), (LAS unsigned*)(lds + (bufoff) + ldsw + _i * 8192), 16, 0, 0); } while (0)
#define PG8_LDA(dst, b, h) do { _Pragma("unroll") for (int m = 0; m < 4; ++m) _Pragma("unroll") for (int k = 0; k < 2; ++k) dst[m][k] = *(const LAS bf16x8*)(lds + PG8_SA(b, h) + aoff + m * 2048 + k * 1024); } while (0)
#define PG8_LDB(dst, b, h) do { _Pragma("unroll") for (int n = 0; n < 2; ++n) _Pragma("unroll") for (int k = 0; k < 2; ++k) dst[n][k] = *(const LAS bf16x8*)(lds + PG8_SB(b, h) + boff + n * 2048 + k * 1024); } while (0)
#define PG8_MMA(ai, bj, At, Bt) do { __builtin_amdgcn_s_setprio(1); _Pragma("unroll") for (int m = 0; m < 4; ++m) _Pragma("unroll") for (int n = 0; n < 2; ++n) _Pragma("unroll") for (int k = 0; k < 2; ++k) \
        acc[ai][bj][m][n] = __builtin_amdgcn_mfma_f32_16x16x32_bf16(Bt[n][k], At[m][k], acc[ai][bj][m][n], 0, 0, 0); __builtin_amdgcn_s_setprio(0); } while (0)
#define PG8_WAIT_V(n) asm volatile("s_waitcnt vmcnt(" #n ")" ::: "memory")
#define PG8_WAIT_L(n) asm volatile("s_waitcnt lgkmcnt(" #n ")" ::: "memory")
#define PG8_BAR __builtin_amdgcn_s_barrier()
#define PG8_SCHED __builtin_amdgcn_sched_barrier(0)
    Unit cur, nxt; int ui = 0;
    if (!S.next(0, cur)) return;
    f32x4 acc[2][2][4][2];
#pragma unroll
    for (int a = 0; a < 2; ++a)
#pragma unroll
        for (int b = 0; b < 2; ++b)
#pragma unroll
            for (int m = 0; m < 4; ++m)
#pragma unroll
                for (int n = 0; n < 2; ++n) acc[a][b][m][n] = (f32x4){0.f, 0.f, 0.f, 0.f};
    bf16x8 At[4][2], B0[2][2], B1[2][2];
    const char* cA = (const char*)g.A + (size_t)cur.pm * tstepA; const char* cB = (const char*)g.Bt + (size_t)cur.pn * tstepB;
    PG8_STAGE(PG8_SB(0, 0), cB, voffB); PG8_STAGE(PG8_SB(0, 1), cB + hstepB, voffB); PG8_STAGE(PG8_SA(0, 0), cA, voffA); PG8_STAGE(PG8_SA(0, 1), cA + hstepA, voffA);
    if (wr == 1) PG8_BAR;
    PG8_WAIT_V(2); PG8_BAR;
    PG8_STAGE(PG8_SB(1, 0), cB + kstepB, voffB); PG8_STAGE(PG8_SA(1, 0), cA + kstepA, voffA); PG8_STAGE(PG8_SB(1, 1), cB + hstepB + kstepB, voffB);
    PG8_WAIT_V(6); PG8_BAR;
    for (;;) {
        const bool has_next = S.next(ui + 1, nxt);
        const char* nA = has_next ? (const char*)g.A + (size_t)nxt.pm * tstepA : cA; const char* nB = has_next ? (const char*)g.Bt + (size_t)nxt.pn * tstepB : cB;
        for (int t = 0; t < nt; t += 2) {
            const bool last = (t == nt - 2);
            const char* a1 = cA + (size_t)(t + 1) * kstepA;
            const char* a2 = last ? nA : cA + (size_t)(t + 2) * kstepA; const char* b2 = last ? nB : cB + (size_t)(t + 2) * kstepB;
            const char* a3 = a2 + kstepA; const char* b3 = b2 + kstepB;
            PG8_LDB(B0, 0, 0); PG8_LDB(B1, 0, 1); PG8_SCHED; PG8_LDA(At, 0, 0); PG8_STAGE(PG8_SA(1, 1), a1 + hstepA, voffA);
            PG8_WAIT_V(8); PG8_WAIT_L(0); PG8_BAR; PG8_MMA(0, 0, At, B0); PG8_MMA(0, 1, At, B1); PG8_BAR; PG8_SCHED;
            PG8_LDA(At, 0, 1); PG8_STAGE(PG8_SB(0, 0), b2, voffB); PG8_STAGE(PG8_SB(0, 1), b2 + hstepB, voffB); PG8_STAGE(PG8_SA(0, 0), a2, voffA);
            PG8_WAIT_V(8); PG8_WAIT_L(0); PG8_BAR; PG8_MMA(1, 0, At, B0); PG8_MMA(1, 1, At, B1); PG8_BAR; PG8_SCHED;
            PG8_LDB(B0, 1, 0); PG8_LDB(B1, 1, 1); PG8_SCHED; PG8_LDA(At, 1, 0); PG8_STAGE(PG8_SA(0, 1), a2 + hstepA, voffA);
            PG8_WAIT_V(8); PG8_WAIT_L(0); PG8_BAR; PG8_MMA(0, 0, At, B0); PG8_MMA(0, 1, At, B1); PG8_BAR; PG8_SCHED;
            PG8_LDA(At, 1, 1); PG8_STAGE(PG8_SB(1, 0), b3, voffB); PG8_STAGE(PG8_SB(1, 1), b3 + hstepB, voffB); PG8_STAGE(PG8_SA(1, 0), a3, voffA);
            PG8_WAIT_V(8); PG8_WAIT_L(0); PG8_BAR; PG8_MMA(1, 0, At, B0); PG8_MMA(1, 1, At, B1); PG8_BAR; PG8_SCHED;
        }
        if (wr == 0) PG8_BAR;
        E(acc, cur, wr, wc, fr, fq);
        if (!has_next) break;
#pragma unroll
        for (int a = 0; a < 2; ++a)
#pragma unroll
            for (int b = 0; b < 2; ++b)
#pragma unroll
                for (int m = 0; m < 4; ++m)
#pragma unroll
                    for (int n = 0; n < 2; ++n) acc[a][b][m][n] = (f32x4){0.f, 0.f, 0.f, 0.f};
        cur = nxt; cA = nA; cB = nB; ++ui;
        if (wr == 1) PG8_BAR;
    }
    PG8_WAIT_V(0);
    PG8_BAR;
#undef PG8_SA
#undef PG8_SB
#undef PG8_STAGE
#undef PG8_LDA
#undef PG8_LDB
#undef PG8_MMA
#undef PG8_WAIT_V
#undef PG8_WAIT_L
#undef PG8_BAR
#undef PG8_SCHED
}
__device__ __forceinline__ size_t img_off(int row, int k, int nt, bool permb) {
    int r = row & 127; if (permb) { const int m = r & 31; r = (r & ~31) + 16 * ((m >> 2) & 1) + 4 * (m >> 3) + (m & 3); }
    return ((size_t)(row >> 7) * nt + (k >> 6)) * (size_t)HTB + (size_t)lds_byte(r, k & 63);
}
}

struct Args { const float* in[20]; float* out; unsigned char* ws; };
enum { I_XP = 0, I_XS, I_SG, I_CK, I_CV, I_CP, I_CS, I_WADA, I_BADA, I_G1, I_WIN, I_WGK, I_BGK, I_GGLA, I_SINK, I_WOUT, I_G2, I_WGU, I_WDN, I_GF };

struct Frame {
    LAS unsigned char* lds;
    volatile LAS unsigned* MISC;
    gu32* ctl;
    int tid, lane, wave, G, bid;
    const float* in[20];
    float* out; unsigned char* ws;
    float* MOD; float* ROPEC; float* ROPES; float* SC; float* DBG;
    bf16 *WIN, *WOUT, *WGU, *WDN, *H, *PROJ;
};

__device__ __forceinline__ int row_batch(int row) { return row < MP ? (row >> 13) : 2 + ((row - MP) >> 4); }
__device__ __forceinline__ int row_pos(int row) { return row < MP ? (row & 8191) : 2048 + (row & 15); }
__device__ __forceinline__ const float* x_row(const Frame& F, int row) { return row < MP ? F.in[I_XP] + (size_t)row * D : F.in[I_XS] + (size_t)(row - MP) * D; }

__device__ __forceinline__ int win_src_col(int n) {
    if (n < 8192) return n;
    if (n < 12288 || (n >= 17408 && n < 21504)) {
        const int ct = n < 12288 ? (n - 8192) >> 8 : 16 + ((n - 17408) >> 8), j = n & 255; return j < 128 ? 8192 + 128 * ct + j : 17424 + 128 * ct + (j - 128); }
    if (n < 16896) { const bool isq = n < 16384; const int r = n - (isq ? 12288 : 16384), hh = r >> 6, p = r & 63, t = p >> 3, e = p & 7;
        const int d = (e < 4) ? (4 * t + e) : (32 + 4 * t + (e - 4)); return (isq ? O_QB : O_KB) + 64 * hh + d; }
    if (n < 25600) return n + 16;
    if (n < 25616) return O_RA + (n - 25600);
    return -1;
}
__device__ __forceinline__ int wgu_src_col(int n) { const int pn = n >> 8, j = n & 255; return j < 128 ? 128 * pn + j : DFF + 128 * pn + (j - 128); }

__device__ __forceinline__ void p0_transpose(const float* W, int K, int N, bf16* WT, int mode, LAS float* scr, int n0, int k0, int lane, int imgnt = 0, bool permb = false) {
    const int cg = lane & 15, kr = lane >> 4;
    const int n = n0 + 4 * cg; const int src = mode == 1 ? win_src_col(n) : (mode == 2 ? wgu_src_col(n) : n);
    const float* wp = W + (size_t)(k0 + kr) * N + (src < 0 ? 0 : src);
    f32x4 v[16];
#pragma unroll
    for (int j = 0; j < 16; ++j) v[j] = src >= 0 ? *(const f32x4*)(wp + (size_t)(4 * j) * N) : (f32x4){0.f, 0.f, 0.f, 0.f};
#pragma unroll
    for (int j = 0; j < 16; ++j) { LAS float* d = scr + (4 * j + kr) * 65 + 4 * cg; d[0] = v[j].x; d[1] = v[j].y; d[2] = v[j].z; d[3] = v[j].w; }
    LDS_WAIT(); asm volatile("" ::: "memory");
    const int c = lane & 7;
#pragma unroll
    for (int j = 0; j < 8; ++j) { const int nn = (lane >> 3) + 8 * j; const LAS float* q = scr + (8 * c) * 65 + nn;
        u32x4 o; o.x = cvtpk(q[0], q[65]); o.y = cvtpk(q[2 * 65], q[3 * 65]); o.z = cvtpk(q[4 * 65], q[5 * 65]); o.w = cvtpk(q[6 * 65], q[7 * 65]);
        if (imgnt) *(u32x4*)((unsigned char*)WT + pg8::img_off(n0 + nn, k0 + 8 * c, imgnt, permb)) = o;
        else *(u32x4*)(WT + (size_t)(n0 + nn) * K + k0 + 8 * c) = o; }
    LDS_WAIT(); asm volatile("" ::: "memory");
}

constexpr int I_MOD = 384, I_TWIN = (NP_IN / 64) * 8, I_TWOUT = (D / 64) * 8, I_TWGU = (N_GU / 64) * 8, I_TWDN = (D / 64) * 22, I_ROPE = 32;
constexpr int P0_ITEMS = I_MOD + I_ROPE + I_TWIN;
constexpr int CW_QGU = 192, CW_QDN = 320;

__device__ __forceinline__ void p0_mod_item(Frame& F, int item) {
    const int w = F.wave, lane = F.lane, cg = item >> 2, kq = item & 3;
    f32x4 acc[10];
#pragma unroll
    for (int b = 0; b < 10; ++b) acc[b] = (f32x4){0.f, 0.f, 0.f, 0.f};
    const int kbase = 1024 * kq + 128 * w;
    const float* wp = F.in[I_WADA] + (size_t)kbase * NMOD + 256 * cg + 4 * lane;
#pragma unroll 1
    for (int kc = 0; kc < 2; ++kc) {
        float scv[10];
#pragma unroll
        for (int b = 0; b < 10; ++b) { const int k = kbase + 64 * kc + lane; const float c = b < 2 ? F.in[I_CP][b * D + k] : F.in[I_CS][(b - 2) * D + k]; scv[b] = c / (1.f + __expf(-c)); }
#pragma unroll
        for (int kk = 0; kk < 64; ++kk) {
            const f32x4 wv = *(const f32x4*)(wp + (size_t)(64 * kc + kk) * NMOD);
#pragma unroll
            for (int b = 0; b < 10; ++b) { const float sv = __builtin_bit_cast(float, __builtin_amdgcn_readlane(__builtin_bit_cast(int, scv[b]), kk)); acc[b] += wv * sv; }
        }
    }
    LAS float* red = (LAS float*)F.lds;
#pragma unroll
    for (int b = 0; b < 10; ++b) *(LAS f32x4*)(red + (w * 10 + b) * 256 + 4 * lane) = acc[b];
    __syncthreads();
    for (int o = F.tid; o < 2560; o += NTHR) { const int b = o >> 8, c = o & 255; float sacc = kq == 0 ? F.in[I_BADA][256 * cg + c] : 0.f;
#pragma unroll
        for (int ww = 0; ww < 8; ++ww) sacc += red[(ww * 10 + b) * 256 + c];
        atomicAdd(F.MOD + b * NMOD + 256 * cg + c, sacc); }
    __syncthreads();
}
__device__ __forceinline__ void p0_rope_item(Frame& F, int it) {
    const int pos = 256 * it + (F.tid >> 1), fh = F.tid & 1;
#pragma unroll 1
    for (int f = 16 * fh; f < 16 * fh + 16; ++f) {
        const float inv = (float)exp2(-(double)f * (13.287712379549449 / 32.0));
        const float ang = (float)pos * inv;
        const double a = (double)ang, r = a - 6.283185307179586 * rint(a * 0.15915494309189535);
        F.ROPEC[pos * 32 + f] = (float)cos(r); F.ROPES[pos * 32 + f] = (float)sin(r);
    }
}
__device__ __forceinline__ void p0_phase(Frame& F, int qw) {
    LAS float* scr = (LAS float*)(F.lds + F.wave * 16640);
    for (;;) {
        __syncthreads();
        if (F.tid == 0) F.MISC[0] = __hip_atomic_fetch_add(F.ctl + qw, 1u, RLX_AGENT);
        __syncthreads();
        int it = (int)F.MISC[0];
        if (it >= P0_ITEMS) break;
        if (it < I_MOD) { p0_mod_item(F, it); continue; } it -= I_MOD;
        if (it < I_ROPE) { p0_rope_item(F, it); continue; } it -= I_ROPE;
        const int w = F.wave;
        p0_transpose(F.in[I_WIN], D, N_IN, F.WIN, 1, scr, 64 * (it >> 3), 512 * (it & 7) + 64 * w, F.lane, D / 64, true);
    }
}
template <int KIND>
__device__ __forceinline__ void drain_weights(Frame& F) {
    LAS float* scr = (LAS float*)(F.lds + F.wave * 16640);
    for (;;) {
        __syncthreads();
        if (F.tid == 0) F.MISC[0] = __hip_atomic_fetch_add(F.ctl + (KIND == 0 ? CW_QGU : CW_QDN), 1u, RLX_AGENT);
        __syncthreads();
        int it = (int)F.MISC[0];
        if (it >= (KIND == 0 ? I_TWOUT + I_TWGU : I_TWDN)) break;
        const int w = F.wave;
        if (KIND == 0 && it < I_TWOUT) p0_transpose(F.in[I_WOUT], D, D, F.WOUT, 0, scr, 64 * (it >> 3), 512 * (it & 7) + 64 * w, F.lane, D / 64, true);
        else if (KIND == 0) { it -= I_TWOUT; p0_transpose(F.in[I_WGU], D, N_GU, F.WGU, 2, scr, 64 * (it >> 3), 512 * (it & 7) + 64 * w, F.lane, D / 64, true); }
        else { const int nb = it / 22, kb = it % 22, k0 = 512 * kb + 64 * w; if (k0 < DFF) p0_transpose(F.in[I_WDN], DFF, D, F.WDN, 0, scr, 64 * nb, k0, F.lane, DFF / 64, true); }
    }
}

template <bool SRCB>
__device__ __forceinline__ void norm_mod_rows(Frame& F, const float* xp, const float* xs, const bf16* xb, const float* g, int off_sh, int off_sc, bf16* Hout) {
    const int gw = F.bid * NWAVES + F.wave, NGW = F.G * NWAVES;
    for (int row = gw; row < MPAD; row += NGW) {
        unsigned char* hb = (unsigned char*)Hout + (size_t)(row >> 7) * (D / 64) * (size_t)pg8::HTB + 8 * (F.lane & 1);
        const int kt0 = F.lane >> 4, cc = (4 * F.lane) & 56, o_lo = pg8::lds_byte(row & 127, cc);
#define H_ST8(j, val) (*(GAS unsigned long long*)(hb + (size_t)(4 * (j) + kt0) * pg8::HTB + o_lo) = (val))
        if (row >= MREAL) {
#pragma unroll
            for (int j = 0; j < 16; ++j) H_ST8(j, 0ull);
            continue; }
        f32x4 v[16]; float s = 0.f;
        if (!SRCB) { const float* xrow = row < MP ? xp + (size_t)row * D : xs + (size_t)(row - MP) * D;
            const GAS f32x4* xr = (const GAS f32x4*)xrow + F.lane;
#pragma unroll
            for (int j = 0; j < 16; ++j) v[j] = xr[64 * j]; }
        else { const GAS u32x2* xr = (const GAS u32x2*)(xb + (size_t)row * D) + F.lane;
#pragma unroll
            for (int j = 0; j < 16; ++j) { const u32x2 w = xr[64 * j]; v[j] = (f32x4){bflo(w.x), bfhi(w.x), bflo(w.y), bfhi(w.y)}; } }
#pragma unroll
        for (int j = 0; j < 16; ++j) s += (v[j].x * v[j].x + v[j].y * v[j].y) + (v[j].z * v[j].z + v[j].w * v[j].w);
        const float r = 1.0f / sqrtf(wave_sum(s) * (1.f / D) + NORM_EPS);
        const float* mod = F.MOD + (size_t)row_batch(row) * NMOD;
#pragma unroll
        for (int j = 0; j < 16; ++j) { const int c = 256 * j + 4 * F.lane;
            const f32x4 gg = *(const f32x4*)(g + c), sh = *(const f32x4*)(mod + off_sh + c), sc = *(const f32x4*)(mod + off_sc + c);
            const f32x4 y = (v[j] * r) * gg * (sc + 1.0f) + sh;
            H_ST8(j, (unsigned long long)cvtpk(y.x, y.y) | ((unsigned long long)cvtpk(y.z, y.w) << 32)); }
    }
}

__device__ __forceinline__ float sigmoidf_(float x) { return __builtin_amdgcn_rcpf(1.f + __expf(-x)); }
struct EpiIn {
    static constexpr bool PERM = true;
    bf16* P; const float* ropec; const float* ropes; float* out;
    __device__ __forceinline__ void operator()(const f32x4 (&acc)[2][2][4][2], const pg8::Unit& u, int wr, int wc, int fr, int fq) const {
        const int pn = u.pn, pm = u.pm;
        const bool is_q = pn >= 48 && pn < 64, is_k = pn >= 64 && pn < 66, is_v = pn >= 66 && pn < 68;
        const bool is_gz = (pn >= 32 && pn < 48) || (pn >= 68 && pn < 84), is_zb = pn >= 84 && pn < 100;
        const int t = 4 * (wc & 1) + fq;
        if (is_gz) {
            const int ct = pn < 48 ? pn - 32 : 16 + (pn - 68);
#pragma unroll
            for (int ai = 0; ai < 2; ++ai)
#pragma unroll
                for (int m = 0; m < 4; ++m) { const int row = pm * 256 + ai * 128 + wr * 64 + m * 16 + fr;
                    const f32x4 g0 = acc[ai][0][m][0], g1 = acc[ai][0][m][1], z0 = acc[ai][1][m][0], z1 = acc[ai][1][m][1]; float a[8];
#pragma unroll
                    for (int x = 0; x < 4; ++x) { a[x] = g0[x] * sigmoidf_(g0[x]) * sigmoidf_(z0[x]); a[4 + x] = g1[x] * sigmoidf_(g1[x]) * sigmoidf_(z1[x]); }
                    u32x4 w; w.x = cvtpk(a[0], a[1]); w.y = cvtpk(a[2], a[3]); w.z = cvtpk(a[4], a[5]); w.w = cvtpk(a[6], a[7]);
                    *(u32x4*)(P + pj(row, C_GA + ct * 128 + wc * 32 + 8 * fq)) = w; }
            return; }
#pragma unroll
        for (int ai = 0; ai < 2; ++ai)
#pragma unroll
            for (int m = 0; m < 4; ++m) {
                const int row = pm * 256 + ai * 128 + wr * 64 + m * 16 + fr;
                bf16* rowp = P + pj(row, pn * 256 + wc * 32 + 8 * fq);
                long kbase = -1;
                if (is_k || is_v) {
                    if (row < MP) { const int tt = row & 8191; if (tt >= 8064) kbase = (is_k ? OUT_KP : OUT_VP) + ((long)((row >> 13) * 128 + (tt - 8064)) * 8) * 64; }
                    else if (row < MREAL) { const int r2 = row - MP; kbase = (is_k ? OUT_KS : OUT_VS) + ((long)((r2 >> 4) * 16 + (r2 & 15)) * 8) * 64; }
                }
                f32x4 cs, sn;
                if (is_q || is_k) { const int pos = row_pos(row); cs = *(const f32x4*)(ropec + pos * 32 + 4 * t); sn = *(const f32x4*)(ropes + pos * 32 + 4 * t); }
#pragma unroll
                for (int bj = 0; bj < 2; ++bj) {
                    f32x4 v0 = acc[ai][bj][m][0], v1 = acc[ai][bj][m][1];
                    if (is_q || is_k) { const f32x4 o1 = v0 * cs - v1 * sn, o2 = v1 * cs + v0 * sn; v0 = o1; v1 = o2;
                        if (is_q) { v0 = v0 * QSCALE; v1 = v1 * QSCALE; } }
                    if (is_zb) {
#pragma unroll
                        for (int x = 0; x < 4; ++x) { v0[x] = sigmoidf_(v0[x]); v1[x] = sigmoidf_(v1[x]); } }
                    if (kbase >= 0) {
                        const int g = 4 * (pn - (is_k ? 64 : 66)) + 2 * bj + (wc >> 1);
                        float* kp = out + kbase + g * 64;
                        if (is_k) { *(f32x4*)(kp + 4 * t) = v0; *(f32x4*)(kp + 32 + 4 * t) = v1; }
                        else { *(f32x4*)(kp + 8 * t) = v0; *(f32x4*)(kp + 8 * t + 4) = v1; }
                    }
                    u32x4 w; w.x = cvtpk(v0[0], v0[1]); w.y = cvtpk(v0[2], v0[3]); w.z = cvtpk(v1[0], v1[1]); w.w = cvtpk(v1[2], v1[3]);
                    *(u32x4*)(rowp + bj * 128) = w;
                }
            }
    }
};

constexpr int CL_PITCH = 520;
constexpr float GLA_QSCALE = 0.04419417382415922f;
__device__ __forceinline__ int crow(int reg, int h) { return (reg & 3) + 8 * (reg >> 2) + 4 * h; }
#define MFMA32(a, b, c) __builtin_amdgcn_mfma_f32_32x32x16_bf16((a), (b), (c), 0, 0, 0)
__device__ __forceinline__ bf16x8 pack8(const f32x16& x, int s) {
    u32x4 p; p.x = cvtpk(x[8 * s], x[8 * s + 1]); p.y = cvtpk(x[8 * s + 2], x[8 * s + 3]); p.z = cvtpk(x[8 * s + 4], x[8 * s + 5]); p.w = cvtpk(x[8 * s + 6], x[8 * s + 7]);
    return __builtin_bit_cast(bf16x8, p);
}
constexpr float LOG2E_ = 1.4426950408889634f;
__device__ __forceinline__ float logsig(float x) { return fminf(x, 0.f) - __logf(1.f + __expf(-fabsf(x))); }

__device__ __forceinline__ void gla_chunk_local(Frame& F, int cid, int hd) {
    const int tid = F.tid, lane = F.lane, wv = F.wave, h = lane >> 5;
    LAS bf16* QL = (LAS bf16*)F.lds; LAS bf16* KL = QL + 64 * CL_PITCH;
    LAS float* RA = (LAS float*)(F.lds + 133120); LAS float* RED = (LAS float*)(F.lds + 137216);
    int row0, ntok; if (cid < 256) { row0 = cid * 64; ntok = 64; } else { row0 = MP + 16 * (cid - 256); ntok = 16; }
    const int d = tid;
    float wg[16];
#pragma unroll
    for (int r = 0; r < 16; ++r) wg[r] = F.in[I_WGK][r * 2048 + hd * 512 + d];
    const float bias = F.in[I_BGK][hd * 512 + d];
    u32x4 rq[8], rk[8];
#pragma unroll
    for (int j = 0; j < 8; ++j) { const int id = tid + 512 * j, rr = id >> 6, c16 = id & 63; rq[j] = (u32x4){0u, 0u, 0u, 0u}; rk[j] = rq[j];
        if (rr < ntok) { rq[j] = *(const u32x4*)(F.PROJ + pj(row0 + rr, C_QA + hd * 512 + 8 * c16)); rk[j] = *(const u32x4*)(F.PROJ + pj(row0 + rr, C_KA + hd * 512 + 8 * c16)); } }
    if (tid < 128) { const int i = tid >> 1, half = tid & 1; u32x4 w = (u32x4){0u, 0u, 0u, 0u};
        if (i < ntok) w = *(const u32x4*)(F.PROJ + pj(row0 + i, C_RA + 8 * half));
        LAS float* r = RA + i * 16 + 8 * half;
        r[0] = bflo(w.x); r[1] = bfhi(w.x); r[2] = bflo(w.y); r[3] = bfhi(w.y); r[4] = bflo(w.z); r[5] = bfhi(w.z); r[6] = bflo(w.w); r[7] = bfhi(w.w); }
#pragma unroll
    for (int j = 0; j < 8; ++j) { const int id = tid + 512 * j, rr = id >> 6, c16 = id & 63; *(LAS u32x4*)(QL + rr * CL_PITCH + 8 * c16) = rq[j]; *(LAS u32x4*)(KL + rr * CL_PITCH + 8 * c16) = rk[j]; }
    __syncthreads();
    float B[64]; float bc = 0.f;
    unsigned ra_base = (unsigned)(size_t)RA; asm volatile("" : "+v"(ra_base));
    const f32x2 w01 = {wg[0], wg[1]}, w23 = {wg[2], wg[3]}, w45 = {wg[4], wg[5]}, w67 = {wg[6], wg[7]}, w89 = {wg[8], wg[9]}, wab = {wg[10], wg[11]}, wcd = {wg[12], wg[13]}, wef = {wg[14], wg[15]};
#pragma unroll
    for (int i = 0; i < 64; ++i) {
        const LAS f32x4* rp = (const LAS f32x4*)(size_t)(ra_base + (unsigned)(i * 64));
        const f32x4 r0 = rp[0], r1 = rp[1], r2 = rp[2], r3 = rp[3];
        f32x2 a2 = (f32x2){r0.x, r0.y} * w01; a2 += (f32x2){r0.z, r0.w} * w23; a2 += (f32x2){r1.x, r1.y} * w45; a2 += (f32x2){r1.z, r1.w} * w67;
        a2 += (f32x2){r2.x, r2.y} * w89; a2 += (f32x2){r2.z, r2.w} * wab; a2 += (f32x2){r3.x, r3.y} * wcd; a2 += (f32x2){r3.z, r3.w} * wef;
        const float gk = bias + (a2.x + a2.y);
        const float l2 = __builtin_amdgcn_logf(1.f + __builtin_amdgcn_exp2f(-fabsf(gk) * LOG2E_));
        float g = (fminf(gk, 0.f) - l2 * 0.6931471805599453f) * (1.f / 16.f); if (i >= ntok) g = 0.f;
        bc += g; B[i] = bc; }
    const float bmid = (ntok == 64) ? B[32] : B[8], blast = B[63];
    float* VEC = (float*)(F.ws + WS_VEC) + (size_t)(cid * 4 + hd) * 1024;
    VEC[d] = __expf(bmid); VEC[512 + d] = __expf(blast - bmid);
    unsigned kpk[32]; float kprev = 0.f;
#pragma unroll
    for (int i = 0; i < 64; ++i) {
        const float q = bf2f(QL[i * CL_PITCH + d]), k = bf2f(KL[i * CL_PITCH + d]);
        const float qt = q * GLA_QSCALE * __expf(B[i] - bmid), kt = k * __expf(bmid - B[i]);
        QL[i * CL_PITCH + d] = (bf16)(cvtpk(qt, 0.f) & 0xffffu);
        KL[i * CL_PITCH + d] = (bf16)(cvtpk(kt, 0.f) & 0xffffu);
        if (i & 1) kpk[i >> 1] = cvtpk(kprev, kt); else kprev = kt; }
    __syncthreads();
    unsigned char* fq = F.ws + WS_FRAG + (size_t)(cid * 4 + hd) * 131072; unsigned char* fk = fq + 65536;
    { const int dt = (d >> 5) & 1, dl = d & 31;
#pragma unroll
      for (int sp = 0; sp < 4; ++sp)
#pragma unroll
          for (int hh = 0; hh < 2; ++hh) { u32x4 o; o.x = kpk[8 * sp + 4 * hh]; o.y = kpk[8 * sp + 4 * hh + 1]; o.z = kpk[8 * sp + 4 * hh + 2]; o.w = kpk[8 * sp + 4 * hh + 3];
              *(u32x4*)(fk + ((wv * 2 + dt) * 4 + sp) * 1024 + (dl + 32 * hh) * 16) = o; } }
#pragma unroll
    for (int mt = 0; mt < 2; ++mt)
#pragma unroll
        for (int dt = 0; dt < 2; ++dt)
#pragma unroll
            for (int s = 0; s < 2; ++s) { const int i = 32 * mt + (lane & 31), d0 = 64 * wv + 32 * dt + 16 * s + 4 * h;
                const u32x2 a = *(const LAS u32x2*)(QL + i * CL_PITCH + d0), b = *(const LAS u32x2*)(QL + i * CL_PITCH + d0 + 8);
                u32x4 o; o.x = a.x; o.y = a.y; o.z = b.x; o.w = b.y;
                *(u32x4*)(fq + (((wv * 2 + mt) * 2 + dt) * 2 + s) * 1024 + lane * 16) = o; }
    const int tile = wv & 3, jt = tile >> 1, it = tile & 1, kh = wv >> 2;
    f32x16 acc;
#pragma unroll
    for (int r = 0; r < 16; ++r) acc[r] = 0.f;
#pragma unroll
    for (int ks = 0; ks < 16; ++ks) { const int dk = 256 * kh + 16 * ks + 8 * h;
        const bf16x8 a = *(const LAS bf16x8*)(KL + (32 * jt + (lane & 31)) * CL_PITCH + dk);
        const bf16x8 b = *(const LAS bf16x8*)(QL + (32 * it + (lane & 31)) * CL_PITCH + dk);
        acc = MFMA32(a, b, acc); }
    if (kh == 1) {
#pragma unroll
        for (int r = 0; r < 16; ++r) RED[(tile * 16 + r) * 64 + lane] = acc[r]; }
    __syncthreads();
    if (kh == 0) {
        const int i = 32 * it + (lane & 31);
#pragma unroll
        for (int r = 0; r < 16; ++r) { const float v = acc[r] + RED[(tile * 16 + r) * 64 + lane]; const int j = 32 * jt + crow(r, h); acc[r] = (j > i) ? 0.f : v; }
        unsigned char* am = F.ws + WS_AMAT + (size_t)(cid * 4 + hd) * 8192;
#pragma unroll
        for (int s = 0; s < 2; ++s) { const bf16x8 p = pack8(acc, s); *(bf16x8*)(am + (it + 2 * (2 * jt + s)) * 1024 + lane * 16) = p; }
    }
    __syncthreads();
}

constexpr int KS_PITCH = 72, VT_PITCH = 196;
constexpr float LOG2E = 1.4426950408889634f;
constexpr size_t WS_DUMMY = 1600 * MiB;
template <bool SAMPLE, bool DUMMY = false>
__device__ __forceinline__ void swa_unit(Frame& F, int b, int n, int g) {
    const int tid = F.tid, lane = F.lane, wv = F.wave, h = lane >> 5;
    LAS bf16* KS = (LAS bf16*)F.lds; LAS bf16* VT = KS + 192 * KS_PITCH;
    int nk, ntile;
    if (!SAMPLE) {
        nk = 64 * (n + 1 < 3 ? n + 1 : 3); ntile = nk >> 5;
        const int kr0 = b * SEQ + 64 * (n > 2 ? n - 2 : 0);
        for (int task = tid; task < nk * 8; task += NTHR) { const int key = task >> 3, c8 = task & 7;
            *(LAS u32x4*)(KS + key * KS_PITCH + 8 * c8) = *(const u32x4*)(F.PROJ + pj(kr0 + key, C_KB + g * 64 + 8 * c8)); }
        for (int task = tid; task < nk * 8; task += NTHR) { const int kp = task >> 4, dq = task & 15;
            const bf16* vp = F.PROJ + pj(kr0 + 2 * kp, C_VB + g * 64 + 4 * dq);
            const u32x2 a = *(const u32x2*)vp, c = *(const u32x2*)(vp + 256);
            LAS unsigned* o = (LAS unsigned*)(VT + (4 * dq) * VT_PITCH + 2 * kp);
            o[0] = (a.x & 0xffffu) | (c.x << 16); o[VT_PITCH / 2] = (a.x >> 16) | (c.x & 0xffff0000u);
            o[VT_PITCH] = (a.y & 0xffffu) | (c.y << 16); o[3 * (VT_PITCH / 2)] = (a.y >> 16) | (c.y & 0xffff0000u); }
    } else {
        nk = 144; ntile = 5;
        const float* ck = F.in[I_CK]; const float* cv = F.in[I_CV];
        for (int task = tid; task < 160 * 8; task += NTHR) { const int key = task >> 3, t = task & 7; u32x4 o = (u32x4){0u, 0u, 0u, 0u};
            if (key < 128) { const float* p = ck + ((size_t)(b * 128 + key) * 8 + g) * 64; const f32x4 x1 = *(const f32x4*)(p + 4 * t), x2 = *(const f32x4*)(p + 32 + 4 * t);
                o.x = cvtpk(x1.x, x1.y); o.y = cvtpk(x1.z, x1.w); o.z = cvtpk(x2.x, x2.y); o.w = cvtpk(x2.z, x2.w); }
            else if (key < 144) o = *(const u32x4*)(F.PROJ + pj(MP + 16 * b + (key - 128), C_KB + g * 64 + 8 * t));
            *(LAS u32x4*)(KS + key * KS_PITCH + 8 * t) = o; }
        for (int task = tid; task < 80 * 16; task += NTHR) { const int kp = task >> 4, dq = task & 15; unsigned w0 = 0u, w1 = 0u, w2 = 0u, w3 = 0u;
            if (kp < 64) { const float* p = cv + ((size_t)(b * 128 + 2 * kp) * 8 + g) * 64 + 4 * dq; const f32x4 a = *(const f32x4*)p, c = *(const f32x4*)(p + 512);
                w0 = cvtpk(a.x, c.x); w1 = cvtpk(a.y, c.y); w2 = cvtpk(a.z, c.z); w3 = cvtpk(a.w, c.w); }
            else if (kp < 72) { const bf16* vp = F.PROJ + pj(MP + 16 * b + 2 * (kp - 64), C_VB + g * 64 + 4 * dq);
                const u32x2 a = *(const u32x2*)vp, c = *(const u32x2*)(vp + 256);
                w0 = (a.x & 0xffffu) | (c.x << 16); w1 = (a.x >> 16) | (c.x & 0xffff0000u); w2 = (a.y & 0xffffu) | (c.y << 16); w3 = (a.y >> 16) | (c.y & 0xffff0000u); }
            LAS unsigned* o = (LAS unsigned*)(VT + (4 * dq) * VT_PITCH + 2 * kp);
            o[0] = w0; o[VT_PITCH / 2] = w1; o[VT_PITCH] = w2; o[3 * (VT_PITCH / 2)] = w3; }
    }
    __syncthreads();
    const int npass = SAMPLE ? 1 : 2;
    if (!SAMPLE || wv < 4) {
#pragma unroll 1
        for (int pass = 0; pass < npass; ++pass) {
            const int r = lane & 31;
            int head, row;
            if (!SAMPLE) { head = g * 8 + wv; row = b * SEQ + 64 * n + 32 * pass + r; }
            else { head = g * 8 + 2 * wv + (r >> 4); row = MP + 16 * b + (r & 15); }
            const float sink2 = F.in[I_SINK][head] * LOG2E;
            bf16* qptr = F.PROJ + pj(row, C_QB + head * 64);
            bf16x8 qf[4];
#pragma unroll
            for (int t = 0; t < 4; ++t) qf[t] = *(const bf16x8*)(qptr + 16 * t + 8 * h);
            f32x16 st[6];
#pragma unroll
            for (int kt = 0; kt < 6; ++kt) {
#pragma unroll
                for (int rr = 0; rr < 16; ++rr) st[kt][rr] = -INFINITY;
                if (kt < ntile) { f32x16 a;
#pragma unroll
                    for (int rr = 0; rr < 16; ++rr) a[rr] = 0.f;
#pragma unroll
                    for (int t = 0; t < 4; ++t) { const bf16x8 kf = *(const LAS bf16x8*)(KS + (32 * kt + r) * KS_PITCH + 16 * t + 8 * h); a = MFMA32(kf, qf[t], a); }
                    st[kt] = a; } }
            if (SAMPLE) {
#pragma unroll
                for (int rr = 0; rr < 16; ++rr) if (crow(rr, h) >= 16) st[4][rr] = -INFINITY; }
            float m = sink2;
#pragma unroll
            for (int kt = 0; kt < 6; ++kt)
#pragma unroll
                for (int rr = 0; rr < 16; ++rr) m = fmaxf(m, st[kt][rr]);
            m = fmaxf(m, __shfl_xor(m, 32));
            float sum = 0.f;
#pragma unroll
            for (int kt = 0; kt < 6; ++kt)
#pragma unroll
                for (int rr = 0; rr < 16; ++rr) { const float p = __builtin_amdgcn_exp2f(st[kt][rr] - m); st[kt][rr] = p; sum += p; }
            sum += __shfl_xor(sum, 32);
            const float inv = 1.f / (sum + __builtin_amdgcn_exp2f(sink2 - m));
            f32x16 o0, o1;
#pragma unroll
            for (int rr = 0; rr < 16; ++rr) { o0[rr] = 0.f; o1[rr] = 0.f; }
#pragma unroll
            for (int kt = 0; kt < 6; ++kt) if (kt < ntile) {
#pragma unroll
                for (int s = 0; s < 2; ++s) { const bf16x8 pb = pack8(st[kt], s);
                    const LAS bf16* v0 = VT + r * VT_PITCH + 32 * kt + 16 * s + 4 * h; const LAS bf16* v1 = v0 + 32 * VT_PITCH;
                    const u32x2 a0 = *(const LAS u32x2*)v0, a1 = *(const LAS u32x2*)(v0 + 8), c0 = *(const LAS u32x2*)v1, c1 = *(const LAS u32x2*)(v1 + 8);
                    u32x4 va; va.x = a0.x; va.y = a0.y; va.z = a1.x; va.w = a1.y; u32x4 vc; vc.x = c0.x; vc.y = c0.y; vc.z = c1.x; vc.w = c1.y;
                    o0 = MFMA32(__builtin_bit_cast(bf16x8, va), pb, o0); o1 = MFMA32(__builtin_bit_cast(bf16x8, vc), pb, o1); } }
#pragma unroll
            for (int rg = 0; rg < 4; ++rg) { u32x2 w0, w1;
                w0.x = cvtpk(o0[4 * rg] * inv, o0[4 * rg + 1] * inv); w0.y = cvtpk(o0[4 * rg + 2] * inv, o0[4 * rg + 3] * inv);
                w1.x = cvtpk(o1[4 * rg] * inv, o1[4 * rg + 1] * inv); w1.y = cvtpk(o1[4 * rg + 2] * inv, o1[4 * rg + 3] * inv);
                bf16* optr = DUMMY ? (bf16*)(F.ws + WS_DUMMY) + (size_t)(row & 1023) * 4096 + head * 64 : qptr;
                *(u32x2*)(optr + 8 * rg + 4 * h) = w0; *(u32x2*)(optr + 32 + 8 * rg + 4 * h) = w1; }
        }
    }
    __syncthreads();
}

constexpr int P3_CL = 264 * 4, P3_SWAP = 2048, P3_SWAS = 64, P3_UNITS = P3_CL + P3_SWAP + P3_SWAS;
__device__ __forceinline__ void p3_phase(Frame& F) {
    for (int u = F.bid; u < P3_CL; u += F.G) gla_chunk_local(F, u >> 2, u & 3);
#if PROBE_TWICE == 105
    for (int u = F.bid; u < P3_CL; u += F.G) gla_chunk_local(F, u >> 2, u & 3);
#endif
#if PROBE_TWICE == 103
    for (int v = (F.bid + F.G - (P3_CL % F.G)) % F.G; v < P3_SWAP; v += F.G) swa_unit<false, true>(F, v >> 10, (v >> 3) & 127, v & 7);
#endif
    const bool bal = F.G == 256;
    for (int v = (F.bid + F.G - (P3_CL % F.G)) % F.G, k = 0; v < P3_SWAP; v += F.G, ++k) { if (bal && F.bid < 32 && k >= 6) break; swa_unit<false>(F, v >> 10, (v >> 3) & 127, v & 7); }
    if (bal && F.bid >= 96 && F.bid < 160) { const int src = (F.bid - 96) >> 1, v = ((src + F.G - (P3_CL % F.G)) % F.G) + F.G * (6 + ((F.bid - 96) & 1)); swa_unit<false>(F, v >> 10, (v >> 3) & 127, v & 7); }
    for (int v = (F.bid + 2 * F.G - ((P3_CL + P3_SWAP) % F.G)) % F.G; v < P3_SWAS; v += F.G) swa_unit<true>(F, v >> 3, 0, v & 7);
}

__device__ __forceinline__ u32x2 tr_read8(unsigned addr) { u32x2 r; asm volatile("ds_read_b64_tr_b16 %0, %1\n\ts_waitcnt lgkmcnt(0)" : "=&v"(r) : "v"(addr) : "memory"); return r; }
struct ScanQ { bf16x8 qf[2][2][2], af; };
__device__ __forceinline__ void scan_load_q(ScanQ& P, const unsigned char* ws, int cid, int hd, int wv, int lane) {
    const unsigned char* fq = ws + WS_FRAG + (size_t)(cid * 4 + hd) * 131072;
#pragma unroll
    for (int mt = 0; mt < 2; ++mt)
#pragma unroll
        for (int dt = 0; dt < 2; ++dt)
#pragma unroll
            for (int s = 0; s < 2; ++s) P.qf[mt][dt][s] = *(const bf16x8*)(fq + (((wv * 2 + mt) * 2 + dt) * 2 + s) * 1024 + lane * 16);
    P.af = *(const bf16x8*)(ws + WS_AMAT + (size_t)(cid * 4 + hd) * 8192 + wv * 1024 + lane * 16);
}
__device__ __forceinline__ void scan_load_v(u32x4& vt, f32x4& vec, const unsigned char* ws, const bf16* PROJ, int cid, int hd, int row0, int ntok, int e0, int tid) {
    vt = (u32x4){0u, 0u, 0u, 0u}; vec = (f32x4){0.f, 0.f, 0.f, 0.f};
    if (tid < 256) { const int i = tid >> 2, c4 = tid & 3;
        if (i < ntok) vt = *(const u32x4*)(PROJ + pj(row0 + i, C_VA + hd * 1024 + e0 + 8 * c4));
        vec = *(const f32x4*)((const float*)(ws + WS_VEC) + (size_t)(cid * 4 + hd) * 1024 + 4 * tid); }
}
__device__ __forceinline__ void scan_store_v(LAS unsigned char* base, const u32x4& vt, const f32x4& vec, int tid) {
    if (tid < 256) { *(LAS u32x4*)((LAS bf16*)base + (tid >> 2) * 32 + 8 * (tid & 3)) = vt; *(LAS f32x4*)((LAS float*)(base + 4096) + 4 * tid) = vec; }
}
struct ScanK { bf16x8 kf[2][4]; };
__device__ __forceinline__ void scan_load_k(ScanK& P, const unsigned char* ws, int cid, int hd, int wv, int lane) {
    const unsigned char* fk = ws + WS_FRAG + (size_t)(cid * 4 + hd) * 131072 + 65536;
#pragma unroll
    for (int dt = 0; dt < 2; ++dt)
#pragma unroll
        for (int sp = 0; sp < 4; ++sp) P.kf[dt][sp] = *(const bf16x8*)(fk + ((wv * 2 + dt) * 4 + sp) * 1024 + lane * 16);
}
constexpr int SC_BUF = 73728, SC_VEC = 4096, SC_RED = 8192;
struct ScanTr { u32x2 n[8]; };
__device__ __forceinline__ void scan_tr_reads_p(u32x2& p0, u32x2& p1, unsigned aP) {
    asm volatile("ds_read_b64_tr_b16 %0, %2\n\tds_read_b64_tr_b16 %1, %2 offset:512\n\ts_waitcnt lgkmcnt(0)" : "=&v"(p0), "=&v"(p1) : "v"(aP) : "memory");
}
__device__ __forceinline__ void scan_tr_reads_n(ScanTr& T, unsigned aN) {
    asm volatile("ds_read_b64_tr_b16 %0, %8\n\tds_read_b64_tr_b16 %1, %8 offset:256\n\t"
                 "ds_read_b64_tr_b16 %2, %8 offset:1024\n\tds_read_b64_tr_b16 %3, %8 offset:1280\n\t"
                 "ds_read_b64_tr_b16 %4, %8 offset:2048\n\tds_read_b64_tr_b16 %5, %8 offset:2304\n\t"
                 "ds_read_b64_tr_b16 %6, %8 offset:3072\n\tds_read_b64_tr_b16 %7, %8 offset:3328\n\ts_waitcnt lgkmcnt(0)"
                 : "=&v"(T.n[0]), "=&v"(T.n[1]), "=&v"(T.n[2]), "=&v"(T.n[3]), "=&v"(T.n[4]), "=&v"(T.n[5]), "=&v"(T.n[6]), "=&v"(T.n[7])
                 : "v"(aN) : "memory");
}
template <bool DUMMY, int BUF>
__device__ __forceinline__ void scan_reduce(Frame& F, int hd, int row0, int ntok, int e0) {
    const int tid = F.tid; LAS float* RED = (LAS float*)(F.lds + BUF * SC_BUF + SC_RED);
    const int i = tid >> 3, e4 = 4 * (tid & 7); f32x4 sacc = *(const LAS f32x4*)(RED + i * 32 + e4);
#pragma unroll
    for (int w = 1; w < 8; ++w) sacc += *(const LAS f32x4*)(RED + w * 2048 + i * 32 + e4);
    if (i < ntok) { u32x2 o; o.x = cvtpk(sacc.x, sacc.y); o.y = cvtpk(sacc.z, sacc.w);
        bf16* op_ = DUMMY ? (bf16*)(F.ws + WS_DUMMY) + (size_t)((row0 + i) & 1023) * 4096 + hd * 1024 + e0 + e4 : F.PROJ + pj(row0 + i, C_VA + hd * 1024 + e0 + e4);
        *(u32x2*)op_ = o; }
}
template <bool SAMPLE, bool DUMMY, int BUF>
__device__ __forceinline__ void scan_step(Frame& F, f32x16& S0, f32x16& S1, ScanQ& cq, ScanK& ck, int cidn, int hd, int rowp, int rown, int ntok, int e0) {
    const int tid = F.tid, lane = F.lane, wv = F.wave, h = lane >> 5, el = lane & 31;
    LAS unsigned char* base = F.lds + BUF * SC_BUF;
    LAS bf16* VB = (LAS bf16*)base; LAS float* VECL = (LAS float*)(base + SC_VEC); LAS float* RED = (LAS float*)(base + SC_RED);
    __syncthreads();
    u32x4 nvt; f32x4 nvec;
    if (!SAMPLE) scan_load_v(nvt, nvec, F.ws, F.PROJ, cidn, hd, rown, ntok, e0, tid);
    if (!SAMPLE && rowp >= 0) scan_reduce<DUMMY, BUF ^ 1>(F, hd, rowp, ntok, e0);
    const int i16 = lane & 15; const unsigned tro = (unsigned)(size_t)VB + (unsigned)((i16 >> 2) * 64 + 32 * ((lane >> 4) & 1) + 8 * (i16 & 3));
    u32x2 tp0, tp1; scan_tr_reads_p(tp0, tp1, tro + (unsigned)((16 * (wv >> 1) + 4 * h) * 64));
#pragma unroll
    for (int rg = 0; rg < 4; ++rg) { const f32x4 e0v = *(const LAS f32x4*)(VECL + 64 * wv + 8 * rg + 4 * h), e1v = *(const LAS f32x4*)(VECL + 64 * wv + 32 + 8 * rg + 4 * h);
#pragma unroll
        for (int x = 0; x < 4; ++x) { S0[4 * rg + x] *= e0v[x]; S1[4 * rg + x] *= e1v[x]; } }
    bf16x8 vP; { u32x4 vv; vv.x = tp0.x; vv.y = tp0.y; vv.z = tp1.x; vv.w = tp1.y; vP = __builtin_bit_cast(bf16x8, vv); }
    LAS float* rw = RED + wv * 2048;
#pragma unroll
    for (int mt = 0; mt < 2; ++mt) {
        f32x16 op;
#pragma unroll
        for (int r = 0; r < 16; ++r) op[r] = 0.f;
        op = MFMA32(cq.qf[mt][0][0], pack8(S0, 0), op); op = MFMA32(cq.qf[mt][0][1], pack8(S0, 1), op); op = MFMA32(cq.qf[mt][1][0], pack8(S1, 0), op); op = MFMA32(cq.qf[mt][1][1], pack8(S1, 1), op);
        if ((wv & 1) == mt) op = MFMA32(cq.af, vP, op);
#pragma unroll
        for (int r = 0; r < 16; ++r) rw[(32 * mt + crow(r, h)) * 32 + el] = op[r];
    }
    asm volatile("" ::: "memory");
    if (!SAMPLE) scan_load_q(cq, F.ws, cidn, hd, wv, lane);
    ScanTr T; scan_tr_reads_n(T, tro + (unsigned)(8 * h * 64));
#pragma unroll
    for (int sp = 0; sp < 4; ++sp) { u32x4 vv; vv.x = T.n[2 * sp].x; vv.y = T.n[2 * sp].y; vv.z = T.n[2 * sp + 1].x; vv.w = T.n[2 * sp + 1].y;
        const bf16x8 vN = __builtin_bit_cast(bf16x8, vv);
        S0 = MFMA32(ck.kf[0][sp], vN, S0); S1 = MFMA32(ck.kf[1][sp], vN, S1); }
    asm volatile("" ::: "memory");
    if (!SAMPLE) scan_load_k(ck, F.ws, cidn, hd, wv, lane);
#pragma unroll
    for (int rg = 0; rg < 4; ++rg) { const f32x4 e0v = *(const LAS f32x4*)(VECL + 512 + 64 * wv + 8 * rg + 4 * h), e1v = *(const LAS f32x4*)(VECL + 512 + 64 * wv + 32 + 8 * rg + 4 * h);
#pragma unroll
        for (int x = 0; x < 4; ++x) { S0[4 * rg + x] *= e0v[x]; S1[4 * rg + x] *= e1v[x]; } }
    if (!SAMPLE) scan_store_v(F.lds + (BUF ^ 1) * SC_BUF, nvt, nvec, tid);
}
template <bool SAMPLE, bool DUMMY = false>
__device__ __forceinline__ void scan_item(Frame& F, int seq, int slice) {
    const int tid = F.tid, lane = F.lane, wv = F.wave, h = lane >> 5, el = lane & 31;
    const int hd = seq & 3, b = seq >> 2, e0 = slice * 32;
    const int nchunks = SAMPLE ? 1 : 128, cid0 = SAMPLE ? 256 + b : b * 128, ntok = SAMPLE ? 16 : 64, row00 = SAMPLE ? MP + 16 * b : b * SEQ;
    ScanQ qa; ScanK ka;
    scan_load_q(qa, F.ws, cid0, hd, wv, lane);
    scan_load_k(ka, F.ws, cid0, hd, wv, lane);
    { u32x4 vt; f32x4 vec; scan_load_v(vt, vec, F.ws, F.PROJ, cid0, hd, row00, ntok, e0, tid); scan_store_v(F.lds, vt, vec, tid); }
    f32x16 S0, S1;
#pragma unroll
    for (int r = 0; r < 16; ++r) { S0[r] = 0.f; S1[r] = 0.f; }
    if (SAMPLE) { const float* sp = F.in[I_SG] + ((size_t)(b * 4 + hd) * 512 + 64 * wv + 4 * h) * 1024 + e0 + el;
#pragma unroll
        for (int rg = 0; rg < 4; ++rg) {
#pragma unroll
            for (int x = 0; x < 4; ++x) { S0[4 * rg + x] = sp[(size_t)(8 * rg + x) * 1024]; S1[4 * rg + x] = sp[(size_t)(32 + 8 * rg + x) * 1024]; }
            asm volatile("" ::: "memory"); } }
    if (SAMPLE) { scan_step<true, DUMMY, 0>(F, S0, S1, qa, ka, cid0, hd, -1, row00, ntok, e0); __syncthreads(); scan_reduce<DUMMY, 0>(F, hd, row00, ntok, e0); __syncthreads(); }
    else {
#pragma unroll 1
        for (int c = 0; c < nchunks; c += 2) {
            const int c2 = c + 2 < nchunks ? c + 2 : c + 1;
            scan_step<false, DUMMY, 0>(F, S0, S1, qa, ka, cid0 + c + 1, hd, c > 0 ? row00 + 64 * (c - 1) : -1, row00 + 64 * (c + 1), ntok, e0);
            scan_step<false, DUMMY, 1>(F, S0, S1, qa, ka, cid0 + c2, hd, row00 + 64 * c, row00 + 64 * c2, ntok, e0);
        }
        __syncthreads();
        scan_reduce<DUMMY, 1>(F, hd, row00 + 64 * (nchunks - 1), ntok, e0);
        __syncthreads();
    }
    { int h2 = h; asm volatile("" : "+v"(h2));
      float* so = F.out + (SAMPLE ? OUT_SGS : OUT_SGP) + ((size_t)(b * 4 + hd) * 512) * 1024 + e0 + (lane & 31) + (size_t)(64 * wv + 4 * h2) * 1024;
#pragma unroll
      for (int r = 0; r < 16; ++r) { so[(size_t)((r & 3) + 8 * (r >> 2)) * 1024] = S0[r]; so[(size_t)(32 + (r & 3) + 8 * (r >> 2)) * 1024] = S1[r]; } }
}
__device__ __forceinline__ void p4_phase(Frame& F) {
#if PROBE_TWICE == 104
    for (int it = F.bid; it < 256; it += F.G) scan_item<false, true>(F, it >> 5, it & 31);
#endif
    for (int it = F.bid; it < 256; it += F.G) scan_item<false>(F, it & 7, (it >> 3) & 31);
    { int t_ = threadIdx.x; asm volatile("" : "+v"(t_)); F.tid = t_; F.lane = t_ & 63; F.wave = __builtin_amdgcn_readfirstlane(t_ >> 6); }
    for (int it = F.bid; it < 1024; it += F.G) scan_item<true>(F, (it & 7) + 8 * (it >> 8), (it >> 3) & 31);
}

__device__ __forceinline__ void unpack8(const u32x4 w, float (&f)[8]) { f[0] = bflo(w.x); f[1] = bfhi(w.x); f[2] = bflo(w.y); f[3] = bfhi(w.y); f[4] = bflo(w.z); f[5] = bfhi(w.z); f[6] = bflo(w.w); f[7] = bfhi(w.w); }
__device__ __forceinline__ void p5_merge(Frame& F) {
    const int gw = F.bid * NWAVES + F.wave, NGW = F.G * NWAVES, lane = F.lane;
    const float* gg = F.in[I_GGLA] + 16 * lane;
    for (int row = gw; row < MPAD; row += NGW) {
        if (row >= MREAL) {
#pragma unroll
            for (int j = 0; j < 8; ++j) *(u32x4*)((unsigned char*)F.H + pg8::img_off(row, 512 * j + 8 * lane, D / 64, false)) = (u32x4){0u, 0u, 0u, 0u};
            continue; }
#pragma unroll 2
        for (int hd = 0; hd < 4; ++hd) {
            const int c = hd * 1024 + 16 * lane;
            const u32x4 wo0 = *(const u32x4*)(F.PROJ + pj(row, C_VA + c)), wo1 = *(const u32x4*)(F.PROJ + pj(row, C_VA + c) + 8);
            const u32x4 wg0 = *(const u32x4*)(F.PROJ + pj(row, C_GA + c)), wg1 = *(const u32x4*)(F.PROJ + pj(row, C_GA + c) + 8);
            const u32x4 wb0 = *(const u32x4*)(F.PROJ + pj(row, C_ZB + c)), wb1 = *(const u32x4*)(F.PROJ + pj(row, C_ZB + c) + 8);
            const u32x4 wq0 = *(const u32x4*)(F.PROJ + pj(row, C_QB + c)), wq1 = *(const u32x4*)(F.PROJ + pj(row, C_QB + c) + 8);
            float o[16], ga[16], zb[16], ob[16];
#define UP16(dst, w0, w1) { float t[8]; unpack8(w0, t); _Pragma("unroll") for (int x = 0; x < 8; ++x) dst[x] = t[x]; unpack8(w1, t); _Pragma("unroll") for (int x = 0; x < 8; ++x) dst[8 + x] = t[x]; }
            UP16(o, wo0, wo1)
            float ss = 0.f;
#pragma unroll
            for (int x = 0; x < 16; ++x) ss += o[x] * o[x];
            const float r = 1.0f / sqrtf(wave_sum(ss) * (1.f / 1024.f) + NORM_EPS);
            UP16(ga, wg0, wg1) UP16(zb, wb0, wb1) UP16(ob, wq0, wq1)
#undef UP16
            float mg[16];
#pragma unroll
            for (int x = 0; x < 16; ++x) mg[x] = (o[x] * r * gg[x]) * ga[x] + zb[x] * ob[x];
            u32x4 w0, w1; w0.x = cvtpk(mg[0], mg[1]); w0.y = cvtpk(mg[2], mg[3]); w0.z = cvtpk(mg[4], mg[5]); w0.w = cvtpk(mg[6], mg[7]);
            w1.x = cvtpk(mg[8], mg[9]); w1.y = cvtpk(mg[10], mg[11]); w1.z = cvtpk(mg[12], mg[13]); w1.w = cvtpk(mg[14], mg[15]);
            *(u32x4*)((unsigned char*)F.H + pg8::img_off(row, c, D / 64, false)) = w0; *(u32x4*)((unsigned char*)F.H + pg8::img_off(row, c + 8, D / 64, false)) = w1;
        }
    }
}

template <int MODE> struct EpiRes {
    static constexpr bool PERM = true;
    const float* srcf; const bf16* srcb; float* outf; bf16* outb; const float* mod; int off_gt;
    __device__ __forceinline__ void operator()(const f32x4 (&acc)[2][2][4][2], const pg8::Unit& u, int wr, int wc, int fr, int fq) const {
        const int col0 = u.pn * 256 + wc * 32 + 8 * fq;
        const float* gt = mod + (size_t)(u.pm >> 5) * NMOD + off_gt + col0;
        f32x4 g[2][2];
#pragma unroll
        for (int bj = 0; bj < 2; ++bj)
#pragma unroll
            for (int n = 0; n < 2; ++n) g[bj][n] = *(const f32x4*)(gt + bj * 128 + n * 4);
#pragma unroll
        for (int ai = 0; ai < 2; ++ai) {
            const size_t rbase = (size_t)(u.pm * 256 + ai * 128 + wr * 64 + fr) * D + col0;
            if (MODE == 0) {
                f32x4 x[4][2][2];
#pragma unroll
                for (int m = 0; m < 4; ++m)
#pragma unroll
                    for (int bj = 0; bj < 2; ++bj)
#pragma unroll
                        for (int n = 0; n < 2; ++n) x[m][bj][n] = *(const f32x4*)(srcf + rbase + (size_t)(m * 16) * D + bj * 128 + n * 4);
#pragma unroll
                for (int m = 0; m < 4; ++m)
#pragma unroll
                    for (int bj = 0; bj < 2; ++bj) { const f32x4 a = x[m][bj][0] + g[bj][0] * acc[ai][bj][m][0], b = x[m][bj][1] + g[bj][1] * acc[ai][bj][m][1];
                        u32x4 w; w.x = cvtpk(a.x, a.y); w.y = cvtpk(a.z, a.w); w.z = cvtpk(b.x, b.y); w.w = cvtpk(b.z, b.w);
                        *(u32x4*)(outb + rbase + (size_t)(m * 16) * D + bj * 128) = w; }
            } else {
                u32x4 x[4][2];
#pragma unroll
                for (int m = 0; m < 4; ++m)
#pragma unroll
                    for (int bj = 0; bj < 2; ++bj) x[m][bj] = *(const u32x4*)(srcb + rbase + (size_t)(m * 16) * D + bj * 128);
#pragma unroll
                for (int m = 0; m < 4; ++m)
#pragma unroll
                    for (int bj = 0; bj < 2; ++bj) { const u32x4 w = x[m][bj];
                        const f32x4 xa = (f32x4){bflo(w.x), bfhi(w.x), bflo(w.y), bfhi(w.y)}, xb = (f32x4){bflo(w.z), bfhi(w.z), bflo(w.w), bfhi(w.w)};
                        const f32x4 a = xa + g[bj][0] * acc[ai][bj][m][0], b = xb + g[bj][1] * acc[ai][bj][m][1];
                        u32x4 o; o.x = cvtpk(a.x, a.y); o.y = cvtpk(a.z, a.w); o.z = cvtpk(b.x, b.y); o.w = cvtpk(b.z, b.w);
                        *(u32x4*)(outb + rbase + (size_t)(m * 16) * D + bj * 128) = o; }
            }
        }
    }
};
template <int K, int MODE, bool BIMG, bool AIMG>
__device__ __forceinline__ void skinny_res(Frame& F, const bf16* A, const bf16* Bt, const float* srcf, const bf16* srcb, float* dstf, bf16* dstb, int off_gt) {
    const int lane = F.lane, wv = F.wave, fr = lane & 15, fq = lane >> 4;
    for (int nb = F.bid; nb < D / 16; nb += F.G) {
        const bf16* ap = A + (size_t)(MP + 16 * wv + fr) * K + 8 * fq;
        const int nrow = 16 * nb + fr;
        int sl = nrow & 127; { const int m = sl & 31; sl = (sl & ~31) + 16 * ((m >> 2) & 1) + 4 * (m >> 3) + (m & 3); }
        const unsigned char* bimg = (const unsigned char*)Bt + (size_t)(nrow >> 7) * (K / 64) * (size_t)pg8::HTB;
        const int oc0 = pg8::lds_byte(sl, 8 * fq), oc1 = pg8::lds_byte(sl, 32 + 8 * fq);
        const bf16* bp = Bt + (size_t)nrow * K + 8 * fq;
        const int arow = MP + 16 * wv + fr;
        const unsigned char* aimg = (const unsigned char*)A + (size_t)(arow >> 7) * (K / 64) * (size_t)pg8::HTB;
        const int ac0 = pg8::lds_byte(arow & 127, 8 * fq), ac1 = pg8::lds_byte(arow & 127, 32 + 8 * fq);
#define SK_ALOAD(kk, u) (AIMG ? *(const bf16x8*)(aimg + (size_t)(((kk) >> 6) + ((u) >> 1)) * pg8::HTB + (((u) & 1) ? ac1 : ac0)) : *(const bf16x8*)(ap + (kk) + 32 * (u)))
#define SK_BLOAD(kk, u) (BIMG ? *(const bf16x8*)(bimg + (size_t)(((kk) >> 6) + ((u) >> 1)) * pg8::HTB + (((u) & 1) ? oc1 : oc0)) : *(const bf16x8*)(bp + (kk) + 32 * (u)))
        f32x4 acc0 = (f32x4){0.f, 0.f, 0.f, 0.f}, acc1 = acc0;
        bf16x8 a[8], b[8], a2[8], b2[8];
#pragma unroll
        for (int u = 0; u < 8; ++u) { a[u] = SK_ALOAD(0, u); b[u] = SK_BLOAD(0, u); }
#pragma unroll 1
        for (int k = 0; k < K; k += 512) {
            const int k1 = k + 256 < K ? k + 256 : k, k2 = k + 512 < K ? k + 512 : k1;
#pragma unroll
            for (int u = 0; u < 8; ++u) { a2[u] = SK_ALOAD(k1, u); b2[u] = SK_BLOAD(k1, u); }
#pragma unroll
            for (int u = 0; u < 8; u += 2) { acc0 = __builtin_amdgcn_mfma_f32_16x16x32_bf16(b[u], a[u], acc0, 0, 0, 0); acc1 = __builtin_amdgcn_mfma_f32_16x16x32_bf16(b[u + 1], a[u + 1], acc1, 0, 0, 0); }
#pragma unroll
            for (int u = 0; u < 8; ++u) { a[u] = SK_ALOAD(k2, u); b[u] = SK_BLOAD(k2, u); }
            if (k + 256 < K) {
#pragma unroll
                for (int u = 0; u < 8; u += 2) { acc0 = __builtin_amdgcn_mfma_f32_16x16x32_bf16(b2[u], a2[u], acc0, 0, 0, 0); acc1 = __builtin_amdgcn_mfma_f32_16x16x32_bf16(b2[u + 1], a2[u + 1], acc1, 0, 0, 0); } }
        }
        const int row = MP + 16 * wv + fr, col = 16 * nb + 4 * fq;
        const f32x4 g = *(const f32x4*)(F.MOD + (size_t)row_batch(row) * NMOD + off_gt + col), r = g * (acc0 + acc1);
        if (MODE == 0) { const f32x4 x = *(const f32x4*)(srcf + (size_t)(row - MP) * D + col) + r; u32x2 w; w.x = cvtpk(x.x, x.y); w.y = cvtpk(x.z, x.w); *(u32x2*)(dstb + (size_t)row * D + col) = w; }
        else { const u32x2 w = *(const u32x2*)(srcb + (size_t)row * D + col); const f32x4 x = (f32x4){bflo(w.x), bfhi(w.x), bflo(w.y), bfhi(w.y)} + r;
            u32x2 o; o.x = cvtpk(x.x, x.y); o.y = cvtpk(x.z, x.w); *(u32x2*)(dstb + (size_t)row * D + col) = o; }
    }
}

struct EpiGU {
    static constexpr bool PERM = true;
    bf16* ACT;
    __device__ __forceinline__ void operator()(const f32x4 (&acc)[2][2][4][2], const pg8::Unit& u, int wr, int wc, int fr, int fq) const {
#pragma unroll
        for (int ai = 0; ai < 2; ++ai)
#pragma unroll
            for (int m = 0; m < 4; ++m) {
                const int row = u.pm * 256 + ai * 128 + wr * 64 + m * 16 + fr;
                const f32x4 g0 = acc[ai][0][m][0], g1 = acc[ai][0][m][1], u0 = acc[ai][1][m][0], u1 = acc[ai][1][m][1];
                float a[8];
#pragma unroll
                for (int x = 0; x < 4; ++x) { a[x] = g0[x] * sigmoidf_(g0[x]) * u0[x]; a[4 + x] = g1[x] * sigmoidf_(g1[x]) * u1[x]; }
                u32x4 w; w.x = cvtpk(a[0], a[1]); w.y = cvtpk(a[2], a[3]); w.z = cvtpk(a[4], a[5]); w.w = cvtpk(a[6], a[7]);
                *(u32x4*)((unsigned char*)ACT + pg8::img_off(row, u.pn * 128 + wc * 32 + 8 * fq, DFF / 64, false)) = w;
            }
    }
};
__device__ __forceinline__ void p10_final(Frame& F, const bf16* X2B) {
    const int gw = F.bid * NWAVES + F.wave, NGW = F.G * NWAVES;
    for (int row = gw; row < MREAL; row += NGW) {
        const GAS u32x2* xr = (const GAS u32x2*)(X2B + (size_t)row * D) + F.lane;
        GAS f32x4* yr = (GAS f32x4*)(F.out + (size_t)row * D) + F.lane;
        f32x4 v[16]; float s = 0.f;
#pragma unroll
        for (int j = 0; j < 16; ++j) { const u32x2 w = xr[64 * j]; v[j] = (f32x4){bflo(w.x), bfhi(w.x), bflo(w.y), bfhi(w.y)}; s += (v[j].x * v[j].x + v[j].y * v[j].y) + (v[j].z * v[j].z + v[j].w * v[j].w); }
        const float r = 1.0f / sqrtf(wave_sum(s) * (1.f / D) + NORM_EPS);
#pragma unroll
        for (int j = 0; j < 16; ++j) { const f32x4 gg = *(const f32x4*)(F.in[I_GF] + 256 * j + 4 * F.lane); yr[64 * j] = (v[j] * r) * gg; }
    }
}

#if DBG_CHECK
__device__ __forceinline__ unsigned hash32(unsigned x) { x ^= x >> 16; x *= 0x7feb352du; x ^= x >> 15; x *= 0x846ca68bu; x ^= x >> 16; return x; }
__device__ __forceinline__ void dbg_report(Frame& F, int k, float e) { if (!(e == e) || e > 1e30f) e = 1e30f; atomicMax((unsigned*)F.DBG + k, __float_as_uint(e)); }
__device__ __forceinline__ float relerr(float got, float ref, float floor_) { return fabsf(got - ref) / (fabsf(ref) + floor_); }
__device__ __forceinline__ int win_fwd(int c) {
    if (c < 12288) return c;
    if (c < 12304) return 25600 + (c - 12288);
    if (c < 16912) { const bool isq = c < 16400; const int r = c - (isq ? 12304 : 16400), hh = r >> 6, d = r & 63;
        const int t = (d & 31) >> 2, e = (d & 3) + 4 * (d >> 5); return (isq ? 12288 : 16384) + 64 * hh + 8 * t + e; }
    return c - 16;
}
__device__ __forceinline__ int win_fwd_w(int c) {
    if (c >= 8192 && c < 12288) { const int i = c - 8192, ct = i >> 7; return (ct < 16 ? 8192 + 256 * ct : 17408 + 256 * (ct - 16)) + (i & 127); }
    if (c >= 17424 && c < 21520) { const int i = c - 17424, ct = i >> 7; return (ct < 16 ? 8192 + 256 * ct : 17408 + 256 * (ct - 16)) + 128 + (i & 127); }
    return win_fwd(c);
}
__device__ __forceinline__ int wgu_fwd(int c) { if (c < DFF) return 256 * (c >> 7) + (c & 127); const int c2 = c - DFF; return 256 * (c2 >> 7) + 128 + (c2 & 127); }
__device__ __forceinline__ float silu_ref(float x) { return x / (1.f + expf(-x)); }
__device__ __forceinline__ float cvec(const Frame& F, int b, int k) { return b < 2 ? F.in[I_CP][b * D + k] : F.in[I_CS][(b - 2) * D + k]; }
__device__ __forceinline__ float bfround(float x) { return bflo(cvtpk(x, 0.f)); }
__device__ __forceinline__ float dbg_h(const Frame& F, int row, int k) { return bf2f(*(const bf16*)((const unsigned char*)F.H + pg8::img_off(row, k & ~7, D / 64, false) + 2 * (k & 7))); }

__device__ __forceinline__ void dbg_check_p0p1(Frame& F) {
    const int gt = F.bid * NTHR + F.tid;
    if (gt < 512) {
        const unsigned h = hash32(gt * 7919u + 13u); const int b = gt % 10, col = (int)(h % NMOD);
        float s = 0.f; for (int k = 0; k < D; ++k) s += silu_ref(cvec(F, b, k)) * F.in[I_WADA][(size_t)k * NMOD + col];
        s += F.in[I_BADA][col];
        dbg_report(F, 0, relerr(F.MOD[b * NMOD + col], s, 0.05f));
    } else if (gt < 1024) {
        const unsigned h = hash32(gt * 31u + 5u); const int pos = (int)(h % 8192u), f = (int)((h >> 16) % 32u);
        const double inv = pow(10000.0, -(double)f / 32.0), a = (double)pos * inv;
        dbg_report(F, 1, fmaxf(fabsf(F.ROPEC[pos * 32 + f] - (float)cos(a)), fabsf(F.ROPES[pos * 32 + f] - (float)sin(a))) * 0.2f);
    } else if (gt < 1024 + 4096) {
        const int i = gt - 1024; const unsigned h = hash32(i * 2654435761u + 77u), h2 = hash32(h + 12345u);
        const int which = 0; float ref, got;
        if (which == 0) { const int k = (int)(h % D), c = (int)(h2 % N_IN); ref = bfround(F.in[I_WIN][(size_t)k * N_IN + c]); got = bf2f(*(const bf16*)((const unsigned char*)F.WIN + pg8::img_off(win_fwd_w(c), k & ~7, D / 64, true) + 2 * (k & 7))); }
        else if (which == 1) { const int k = (int)(h % D), c = (int)(h2 % D); ref = bfround(F.in[I_WOUT][(size_t)k * D + c]); got = bf2f(*(const bf16*)((const unsigned char*)F.WOUT + pg8::img_off(c, k & ~7, D / 64, true) + 2 * (k & 7))); }
        else if (which == 2) { const int k = (int)(h % D), c = (int)(h2 % N_GU); ref = bfround(F.in[I_WGU][(size_t)k * N_GU + c]); got = bf2f(*(const bf16*)((const unsigned char*)F.WGU + pg8::img_off(wgu_fwd(c), k & ~7, D / 64, true) + 2 * (k & 7))); }
        else { const int k = (int)(h % DFF), c = (int)(h2 % D); ref = bfround(F.in[I_WDN][(size_t)k * D + c]); got = bf2f(*(const bf16*)((const unsigned char*)F.WDN + pg8::img_off(c, k & ~7, DFF / 64, true) + 2 * (k & 7))); }
        dbg_report(F, 2, fabsf(got - ref) * 100.f);
        if (i < 240) { const int k = (int)(h % D); dbg_report(F, 2, fabsf(bf2f(*(const bf16*)((const unsigned char*)F.WIN + pg8::img_off(25616 + i, k & ~7, D / 64, true) + 2 * (k & 7)))) * 100.f); }
    } else if (gt < 1024 + 4096 + 96) {
        const int i = gt - 5120; const unsigned h = hash32(i * 977u + 3u);
        const int row = i < 64 ? (int)(h % MP) : (i < 88 ? MP + (int)(h % MS) : MREAL + (int)(h % 128u));
        if (row >= MREAL) { float m = 0.f; for (int c = 0; c < D; ++c) m = fmaxf(m, fabsf(dbg_h(F, row, c))); dbg_report(F, 3, m); }
        else { const float* x = x_row(F, row); float s = 0.f; for (int c = 0; c < D; ++c) s += x[c] * x[c];
            const float r = 1.f / sqrtf(s / D + NORM_EPS); const float* mod = F.MOD + row_batch(row) * NMOD; float e = 0.f;
            for (int c = 0; c < D; ++c) { const float y = x[c] * r * F.in[I_G1][c] * (1.f + mod[D + c]) + mod[c]; e = fmaxf(e, relerr(dbg_h(F, row, c), y, 0.2f)); }
            dbg_report(F, 3, e); }
    }
}
__device__ __forceinline__ float dbg_dot_h_win(Frame& F, int row, int c) { float s = 0.f; const float* w = F.in[I_WIN] + c; for (int k = 0; k < D; ++k) s += dbg_h(F, row, k) * w[(size_t)k * N_IN]; return s; }
__device__ __forceinline__ void dbg_check_p2(Frame& F) {
    const int gt = F.bid * NTHR + F.tid;
    if (gt >= 2048) return;
    const unsigned h = hash32(gt * 2246822519u + 99u), h2 = hash32(h ^ 0x9e3779b9u);
    int row = (gt & 7) == 7 ? MP + (int)(h % MS) : (int)(h % MP);
    int c;
    const int cls = gt % 5;
    if (cls == 0) c = (int)(h2 % N_IN); else if (cls == 1) c = O_QB + (int)(h2 % 4096u); else if (cls == 2) c = O_KB + (int)(h2 % 512u); else if (cls == 3) c = O_VB + (int)(h2 % 512u); else c = O_RA + (int)(h2 % 16u);
    if (gt >= 1024) {
        if (cls != 2 && cls != 3) return;
        if (gt & 8) { const int b = (h >> 3) & 1, tt = 8064 + (int)((h >> 8) % 128u); row = b * 8192 + tt; } else row = MP + (int)(h % MS);
    }
    const bool isq = c >= O_QB && c < O_KB, isk = c >= O_KB && c < O_VB, isv = c >= O_VB && c < O_VB + 512;
    float ref;
    if (isq || isk) { const int base = isq ? O_QB : O_KB, r = c - base, hh = r >> 6, d = r & 63, dl = d & 31;
        const float x1 = dbg_dot_h_win(F, row, base + 64 * hh + dl), x2 = dbg_dot_h_win(F, row, base + 64 * hh + dl + 32);
        const double inv = pow(10000.0, -(double)dl / 32.0), a = (double)row_pos(row) * inv; const float cs = (float)cos(a), sn = (float)sin(a);
        ref = d < 32 ? x1 * cs - x2 * sn : x2 * cs + x1 * sn; }
    else ref = dbg_dot_h_win(F, row, c);
    if (gt < 1024) {
        int pc = win_fwd(c);
        if ((c >= 8192 && c < 12288) || (c >= 17424 && c < 21520)) { const int i = c >= 17424 ? c - 17424 : c - 8192; const float gv = dbg_dot_h_win(F, row, 8192 + i), zv = dbg_dot_h_win(F, row, 17424 + i);
            ref = silu_ref(gv) / (1.f + expf(-zv)); pc = C_GA + i; }
        else if (c >= 21520) ref = 1.f / (1.f + expf(-ref));
        const float got = bf2f(F.PROJ[pj(row, pc)]); dbg_report(F, 4, relerr(got, isq ? ref * QSCALE : ref, 1.0f)); }
    else { const int r = c - (isk ? O_KB : O_VB), g = r >> 6, d = r & 63; long o;
        if (row < MP) o = (isk ? OUT_KP : OUT_VP) + ((long)(((row >> 13) * 128 + ((row & 8191) - 8064)) * 8 + g)) * 64 + d;
        else { const int r2 = row - MP; o = (isk ? OUT_KS : OUT_VS) + ((long)(((r2 >> 4) * 16 + (r2 & 15)) * 8 + g)) * 64 + d; }
        dbg_report(F, 5, relerr(F.out[o], ref, 1.0f)); }
}
__device__ __forceinline__ float logsig_ref(float x) { return x < 0.f ? x - log1pf(expf(x)) : -log1pf(expf(-x)); }
__device__ __forceinline__ float dbg_bcum(Frame& F, int row0, int ntok, int hd, int d, int upto) {
    float bc = 0.f; const float bias = F.in[I_BGK][hd * 512 + d];
    for (int t = 0; t <= upto && t < ntok; ++t) { float gk = bias; const bf16* ra = F.PROJ + pj(row0 + t, C_RA);
        for (int r = 0; r < 16; ++r) gk += bf2f(ra[r]) * F.in[I_WGK][r * 2048 + hd * 512 + d];
        bc += logsig_ref(gk) * (1.f / 16.f); }
    return bc;
}
__device__ __forceinline__ float dbg_qfrag(Frame& F, int cid, int hd, int i, int d) { const int w = d >> 6, dl = d & 63, dt = dl >> 5, r32 = dl & 31, s = r32 >> 4, r16 = r32 & 15, h = (r16 >> 2) & 1, jj = (r16 & 3) + 4 * (r16 >> 3);
    const int mt = i >> 5, ln = (i & 31) + 32 * h, fb = ((w * 2 + mt) * 2 + dt) * 2 + s; return bf2f(((const bf16*)(F.ws + WS_FRAG + (size_t)(cid * 4 + hd) * 131072))[fb * 512 + ln * 8 + jj]); }
__device__ __forceinline__ float dbg_kfrag(Frame& F, int cid, int hd, int j, int d) { const int w = d >> 6, dt = (d >> 5) & 1, dl = d & 31, sp = j >> 4, h = (j >> 3) & 1, jj = j & 7;
    const int ln = dl + 32 * h, fb = (w * 2 + dt) * 4 + sp; return bf2f(((const bf16*)(F.ws + WS_FRAG + (size_t)(cid * 4 + hd) * 131072 + 65536))[fb * 512 + ln * 8 + jj]); }
__device__ __forceinline__ float dbg_afrag(Frame& F, int cid, int hd, int i, int j) { const int it = i >> 5, jt = j >> 5, jl = j & 31, s = jl >> 4, r16 = jl & 15, h = (r16 >> 2) & 1, jj = (r16 & 3) + 4 * (r16 >> 3);
    const int blk = it + 2 * (2 * jt + s), ln = (i & 31) + 32 * h; return bf2f(((const bf16*)(F.ws + WS_AMAT + (size_t)(cid * 4 + hd) * 8192))[blk * 512 + ln * 8 + jj]); }
__device__ __forceinline__ void dbg_check_cl(Frame& F) {
    const int gt = F.bid * NTHR + F.tid;
    if (gt >= 2048) return;
    const unsigned hs = hash32(gt * 40503u + 17u), h2 = hash32(hs + 0x51ed27u);
    const int cid = (gt & 7) == 7 ? 256 + (int)(hs % 8u) : (int)(hs % 256u), hd = (int)((hs >> 8) & 3u);
    const int ntok = cid < 256 ? 64 : 16, row0 = cid < 256 ? cid * 64 : MP + 16 * (cid - 256), mid = ntok >> 1;
    const int i = (int)((hs >> 10) % (unsigned)ntok), j = (int)((h2) % (unsigned)ntok), d = (int)((h2 >> 8) % 512u);
    if (gt >= 256) {
        const float bi = dbg_bcum(F, row0, ntok, hd, d, i), bj = dbg_bcum(F, row0, ntok, hd, d, j), bm = dbg_bcum(F, row0, ntok, hd, d, mid), bl = dbg_bcum(F, row0, ntok, hd, d, 63);
        const float q = bf2f(F.PROJ[pj(row0 + i, C_QA + hd * 512 + d)]), k = bf2f(F.PROJ[pj(row0 + j, C_KA + hd * 512 + d)]);
        dbg_report(F, 6, relerr(dbg_qfrag(F, cid, hd, i, d), q * GLA_QSCALE * expf(bi - bm), 0.02f));
        dbg_report(F, 6, relerr(dbg_kfrag(F, cid, hd, j, d), k * expf(bm - bj), 0.3f));
        const float* VEC = (const float*)(F.ws + WS_VEC) + (size_t)(cid * 4 + hd) * 1024;
        dbg_report(F, 6, relerr(VEC[d], expf(bm), 0.01f)); dbg_report(F, 6, relerr(VEC[512 + d], expf(bl - bm), 0.01f));
        if (cid >= 256) { dbg_report(F, 6, fabsf(dbg_qfrag(F, cid, hd, 16 + (i % 48), d))); dbg_report(F, 6, fabsf(dbg_kfrag(F, cid, hd, 16 + (j % 48), d))); }
    } else {
        float s = 0.f;
        for (int dd = 0; dd < 512; ++dd) { float bi = 0.f, bj = 0.f, bm = 0.f, bc = 0.f; const float bias = F.in[I_BGK][hd * 512 + dd];
            for (int t = 0; t < ntok; ++t) { float gk = bias; const bf16* ra = F.PROJ + pj(row0 + t, C_RA);
                for (int r = 0; r < 16; ++r) gk += bf2f(ra[r]) * F.in[I_WGK][r * 2048 + hd * 512 + dd];
                bc += logsig_ref(gk) * (1.f / 16.f); if (t == i) bi = bc; if (t == j) bj = bc; if (t == mid) bm = bc; }
            const float q = bf2f(F.PROJ[pj(row0 + i, C_QA + hd * 512 + dd)]), k = bf2f(F.PROJ[pj(row0 + j, C_KA + hd * 512 + dd)]);
            s += bfround(q * GLA_QSCALE * expf(bi - bm)) * bfround(k * expf(bm - bj)); }
        if (j > i) s = 0.f;
        dbg_report(F, 6, relerr(dbg_afrag(F, cid, hd, i, j), s, 0.1f));
    }
}
__device__ __forceinline__ void dbg_check_swa(Frame& F) {
    LAS float* part = (LAS float*)F.lds;
    LAS float* qh = part + 512;
    LAS float* lg = qh + 64;
    LAS float* sm = lg + 192;
    const int tid = F.tid; const unsigned hs = hash32(F.bid * 7349u + 1234567u);
    const bool smp = (F.bid & 3) == 3;
    int row, b, tt;
    if (!smp) { b = hs & 1; tt = (F.bid & 7) == 0 ? (int)((hs >> 4) % 128u) : (int)((hs >> 4) % 8192u); row = b * SEQ + tt; } else { b = (hs >> 1) & 7; tt = (hs >> 4) & 15; row = MP + 16 * b + tt; }
    const int head = (int)((hs >> 20) & 63u), g = head >> 3;
    { const int d = tid >> 3, pt = tid & 7; float s = 0.f; const float* w = F.in[I_WIN] + O_QB + head * 64 + d;
      for (int k = 512 * pt; k < 512 * pt + 512; ++k) s += dbg_h(F, row, k) * w[(size_t)k * N_IN];
      part[d * 8 + pt] = s; }
    __syncthreads();
    float xq = 0.f; if (tid < 64) { for (int p = 0; p < 8; ++p) xq += part[tid * 8 + p]; }
    __syncthreads();
    if (tid < 64) part[tid] = xq;
    __syncthreads();
    if (tid < 64) { const int dl = tid & 31; const double inv = pow(10000.0, -(double)dl / 32.0), a = (double)row_pos(row) * inv; const float cs = (float)cos(a), sn = (float)sin(a);
        const float x1 = part[dl], x2 = part[dl + 32]; qh[tid] = (tid < 32 ? x1 * cs - x2 * sn : x2 * cs + x1 * sn) * QSCALE; }
    __syncthreads();
    int nk, kr0 = 0;
    if (!smp) { const int n = tt >> 6; nk = 64 * (n + 1 < 3 ? n + 1 : 3); kr0 = b * SEQ + 64 * (n > 2 ? n - 2 : 0); } else nk = 144;
    if (tid < nk) { float s = 0.f;
        for (int d = 0; d < 64; ++d) { float kv;
            if (smp && tid < 128) kv = bfround(F.in[I_CK][((size_t)(b * 128 + tid) * 8 + g) * 64 + d]);
            else { const int krow = smp ? MP + 16 * b + (tid - 128) : kr0 + tid; const int p = 8 * ((d & 31) >> 2) + (d & 3) + 4 * (d >> 5); kv = bf2f(F.PROJ[pj(krow, C_KB + g * 64 + p)]); }
            s += qh[d] * kv; }
        lg[tid] = s; }
    __syncthreads();
    if (tid == 0) { const float sk = F.in[I_SINK][head] * LOG2E; float m = sk; for (int k = 0; k < nk; ++k) m = fmaxf(m, lg[k]); float su = exp2f(sk - m); for (int k = 0; k < nk; ++k) su += exp2f(lg[k] - m); sm[0] = m; sm[1] = su; }
    __syncthreads();
    if (tid < 64) { float o = 0.f; const float m = sm[0];
        for (int k = 0; k < nk; ++k) { float vv;
            if (smp && k < 128) vv = bfround(F.in[I_CV][((size_t)(b * 128 + k) * 8 + g) * 64 + tid]);
            else { const int krow = smp ? MP + 16 * b + (k - 128) : kr0 + k; vv = bf2f(F.PROJ[pj(krow, C_VB + g * 64 + tid)]); }
            o += exp2f(lg[k] - m) * vv; }
        o /= sm[1];
        dbg_report(F, 7, relerr(bf2f(F.PROJ[pj(row, C_QB + head * 64 + tid)]), o, 0.3f)); }
    __syncthreads();
}
constexpr size_t WS_DBGV = 1596 * MiB;
__device__ __forceinline__ void dbg_check_scan(Frame& F) {
    LAS float* red = (LAS float*)F.lds;
    const int tid = F.tid; const unsigned hs = hash32(F.bid * 92821u + 777u);
    const bool smp = (F.bid & 1) == 1;
    const int b = smp ? (int)((hs >> 2) & 7u) : (int)((hs >> 2) & 1u), hd = (int)((hs >> 6) & 3u), e = (int)((hs >> 8) & 1023u);
    const int T = smp ? 16 : SEQ, row00 = smp ? MP + 16 * b : b * SEQ;
    float* vcol = (float*)(F.ws + WS_DBGV) + (size_t)F.bid * SEQ;
    for (int t = tid; t < T; t += NTHR) { float s = 0.f; const float* w = F.in[I_WIN] + C_VA + hd * 1024 + e;
        for (int k = 0; k < D; ++k) s += dbg_h(F, row00 + t, k) * w[(size_t)k * N_IN];
        vcol[t] = s; }
    __syncthreads();
    const int d = tid; float wg[16];
#pragma unroll
    for (int r = 0; r < 16; ++r) wg[r] = F.in[I_WGK][r * 2048 + hd * 512 + d];
    const float bias = F.in[I_BGK][hd * 512 + d];
    float S = smp ? F.in[I_SG][((size_t)(b * 4 + hd) * 512 + d) * 1024 + e] : 0.f;
    for (int t = 0; t < T; ++t) {
        const int row = row00 + t;
        const u32x4 ra0 = *(const u32x4*)(F.PROJ + pj(row, C_RA)), ra1 = *(const u32x4*)(F.PROJ + pj(row, C_RA) + 8);
        float gk = bias + bflo(ra0.x) * wg[0] + bfhi(ra0.x) * wg[1] + bflo(ra0.y) * wg[2] + bfhi(ra0.y) * wg[3] + bflo(ra0.z) * wg[4] + bfhi(ra0.z) * wg[5] + bflo(ra0.w) * wg[6] + bfhi(ra0.w) * wg[7]
                 + bflo(ra1.x) * wg[8] + bfhi(ra1.x) * wg[9] + bflo(ra1.y) * wg[10] + bfhi(ra1.y) * wg[11] + bflo(ra1.z) * wg[12] + bfhi(ra1.z) * wg[13] + bflo(ra1.w) * wg[14] + bfhi(ra1.w) * wg[15];
        const float a = expf(logsig_ref(gk) * (1.f / 16.f));
        S = a * S + bf2f(F.PROJ[pj(row, C_KA + hd * 512 + d)]) * vcol[t];
        const bool chk = smp || t < 2 || t == 31 || t == 63 || t == 64 || t == 65 || t == 127 || t == 128 || t == 1000 || t == 4095 || t == 8191;
        if (chk) { red[tid] = bf2f(F.PROJ[pj(row, C_QA + hd * 512 + d)]) * GLA_QSCALE * S; __syncthreads();
            if (tid == 0) { float o = 0.f; for (int x = 0; x < 512; ++x) o += red[x]; const float got = bf2f(F.PROJ[pj(row, C_VA + hd * 1024 + e)]); dbg_report(F, 8, relerr(got, o, 5.0f)); atomicAdd(F.DBG + 32, (got - o) * (got - o)); atomicAdd(F.DBG + 33, o * o); }
            __syncthreads(); }
    }
    { const float got = F.out[(smp ? OUT_SGS : OUT_SGP) + ((size_t)(b * 4 + hd) * 512 + d) * 1024 + e]; dbg_report(F, 8, relerr(got, S, 5.0f));
      const float se = wave_sum((got - S) * (got - S)), sr = wave_sum(S * S); if (F.lane == 0) { atomicAdd(F.DBG + 34, se); atomicAdd(F.DBG + 35, sr); } }
}

constexpr int DBG_NCHECK = 11;
__device__ __forceinline__ void dbg_final(Frame& F) {
    if (F.bid != 0 || F.tid != 0) return;
    const float tol[DBG_NCHECK] = {2e-3f, 1e-3f, 1e-3f, 1e-2f, 3e-2f, 3e-2f, 2e-2f, 3e-2f, 3e-2f, 1e-2f, 1e-2f};
    for (int k = 0; k < DBG_NCHECK; ++k) { float e = __uint_as_float(__hip_atomic_load((unsigned*)F.DBG + k, RLX_AGENT));
        if (k == 9) e = sqrtf(F.DBG[32] / F.DBG[33]); if (k == 10) e = sqrtf(F.DBG[34] / F.DBG[35]);
        if (!(e <= tol[k])) { const int m = e >= 1.f ? 9 : e >= 0.3f ? 8 : e >= 0.1f ? 7 : e >= 0.03f ? 6 : e >= 0.01f ? 5 : e >= 0.003f ? 4 : e >= 0.001f ? 3 : e >= 3e-4f ? 2 : 1;
            float x = (1.f + 0.1f * m) * 1e4f; for (int j = 0; j < k; ++j) x *= 10.f; F.out[0] = x; return; } }
}
#endif

#define PHASE_BEGIN() do { int t_ = threadIdx.x; asm volatile("" : "+v"(t_)); F.tid = t_; F.lane = t_ & 63; F.wave = __builtin_amdgcn_readfirstlane(t_ >> 6); } while (0)
__global__ void __launch_bounds__(NTHR, 2) mega_fwd(Args args) {
    extern __shared__ __attribute__((aligned(16))) unsigned char lds[];
    Frame F;
    F.lds = (LAS unsigned char*)lds;
    F.MISC = (volatile LAS unsigned*)(F.lds + MISC_OFF);
    F.tid = threadIdx.x; F.lane = F.tid & 63; F.wave = __builtin_amdgcn_readfirstlane(F.tid >> 6);
    F.G = gridDim.x; F.bid = blockIdx.x;
    unsigned char* ws = args.ws; F.ws = ws; F.out = args.out;
#pragma unroll
    for (int i = 0; i < 20; ++i) F.in[i] = args.in[i];
    F.ctl = (gu32*)(ws + WS_CTL);
    F.MOD = (float*)(ws + WS_MOD); F.ROPEC = (float*)(ws + WS_ROPE); F.ROPES = (float*)(ws + WS_ROPE + MiB); F.SC = (float*)(ws + WS_SC); F.DBG = (float*)(ws + WS_DBG);
    F.WIN = (bf16*)(ws + WS_WIN); F.WOUT = (bf16*)(ws + WS_WOUT); F.WGU = (bf16*)(ws + WS_WGU); F.WDN = (bf16*)(ws + WS_WDN); F.H = (bf16*)(ws + WS_H); F.PROJ = (bf16*)(ws + WS_PROJ);
    for (int u = F.tid; u < 64; u += NTHR) ((LAS unsigned*)(F.lds + MISC_OFF))[u] = 0u;
    __syncthreads();
    XcdBarrier bar = xcd_barrier_post((unsigned*)(F.ctl + CW_BAR), F.MISC + 8);
    const int gtid = F.bid * NTHR + F.tid;

#if DBG_CHECK
    if (gtid < 64) F.DBG[gtid] = 0.f;
    xcd_barrier(bar);
#endif
    PHASE_BEGIN();
    p0_phase(F, CW_Q0);
#if PROBE_TWICE == 100
    xcd_barrier(bar); p0_phase(F, CW_Q0 + 64);
#endif
    xcd_barrier(bar);
    PHASE_BEGIN();
    norm_mod_rows<false>(F, F.in[I_XP], F.in[I_XS], nullptr, F.in[I_G1], 0, D, F.H);
#if PROBE_TWICE == 101
    xcd_barrier(bar); norm_mod_rows<false>(F, F.in[I_XP], F.in[I_XS], nullptr, F.in[I_G1], 0, D, F.H);
#endif
    xcd_barrier(bar);
#if DBG_CHECK
    dbg_check_p0p1(F);
#endif
    PHASE_BEGIN();
    { pg8::Gemm g{F.H, F.WIN, MPAD, NP_IN, D}; pg8::StaticOrder S; S.init(MPAD, NP_IN, F.G, F.bid);
      EpiIn E{F.PROJ, F.ROPEC, F.ROPES, F.out};
#if PROBE_TWICE == 110
      S.force0 = 1; pg8::gemm_phase<EpiIn, true, true>(F.lds, g, S, E); S.force0 = 0; xcd_barrier(bar);
#endif
      pg8::gemm_phase<EpiIn, true, true>(F.lds, g, S, E);
      drain_weights<0>(F);
#if PROBE_TWICE == 102
      xcd_barrier(bar); pg8::gemm_phase<EpiIn, true, true>(F.lds, g, S, E);
#endif
    }
    xcd_barrier(bar);
#if DBG_CHECK
    dbg_check_p2(F);
    xcd_barrier(bar);
#endif
    PHASE_BEGIN();
    p3_phase(F);
    xcd_barrier(bar);
#if DBG_CHECK
    dbg_check_cl(F);
    dbg_check_swa(F);
    xcd_barrier(bar);
#endif
    PHASE_BEGIN();
    p4_phase(F);
    xcd_barrier(bar);
#if DBG_CHECK
    dbg_check_scan(F);
    xcd_barrier(bar);
#endif
    PHASE_BEGIN();
    p5_merge(F);
#if PROBE_TWICE == 105
    xcd_barrier(bar); p5_merge(F);
#endif
    xcd_barrier(bar);
    PHASE_BEGIN();
    bf16* const X1B = (bf16*)(F.ws + WS_FRAG);
    { pg8::Gemm g{F.H, F.WOUT, MP, D, D}; pg8::StaticOrder S; S.init(MP, D, F.G, F.bid);
      EpiRes<0> E{F.in[I_XP], nullptr, nullptr, X1B, F.MOD, 2 * D};
      pg8::gemm_phase<EpiRes<0>, true, true>(F.lds, g, S, E); }
    skinny_res<D, 0, true, true>(F, F.H, F.WOUT, F.in[I_XS], nullptr, nullptr, X1B, 2 * D);
    xcd_barrier(bar);
    PHASE_BEGIN();
    norm_mod_rows<true>(F, nullptr, nullptr, X1B, F.in[I_G2], 3 * D, 4 * D, F.H);
#if PROBE_TWICE == 101
    xcd_barrier(bar); norm_mod_rows<true>(F, nullptr, nullptr, X1B, F.in[I_G2], 3 * D, 4 * D, F.H);
#endif
    xcd_barrier(bar);
    PHASE_BEGIN();
    { pg8::Gemm g{F.H, F.WGU, MPAD, N_GU, D}; pg8::StaticOrder S; S.init(MPAD, N_GU, F.G, F.bid);
      EpiGU E{F.PROJ};
      pg8::gemm_phase<EpiGU, true, true>(F.lds, g, S, E);
      drain_weights<1>(F); }
    xcd_barrier(bar);
    PHASE_BEGIN();
    { pg8::Gemm g{F.PROJ, F.WDN, MP, D, DFF}; pg8::StaticOrder S; S.init(MP, D, F.G, F.bid);
      EpiRes<1> E{nullptr, X1B, nullptr, X1B, F.MOD, 5 * D};
      pg8::gemm_phase<EpiRes<1>, true, true>(F.lds, g, S, E); }
    skinny_res<DFF, 1, true, true>(F, F.PROJ, F.WDN, nullptr, X1B, nullptr, X1B, 5 * D);
    xcd_barrier(bar);
    PHASE_BEGIN();
    p10_final(F, X1B);
#if DBG_CHECK
    xcd_barrier(bar);
    dbg_final(F);
#endif
}

extern "C" void kernel_launch(void* const* d_in, const int* in_sizes, int n_in, void* d_out, int out_size, void* d_ws, size_t ws_size, hipStream_t stream) {
    static int grid = 0;
    if (grid == 0) {
        int dev = 0, cus = 0, per_cu = 0;
        if (n_in != 20 || out_size != (int)OUT_TOTAL || ws_size < WS_END + 32 * MiB) { fprintf(stderr, "kernel_launch: unexpected sizes n_in %d out %d ws %zu (need %zu); nothing launched\n", n_in, out_size, ws_size, (size_t)WS_END); grid = -1; return; }
        if (hipGetDevice(&dev) != hipSuccess || hipDeviceGetAttribute(&cus, hipDeviceAttributeMultiprocessorCount, dev) != hipSuccess) { fprintf(stderr, "kernel_launch: device query failed\n"); grid = -1; return; }
        if (hipFuncSetAttribute((const void*)mega_fwd, hipFuncAttributeMaxDynamicSharedMemorySize, LDS_BYTES) != hipSuccess) { fprintf(stderr, "kernel_launch: hipFuncSetAttribute failed\n"); grid = -1; return; }
        if (hipOccupancyMaxActiveBlocksPerMultiprocessor(&per_cu, (const void*)mega_fwd, NTHR, LDS_BYTES) != hipSuccess || per_cu < 1)
            fprintf(stderr, "kernel_launch: occupancy query reports %d blocks per CU\n", per_cu);
        (void)hipGetLastError();
        grid = cus;
    }
    if (grid < 0) return;
    if (hipMemsetAsync((char*)d_ws + WS_CTL, 0, CTL_ZERO_BYTES, stream) != hipSuccess) { fprintf(stderr, "kernel_launch: memset failed\n"); return; }
    Args a{};
    for (int i = 0; i < 20; ++i) a.in[i] = (const float*)d_in[i];
    a.out = (float*)d_out; a.ws = (unsigned char*)d_ws;
    hipLaunchKernelGGL(mega_fwd, dim3(grid), dim3(NTHR), LDS_BYTES, stream, a);
}
```

```cpp
#include <hip/hip_runtime.h>
#include <cstdio>

#ifndef DBG_CHECK
#define DBG_CHECK 0
#endif
#ifndef PROBE_TWICE
#define PROBE_TWICE 0
#endif
#ifndef ZERO_FILL
#define ZERO_FILL 0
#endif

#define LAS __attribute__((address_space(3)))
#define GAS __attribute__((address_space(1)))
typedef GAS unsigned gu32;
typedef unsigned short bf16;
typedef short bf16x8 __attribute__((ext_vector_type(8)));
typedef float f32x2 __attribute__((ext_vector_type(2)));
typedef float f32x4 __attribute__((ext_vector_type(4)));
typedef float f32x16 __attribute__((ext_vector_type(16)));
typedef unsigned u32x2 __attribute__((ext_vector_type(2)));
typedef unsigned u32x4 __attribute__((ext_vector_type(4)));
typedef __bf16 bf16x2_t __attribute__((ext_vector_type(2)));
#define RLX_AGENT __ATOMIC_RELAXED, __HIP_MEMORY_SCOPE_AGENT
#define LDS_WAIT() asm volatile("s_waitcnt lgkmcnt(0)" ::: "memory")
#define VM_WAIT() asm volatile("s_waitcnt vmcnt(0)" ::: "memory")

__device__ __forceinline__ unsigned cvtpk(float lo, float hi) { f32x2 v = {lo, hi}; bf16x2_t b = __builtin_convertvector(v, bf16x2_t); return __builtin_bit_cast(unsigned, b); }
__device__ __forceinline__ float bf2f(unsigned short b) { return __uint_as_float(((unsigned)b) << 16); }
__device__ __forceinline__ float bflo(unsigned w) { return __uint_as_float(w << 16); }
__device__ __forceinline__ float bfhi(unsigned w) { return __uint_as_float(w & 0xffff0000u); }
__device__ __forceinline__ float wave_sum(float v) {
#pragma unroll
    for (int o = 1; o < 64; o <<= 1) v += __shfl_xor(v, o);
    return v;
}

constexpr int NWAVES = 8, NTHR = 512;
constexpr int D = 4096, SEQ = 8192, MP = 16384, MS = 128, MREAL = 16512, MPAD = 16640;
constexpr int N_IN = 25616, NP_IN = 25856, DFF = 11008, N_GU = 22016, NMOD = 24576;
constexpr int C_QA = 0, C_KA = 2048, C_VA = 4096, C_GA = 8192, C_QB = 12288, C_KB = 16384, C_VB = 16896, C_ZA = 17408, C_ZB = 21504, C_RA = 25600;
constexpr int O_RA = 12288, O_QB = 12304, O_KB = 16400, O_VB = 16912;
constexpr float NORM_EPS = 1e-6f;
__host__ __device__ __forceinline__ size_t pj(int row, int col) { return ((size_t)((row >> 8) * 101 + (col >> 8)) << 16) + (size_t)(((row & 255) << 8) + (col & 255)); }
constexpr float QSCALE = 0.125f * 1.4426950408889634f;
constexpr long OUT_YP = 0, OUT_YS = 67108864L, OUT_SGP = 67633152L, OUT_KP = 71827456L, OUT_VP = 71958528L, OUT_SGS = 72089600L, OUT_KS = 88866816L, OUT_VS = 88932352L, OUT_TOTAL = 88997888L;

constexpr size_t MiB = 1u << 20;
constexpr size_t WS_CTL = 0, CTL_ZERO_BYTES = 2 * MiB;
constexpr size_t WS_MOD = 1 * MiB, WS_ROPE = 2 * MiB, WS_VEC = 4 * MiB, WS_AMAT = 9 * MiB, WS_SC = 18 * MiB, WS_DBG = 19 * MiB;
constexpr size_t WS_WIN = 20 * MiB, WS_WOUT = 222 * MiB, WS_WGU = 254 * MiB, WS_WDN = 426 * MiB, WS_H = 512 * MiB, WS_PROJ = 642 * MiB, WS_FRAG = 1463 * MiB, WS_END = 1595 * MiB;
static_assert(WS_WIN + (size_t)NP_IN * D * 2 <= WS_WOUT && WS_WGU + (size_t)N_GU * D * 2 <= WS_WDN && WS_WDN + (size_t)D * DFF * 2 <= WS_H, "ws map");
static_assert(WS_H + (size_t)MPAD * D * 2 <= WS_PROJ && WS_PROJ + (size_t)MPAD * NP_IN * 2 <= WS_FRAG && WS_FRAG + (size_t)264 * 4 * 131072 <= WS_END, "ws map");
constexpr int CW_Q0 = 64, CW_BAR = 4096;

constexpr int LDS_BYTES = 160 * 1024;
constexpr int MISC_OFF = LDS_BYTES - 256;

#define XB_TMO      128
#define XB_XCNT(j)  (256  + 64 * (j))
#define XB_XSUB(j)  (1280 + 64 * (j))
#define XB_XGEN(j)  (2304 + 64 * (j))
#define XB_TOP      3328
#define XB_TOPGEN   3392
#define XCD_BAR_WORDS 3456
#define XB_SPIN_CAP (1u << 24)
__device__ __forceinline__ unsigned xb_ld(unsigned* p)              { return __hip_atomic_load(p, __ATOMIC_RELAXED, __HIP_MEMORY_SCOPE_AGENT); }
__device__ __forceinline__ unsigned xb_add(unsigned* p, unsigned v) { return __hip_atomic_fetch_add(p, v, __ATOMIC_RELAXED, __HIP_MEMORY_SCOPE_AGENT); }
__device__ __forceinline__ unsigned xb_xcc_id() { return (unsigned)__builtin_amdgcn_s_getreg((3 << 11) | 20) & 0xFu; }
#define XB_SPIN(cond, bar) do { unsigned _sp = 0; while (cond) { __builtin_amdgcn_s_sleep(1); \
    if ((++_sp & 255u) == 0u) { if (xb_ld(&(bar)[XB_TMO])) break; if (_sp > XB_SPIN_CAP) { atomicAdd(&(bar)[XB_TMO], 1u); break; } } } } while (0)
struct XcdBarrier { unsigned* bar; unsigned x; volatile LAS unsigned* st; };
__device__ __forceinline__ XcdBarrier xcd_barrier_post(unsigned* bar, volatile LAS unsigned* st) {
    XcdBarrier b; b.bar = bar; b.x = xb_xcc_id(); b.st = st;
    if (threadIdx.x == 0) (void)xb_add(&bar[XB_XCNT(b.x)], 1u);
    return b;
}
__device__ __forceinline__ void xcd_barrier_complete(unsigned* bar, unsigned x, unsigned& nloc, unsigned& nx) {
    const unsigned G = gridDim.x * gridDim.y * gridDim.z;
    unsigned sum, cnt, mine, sp = 0u;
    for (;;) {
        sum = 0u; cnt = 0u; mine = 0u;
#pragma unroll
        for (unsigned j = 0; j < 16; ++j) { const unsigned c = xb_ld(&bar[XB_XCNT(j)]); sum += c; cnt += (c > 0u) ? 1u : 0u; mine = (j == x) ? c : mine; }
        if (sum == G) break;
        __builtin_amdgcn_s_sleep(1);
        if ((++sp & 255u) == 0u) { if (xb_ld(&bar[XB_TMO])) break; if (sp > XB_SPIN_CAP) { atomicAdd(&bar[XB_TMO], 1u); break; } }
    }
    nloc = mine > 0u ? mine : 1u; nx = cnt > 0u ? cnt : 1u;
}
__device__ __forceinline__ void xcd_barrier(const XcdBarrier& b) {
    asm volatile("s_waitcnt vmcnt(0)" ::: "memory");
    __syncthreads();
    if (threadIdx.x == 0) {
        unsigned* bar = b.bar;
        __builtin_amdgcn_s_waitcnt(0);
        unsigned nloc = b.st[0], nx = b.st[1];
        if (nloc == 0u) { xcd_barrier_complete(bar, b.x, nloc, nx); b.st[0] = nloc; b.st[1] = nx; }
        const unsigned old = xb_add(&bar[XB_XSUB(b.x)], 1u);
        const unsigned gen = old / nloc;
        if (old + 1u == (gen + 1u) * nloc) {
            __builtin_amdgcn_fence(__ATOMIC_RELEASE, "agent");
            asm volatile("s_waitcnt vmcnt(0)" ::: "memory");
            const unsigned og = xb_add(&bar[XB_TOP], 1u);
            const unsigned tg = og / nx;
            if (og + 1u == (tg + 1u) * nx) xb_add(&bar[XB_TOPGEN], 1u);
            else XB_SPIN(xb_ld(&bar[XB_TOPGEN]) == tg, bar);
            __builtin_amdgcn_fence(__ATOMIC_ACQUIRE, "agent");
            xb_add(&bar[XB_XGEN(b.x)], 1u);
            asm volatile("s_waitcnt vmcnt(0)" ::: "memory");
        } else {
            XB_SPIN(xb_ld(&bar[XB_XGEN(b.x)]) == gen, bar);
            __builtin_amdgcn_fence(__ATOMIC_ACQUIRE, "agent");
            asm volatile("s_waitcnt vmcnt(0)" ::: "memory");
        }
    }
    __syncthreads();
}

namespace pg8 {
constexpr int BM = 256, BK = 64, HALF = 128, HTB = HALF * BK * 2, STAGE_BYTES = 8 * HTB, NXCD = 8, WGM = 8;
__host__ __device__ __forceinline__ int lds_byte(int r, int c) { const int st = (r >> 4) * 2 + (c >> 5), rr = r & 15, cc = c & 31, ob = rr * 64 + cc * 2; return st * 1024 + (ob ^ (((ob >> 9) & 1) << 5)); }
__host__ __device__ __forceinline__ void stage_rc(int b, int& R, int& C) { const int st = b / 1024, sb = b % 1024, swz = sb ^ (((sb >> 9) & 1) << 5); R = (st >> 1) * 16 + swz / 64; C = (st & 1) * 32 + (swz % 64) / 2; }
__host__ __device__ __forceinline__ int perm32(int rho) { const int n = rho >> 4, i = rho & 15; return 8 * (i >> 2) + 4 * n + (i & 3); }
struct Unit { int pm, pn; };
struct Gemm { const bf16* A; const bf16* Bt; int M, N, K; };
struct StaticOrder {
    int nM, nN, nwg, G, c; int force0 = 0; int fatk = 0;
    __host__ __device__ void init(int M, int N, int G_, int c_) { nM = M / BM; nN = N / BM; nwg = nM * nN; G = G_; c = c_; }
    __host__ __device__ bool next(int i, Unit& u) const {
        const long L = (long)i * G + c; if (L >= nwg) return false;
        if (fatk && G == 256 && nM == 64 && nN == 16) { const int x = c & 7, l = c >> 3; u.pm = 8 * (2 * i + (x >> 2)) + (l & 7); u.pn = 4 * (x & 3) + (l >> 3); return true; }
        int wgid = (int)L; { const int q = nwg / NXCD, r = nwg % NXCD, xcd = wgid % NXCD, off = wgid / NXCD; wgid = (xcd < r ? xcd * (q + 1) : r * (q + 1) + (xcd - r) * q) + off; }
        const int nig = WGM * nN, gid = wgid / nig, fm = gid * WGM, gsz = (nM - fm) < WGM ? (nM - fm) : WGM;
        u.pm = fm + ((wgid % nig) % gsz); u.pn = (wgid % nig) / gsz; if (force0) { u.pm = 0; u.pn = 0; } return true;
    }
};
template <class Epi, bool AIMG = false, bool BIMG = false>
__device__ __forceinline__ void gemm_phase(LAS unsigned char* lds, const Gemm g, const StaticOrder& S, const Epi& E) {
    int tid_ = threadIdx.x; asm volatile("" : "+v"(tid_));
    const int tid = tid_, wid = __builtin_amdgcn_readfirstlane(tid >> 6), lane = tid & 63, wr = wid >> 2, wc = wid & 3, fr = lane & 15, fq = lane >> 4;
    const int K = g.K, nt = K / BK;
    unsigned voffA[2], voffB[2];
#pragma unroll
    for (int i = 0; i < 2; ++i) { int R, C; stage_rc(tid * 16 + i * 8192, R, C); const int Rb = Epi::PERM ? ((R & ~31) + perm32(R & 31)) : R;
        voffA[i] = AIMG ? (unsigned)(tid * 16 + i * 8192) : (unsigned)(R * K + C) * 2u; voffB[i] = BIMG ? (unsigned)(tid * 16 + i * 8192) : (unsigned)(Rb * K + C) * 2u; }
    const size_t kstepA = AIMG ? (size_t)HTB : (size_t)(BK * 2), kstepB = BIMG ? (size_t)HTB : (size_t)(BK * 2);
    const size_t hstepA = AIMG ? (size_t)nt * HTB : (size_t)HALF * K * 2, hstepB = BIMG ? (size_t)nt * HTB : (size_t)HALF * K * 2;
    const size_t tstepA = 2 * hstepA, tstepB = 2 * hstepB;
    const unsigned ldsw = (unsigned)wid * 1024u;
    const int aoff = lds_byte(wr * 64 + fr, fq * 8), boff = lds_byte(wc * 32 + fr, fq * 8);
#define PG8_SA(b, h) (((b) * 2 + (h)) * HTB)
#define PG8_SB(b, h) ((4 + (b) * 2 + (h)) * HTB)
#define PG8_STAGE(bufoff, gbase, voff) do { _Pragma("unroll") for (int _i = 0; _i < 2; ++_i) \
        __builtin_amdgcn_global_load_lds((const unsigned*)((const char*)(gbase) + (voff)[_i]), (LAS unsigned*)(lds + (bufoff) + ldsw + _i * 8192), 16, 0, 0); } while (0)
#define PG8_LDA(dst, b, h) do { _Pragma("unroll") for (int m = 0; m < 4; ++m) _Pragma("unroll") for (int k = 0; k < 2; ++k) dst[m][k] = *(const LAS bf16x8*)(lds + PG8_SA(b, h) + aoff + m * 2048 + k * 1024); } while (0)
#define PG8_LDB(dst, b, h) do { _Pragma("unroll") for (int n = 0; n < 2; ++n) _Pragma("unroll") for (int k = 0; k < 2; ++k) dst[n][k] = *(const LAS bf16x8*)(lds + PG8_SB(b, h) + boff + n * 2048 + k * 1024); } while (0)
#define PG8_MMA(ai, bj, At, Bt) do { __builtin_amdgcn_s_setprio(1); _Pragma("unroll") for (int m = 0; m < 4; ++m) _Pragma("unroll") for (int n = 0; n < 2; ++n) _Pragma("unroll") for (int k = 0; k < 2; ++k) \
        acc[ai][bj][m][n] = __builtin_amdgcn_mfma_f32_16x16x32_bf16(Bt[n][k], At[m][k], acc[ai][bj][m][n], 0, 0, 0); __builtin_amdgcn_s_setprio(0); } while (0)
#define PG8_WAIT_V(n) asm volatile("s_waitcnt vmcnt(" #n ")" ::: "memory")
#define PG8_WAIT_L(n) asm volatile("s_waitcnt lgkmcnt(" #n ")" ::: "memory")
#define PG8_BAR __builtin_amdgcn_s_barrier()
#define PG8_SCHED __builtin_amdgcn_sched_barrier(0)
    Unit cur, nxt; int ui = 0;
    if (!S.next(0, cur)) return;
    f32x4 acc[2][2][4][2];
#pragma unroll
    for (int a = 0; a < 2; ++a)
#pragma unroll
        for (int b = 0; b < 2; ++b)
#pragma unroll
            for (int m = 0; m < 4; ++m)
#pragma unroll
                for (int n = 0; n < 2; ++n) acc[a][b][m][n] = (f32x4){0.f, 0.f, 0.f, 0.f};
    bf16x8 At[4][2], B0[2][2], B1[2][2];
    const char* cA = (const char*)g.A + (size_t)cur.pm * tstepA; const char* cB = (const char*)g.Bt + (size_t)cur.pn * tstepB;
    PG8_STAGE(PG8_SB(0, 0), cB, voffB); PG8_STAGE(PG8_SB(0, 1), cB + hstepB, voffB); PG8_STAGE(PG8_SA(0, 0), cA, voffA); PG8_STAGE(PG8_SA(0, 1), cA + hstepA, voffA);
    if (wr == 1) PG8_BAR;
    PG8_WAIT_V(2); PG8_BAR;
    PG8_STAGE(PG8_SB(1, 0), cB + kstepB, voffB); PG8_STAGE(PG8_SA(1, 0), cA + kstepA, voffA); PG8_STAGE(PG8_SB(1, 1), cB + hstepB + kstepB, voffB);
    PG8_WAIT_V(6); PG8_BAR;
    for (;;) {
        const bool has_next = S.next(ui + 1, nxt);
        const char* nA = has_next ? (const char*)g.A + (size_t)nxt.pm * tstepA : cA; const char* nB = has_next ? (const char*)g.Bt + (size_t)nxt.pn * tstepB : cB;
        for (int t = 0; t < nt; t += 2) {
            const bool last = (t == nt - 2);
            const char* a1 = cA + (size_t)(t + 1) * kstepA;
            const char* a2 = last ? nA : cA + (size_t)(t + 2) * kstepA; const char* b2 = last ? nB : cB + (size_t)(t + 2) * kstepB;
            const char* a3 = a2 + kstepA; const char* b3 = b2 + kstepB;
            PG8_LDB(B0, 0, 0); PG8_LDB(B1, 0, 1); PG8_SCHED; PG8_LDA(At, 0, 0); PG8_STAGE(PG8_SA(1, 1), a1 + hstepA, voffA);
            PG8_WAIT_V(8); PG8_WAIT_L(0); PG8_BAR; PG8_MMA(0, 0, At, B0); PG8_MMA(0, 1, At, B1); PG8_BAR; PG8_SCHED;
            PG8_LDA(At, 0, 1); PG8_STAGE(PG8_SB(0, 0), b2, voffB); PG8_STAGE(PG8_SB(0, 1), b2 + hstepB, voffB); PG8_STAGE(PG8_SA(0, 0), a2, voffA);
            PG8_WAIT_V(8); PG8_WAIT_L(0); PG8_BAR; PG8_MMA(1, 0, At, B0); PG8_MMA(1, 1, At, B1); PG8_BAR; PG8_SCHED;
            PG8_LDB(B0, 1, 0); PG8_LDB(B1, 1, 1); PG8_SCHED; PG8_LDA(At, 1, 0); PG8_STAGE(PG8_SA(0, 1), a2 + hstepA, voffA);
            PG8_WAIT_V(8); PG8_WAIT_L(0); PG8_BAR; PG8_MMA(0, 0, At, B0); PG8_MMA(0, 1, At, B1); PG8_BAR; PG8_SCHED;
            PG8_LDA(At, 1, 1); PG8_STAGE(PG8_SB(1, 0), b3, voffB); PG8_STAGE(PG8_SB(1, 1), b3 + hstepB, voffB); PG8_STAGE(PG8_SA(1, 0), a3, voffA);
            PG8_WAIT_V(8); PG8_WAIT_L(0); PG8_BAR; PG8_MMA(1, 0, At, B0); PG8_MMA(1, 1, At, B1); PG8_BAR; PG8_SCHED;
        }
        if (wr == 0) PG8_BAR;
        E(acc, cur, wr, wc, fr, fq);
        if (!has_next) break;
#pragma unroll
        for (int a = 0; a < 2; ++a)
#pragma unroll
            for (int b = 0; b < 2; ++b)
#pragma unroll
                for (int m = 0; m < 4; ++m)
#pragma unroll
                    for (int n = 0; n < 2; ++n) acc[a][b][m][n] = (f32x4){0.f, 0.f, 0.f, 0.f};
        cur = nxt; cA = nA; cB = nB; ++ui;
        if (wr == 1) PG8_BAR;
    }
    PG8_WAIT_V(0);
    PG8_BAR;
#undef PG8_SA
#undef PG8_SB
#undef PG8_STAGE
#undef PG8_LDA
#undef PG8_LDB
#undef PG8_MMA
#undef PG8_WAIT_V
#undef PG8_WAIT_L
#undef PG8_BAR
#undef PG8_SCHED
}
__device__ __forceinline__ size_t img_off(int row, int k, int nt, bool permb) {
    int r = row & 127; if (permb) { const int m = r & 31; r = (r & ~31) + 16 * ((m >> 2) & 1) + 4 * (m >> 3) + (m & 3); }
    return ((size_t)(row >> 7) * nt + (k >> 6)) * (size_t)HTB + (size_t)lds_byte(r, k & 63);
}
}

struct Args { const float* in[20]; float* out; unsigned char* ws; };
enum { I_XP = 0, I_XS, I_SG, I_CK, I_CV, I_CP, I_CS, I_WADA, I_BADA, I_G1, I_WIN, I_WGK, I_BGK, I_GGLA, I_SINK, I_WOUT, I_G2, I_WGU, I_WDN, I_GF };

struct Frame {
    LAS unsigned char* lds;
    volatile LAS unsigned* MISC;
    gu32* ctl;
    int tid, lane, wave, G, bid;
    const float* in[20];
    float* out; unsigned char* ws;
    float* MOD; float* ROPEC; float* ROPES; float* SC; float* DBG;
    bf16 *WIN, *WOUT, *WGU, *WDN, *H, *PROJ;
};

__device__ __forceinline__ int row_batch(int row) { return row < MP ? (row >> 13) : 2 + ((row - MP) >> 4); }
__device__ __forceinline__ int row_pos(int row) { return row < MP ? (row & 8191) : 2048 + (row & 15); }
__device__ __forceinline__ const float* x_row(const Frame& F, int row) { return row < MP ? F.in[I_XP] + (size_t)row * D : F.in[I_XS] + (size_t)(row - MP) * D; }

__device__ __forceinline__ int win_src_col(int n) {
    if (n < 8192) return n;
    if (n < 12288 || (n >= 17408 && n < 21504)) {
        const int ct = n < 12288 ? (n - 8192) >> 8 : 16 + ((n - 17408) >> 8), j = n & 255; return j < 128 ? 8192 + 128 * ct + j : 17424 + 128 * ct + (j - 128); }
    if (n < 16896) { const bool isq = n < 16384; const int r = n - (isq ? 12288 : 16384), hh = r >> 6, p = r & 63, t = p >> 3, e = p & 7;
        const int d = (e < 4) ? (4 * t + e) : (32 + 4 * t + (e - 4)); return (isq ? O_QB : O_KB) + 64 * hh + d; }
    if (n < 25600) return n + 16;
    if (n < 25616) return O_RA + (n - 25600);
    return -1;
}
__device__ __forceinline__ int wgu_src_col(int n) { const int pn = n >> 8, j = n & 255; return j < 128 ? 128 * pn + j : DFF + 128 * pn + (j - 128); }

__device__ __forceinline__ void p0_transpose(const float* W, int K, int N, bf16* WT, int mode, LAS float* scr, int n0, int k0, int lane, int imgnt = 0, bool permb = false) {
    const int cg = lane & 15, kr = lane >> 4;
    const int n = n0 + 4 * cg; const int src = mode == 1 ? win_src_col(n) : (mode == 2 ? wgu_src_col(n) : n);
    const float* wp = W + (size_t)(k0 + kr) * N + (src < 0 ? 0 : src);
    f32x4 v[16];
#pragma unroll
    for (int j = 0; j < 16; ++j) v[j] = src >= 0 ? *(const f32x4*)(wp + (size_t)(4 * j) * N) : (f32x4){0.f, 0.f, 0.f, 0.f};
#pragma unroll
    for (int j = 0; j < 16; ++j) { LAS float* d = scr + (4 * j + kr) * 65 + 4 * cg; d[0] = v[j].x; d[1] = v[j].y; d[2] = v[j].z; d[3] = v[j].w; }
    LDS_WAIT(); asm volatile("" ::: "memory");
    const int c = lane & 7;
#pragma unroll
    for (int j = 0; j < 8; ++j) { const int nn = (lane >> 3) + 8 * j; const LAS float* q = scr + (8 * c) * 65 + nn;
        u32x4 o; o.x = cvtpk(q[0], q[65]); o.y = cvtpk(q[2 * 65], q[3 * 65]); o.z = cvtpk(q[4 * 65], q[5 * 65]); o.w = cvtpk(q[6 * 65], q[7 * 65]);
        if (imgnt) *(u32x4*)((unsigned char*)WT + pg8::img_off(n0 + nn, k0 + 8 * c, imgnt, permb)) = o;
        else *(u32x4*)(WT + (size_t)(n0 + nn) * K + k0 + 8 * c) = o; }
    LDS_WAIT(); asm volatile("" ::: "memory");
}

constexpr int I_MOD = 384, I_TWIN = (NP_IN / 64) * 8, I_TWOUT = (D / 64) * 8, I_TWGU = (N_GU / 64) * 8, I_TWDN = (D / 64) * 22, I_ROPE = 32;
constexpr int P0_ITEMS = I_MOD + I_ROPE + I_TWIN;
constexpr int CW_QGU = 192, CW_QDN = 320;

__device__ __forceinline__ void p0_mod_item(Frame& F, int item) {
    const int w = F.wave, lane = F.lane, cg = item >> 2, kq = item & 3;
    f32x4 acc[10];
#pragma unroll
    for (int b = 0; b < 10; ++b) acc[b] = (f32x4){0.f, 0.f, 0.f, 0.f};
    const int kbase = 1024 * kq + 128 * w;
    const float* wp = F.in[I_WADA] + (size_t)kbase * NMOD + 256 * cg + 4 * lane;
#pragma unroll 1
    for (int kc = 0; kc < 2; ++kc) {
        float scv[10];
#pragma unroll
        for (int b = 0; b < 10; ++b) { const int k = kbase + 64 * kc + lane; const float c = b < 2 ? F.in[I_CP][b * D + k] : F.in[I_CS][(b - 2) * D + k]; scv[b] = c / (1.f + __expf(-c)); }
#pragma unroll
        for (int kk = 0; kk < 64; ++kk) {
            const f32x4 wv = *(const f32x4*)(wp + (size_t)(64 * kc + kk) * NMOD);
#pragma unroll
            for (int b = 0; b < 10; ++b) { const float sv = __builtin_bit_cast(float, __builtin_amdgcn_readlane(__builtin_bit_cast(int, scv[b]), kk)); acc[b] += wv * sv; }
        }
    }
    LAS float* red = (LAS float*)F.lds;
#pragma unroll
    for (int b = 0; b < 10; ++b) *(LAS f32x4*)(red + (w * 10 + b) * 256 + 4 * lane) = acc[b];
    __syncthreads();
    for (int o = F.tid; o < 2560; o += NTHR) { const int b = o >> 8, c = o & 255; float sacc = kq == 0 ? F.in[I_BADA][256 * cg + c] : 0.f;
#pragma unroll
        for (int ww = 0; ww < 8; ++ww) sacc += red[(ww * 10 + b) * 256 + c];
        atomicAdd(F.MOD + b * NMOD + 256 * cg + c, sacc); }
    __syncthreads();
}
__device__ __forceinline__ void p0_rope_item(Frame& F, int it) {
    const int pos = 256 * it + (F.tid >> 1), fh = F.tid & 1;
#pragma unroll 1
    for (int f = 16 * fh; f < 16 * fh + 16; ++f) {
        const float inv = (float)exp2(-(double)f * (13.287712379549449 / 32.0));
        const float ang = (float)pos * inv;
        const double a = (double)ang, r = a - 6.283185307179586 * rint(a * 0.15915494309189535);
        F.ROPEC[pos * 32 + f] = (float)cos(r); F.ROPES[pos * 32 + f] = (float)sin(r);
    }
}
__device__ __forceinline__ void p0_phase(Frame& F, int qw) {
    LAS float* scr = (LAS float*)(F.lds + F.wave * 16640);
    for (;;) {
        __syncthreads();
        if (F.tid == 0) F.MISC[0] = __hip_atomic_fetch_add(F.ctl + qw, 1u, RLX_AGENT);
        __syncthreads();
        int it = (int)F.MISC[0];
        if (it >= P0_ITEMS) break;
        if (it < I_MOD) { p0_mod_item(F, it); continue; } it -= I_MOD;
        if (it < I_ROPE) { p0_rope_item(F, it); continue; } it -= I_ROPE;
        const int w = F.wave;
        p0_transpose(F.in[I_WIN], D, N_IN, F.WIN, 1, scr, 64 * (it >> 3), 512 * (it & 7) + 64 * w, F.lane, D / 64, true);
    }
}
template <int KIND>
__device__ __forceinline__ void drain_weights(Frame& F) {
    LAS float* scr = (LAS float*)(F.lds + F.wave * 16640);
    for (;;) {
        __syncthreads();
        if (F.tid == 0) F.MISC[0] = __hip_atomic_fetch_add(F.ctl + (KIND == 0 ? CW_QGU : CW_QDN), 1u, RLX_AGENT);
        __syncthreads();
        int it = (int)F.MISC[0];
        if (it >= (KIND == 0 ? I_TWOUT + I_TWGU : I_TWDN)) break;
        const int w = F.wave;
        if (KIND == 0 && it < I_TWOUT) p0_transpose(F.in[I_WOUT], D, D, F.WOUT, 0, scr, 64 * (it >> 3), 512 * (it & 7) + 64 * w, F.lane, D / 64, true);
        else if (KIND == 0) { it -= I_TWOUT; p0_transpose(F.in[I_WGU], D, N_GU, F.WGU, 2, scr, 64 * (it >> 3), 512 * (it & 7) + 64 * w, F.lane, D / 64, true); }
        else { const int nb = it / 22, kb = it % 22, k0 = 512 * kb + 64 * w; if (k0 < DFF) p0_transpose(F.in[I_WDN], DFF, D, F.WDN, 0, scr, 64 * nb, k0, F.lane, DFF / 64, true); }
    }
}

template <bool SRCB>
__device__ __forceinline__ void norm_mod_rows(Frame& F, const float* xp, const float* xs, const bf16* xb, const float* g, int off_sh, int off_sc, bf16* Hout) {
    const int gw = F.bid * NWAVES + F.wave, NGW = F.G * NWAVES;
    for (int row = gw; row < MPAD; row += NGW) {
        unsigned char* hb = (unsigned char*)Hout + (size_t)(row >> 7) * (D / 64) * (size_t)pg8::HTB + 8 * (F.lane & 1);
        const int kt0 = F.lane >> 4, cc = (4 * F.lane) & 56, o_lo = pg8::lds_byte(row & 127, cc);
#define H_ST8(j, val) (*(GAS unsigned long long*)(hb + (size_t)(4 * (j) + kt0) * pg8::HTB + o_lo) = (val))
        if (row >= MREAL) {
#pragma unroll
            for (int j = 0; j < 16; ++j) H_ST8(j, 0ull);
            continue; }
        f32x4 v[16]; float s = 0.f;
        if (!SRCB) { const float* xrow = row < MP ? xp + (size_t)row * D : xs + (size_t)(row - MP) * D;
            const GAS f32x4* xr = (const GAS f32x4*)xrow + F.lane;
#pragma unroll
            for (int j = 0; j < 16; ++j) v[j] = xr[64 * j]; }
        else { const GAS u32x2* xr = (const GAS u32x2*)(xb + (size_t)row * D) + F.lane;
#pragma unroll
            for (int j = 0; j < 16; ++j) { const u32x2 w = xr[64 * j]; v[j] = (f32x4){bflo(w.x), bfhi(w.x), bflo(w.y), bfhi(w.y)}; } }
#pragma unroll
        for (int j = 0; j < 16; ++j) s += (v[j].x * v[j].x + v[j].y * v[j].y) + (v[j].z * v[j].z + v[j].w * v[j].w);
        const float r = 1.0f / sqrtf(wave_sum(s) * (1.f / D) + NORM_EPS);
        const float* mod = F.MOD + (size_t)row_batch(row) * NMOD;
#pragma unroll
        for (int j = 0; j < 16; ++j) { const int c = 256 * j + 4 * F.lane;
            const f32x4 gg = *(const f32x4*)(g + c), sh = *(const f32x4*)(mod + off_sh + c), sc = *(const f32x4*)(mod + off_sc + c);
            const f32x4 y = (v[j] * r) * gg * (sc + 1.0f) + sh;
            H_ST8(j, (unsigned long long)cvtpk(y.x, y.y) | ((unsigned long long)cvtpk(y.z, y.w) << 32)); }
    }
}

__device__ __forceinline__ float sigmoidf_(float x) { return __builtin_amdgcn_rcpf(1.f + __expf(-x)); }
struct EpiIn {
    static constexpr bool PERM = true;
    bf16* P; const float* ropec; const float* ropes; float* out;
    __device__ __forceinline__ void operator()(const f32x4 (&acc)[2][2][4][2], const pg8::Unit& u, int wr, int wc, int fr, int fq) const {
        const int pn = u.pn, pm = u.pm;
        const bool is_q = pn >= 48 && pn < 64, is_k = pn >= 64 && pn < 66, is_v = pn >= 66 && pn < 68;
        const bool is_gz = (pn >= 32 && pn < 48) || (pn >= 68 && pn < 84), is_zb = pn >= 84 && pn < 100;
        const int t = 4 * (wc & 1) + fq;
        if (is_gz) {
            const int ct = pn < 48 ? pn - 32 : 16 + (pn - 68);
#pragma unroll
            for (int ai = 0; ai < 2; ++ai)
#pragma unroll
                for (int m = 0; m < 4; ++m) { const int row = pm * 256 + ai * 128 + wr * 64 + m * 16 + fr;
                    const f32x4 g0 = acc[ai][0][m][0], g1 = acc[ai][0][m][1], z0 = acc[ai][1][m][0], z1 = acc[ai][1][m][1]; float a[8];
#pragma unroll
                    for (int x = 0; x < 4; ++x) { a[x] = g0[x] * sigmoidf_(g0[x]) * sigmoidf_(z0[x]); a[4 + x] = g1[x] * sigmoidf_(g1[x]) * sigmoidf_(z1[x]); }
                    u32x4 w; w.x = cvtpk(a[0], a[1]); w.y = cvtpk(a[2], a[3]); w.z = cvtpk(a[4], a[5]); w.w = cvtpk(a[6], a[7]);
                    *(u32x4*)(P + pj(row, C_GA + ct * 128 + wc * 32 + 8 * fq)) = w; }
            return; }
#pragma unroll
        for (int ai = 0; ai < 2; ++ai)
#pragma unroll
            for (int m = 0; m < 4; ++m) {
                const int row = pm * 256 + ai * 128 + wr * 64 + m * 16 + fr;
                bf16* rowp = P + pj(row, pn * 256 + wc * 32 + 8 * fq);
                long kbase = -1;
                if (is_k || is_v) {
                    if (row < MP) { const int tt = row & 8191; if (tt >= 8064) kbase = (is_k ? OUT_KP : OUT_VP) + ((long)((row >> 13) * 128 + (tt - 8064)) * 8) * 64; }
                    else if (row < MREAL) { const int r2 = row - MP; kbase = (is_k ? OUT_KS : OUT_VS) + ((long)((r2 >> 4) * 16 + (r2 & 15)) * 8) * 64; }
                }
                f32x4 cs, sn;
                if (is_q || is_k) { const int pos = row_pos(row); cs = *(const f32x4*)(ropec + pos * 32 + 4 * t); sn = *(const f32x4*)(ropes + pos * 32 + 4 * t); }
#pragma unroll
                for (int bj = 0; bj < 2; ++bj) {
                    f32x4 v0 = acc[ai][bj][m][0], v1 = acc[ai][bj][m][1];
                    if (is_q || is_k) { const f32x4 o1 = v0 * cs - v1 * sn, o2 = v1 * cs + v0 * sn; v0 = o1; v1 = o2;
                        if (is_q) { v0 = v0 * QSCALE; v1 = v1 * QSCALE; } }
                    if (is_zb) {
#pragma unroll
                        for (int x = 0; x < 4; ++x) { v0[x] = sigmoidf_(v0[x]); v1[x] = sigmoidf_(v1[x]); } }
                    if (kbase >= 0) {
                        const int g = 4 * (pn - (is_k ? 64 : 66)) + 2 * bj + (wc >> 1);
                        float* kp = out + kbase + g * 64;
                        if (is_k) { *(f32x4*)(kp + 4 * t) = v0; *(f32x4*)(kp + 32 + 4 * t) = v1; }
                        else { *(f32x4*)(kp + 8 * t) = v0; *(f32x4*)(kp + 8 * t + 4) = v1; }
                    }
                    u32x4 w; w.x = cvtpk(v0[0], v0[1]); w.y = cvtpk(v0[2], v0[3]); w.z = cvtpk(v1[0], v1[1]); w.w = cvtpk(v1[2], v1[3]);
                    *(u32x4*)(rowp + bj * 128) = w;
                }
            }
    }
};

constexpr int CL_PITCH = 520;
constexpr float GLA_QSCALE = 0.04419417382415922f;
__device__ __forceinline__ int crow(int reg, int h) { return (reg & 3) + 8 * (reg >> 2) + 4 * h; }
#define MFMA32(a, b, c) __builtin_amdgcn_mfma_f32_32x32x16_bf16((a), (b), (c), 0, 0, 0)
__device__ __forceinline__ bf16x8 pack8(const f32x16& x, int s) {
    u32x4 p; p.x = cvtpk(x[8 * s], x[8 * s + 1]); p.y = cvtpk(x[8 * s + 2], x[8 * s + 3]); p.z = cvtpk(x[8 * s + 4], x[8 * s + 5]); p.w = cvtpk(x[8 * s + 6], x[8 * s + 7]);
    return __builtin_bit_cast(bf16x8, p);
}
constexpr float LOG2E_ = 1.4426950408889634f;
__device__ __forceinline__ float logsig(float x) { return fminf(x, 0.f) - __logf(1.f + __expf(-fabsf(x))); }

__device__ __forceinline__ void gla_chunk_local(Frame& F, int cid, int hd) {
    const int tid = F.tid, lane = F.lane, wv = F.wave, h = lane >> 5;
    LAS bf16* QL = (LAS bf16*)F.lds; LAS bf16* KL = QL + 64 * CL_PITCH;
    LAS float* RA = (LAS float*)(F.lds + 133120); LAS float* RED = (LAS float*)(F.lds + 137216);
    int row0, ntok; if (cid < 256) { row0 = cid * 64; ntok = 64; } else { row0 = MP + 16 * (cid - 256); ntok = 16; }
    const int d = tid;
    float wg[16];
#pragma unroll
    for (int r = 0; r < 16; ++r) wg[r] = F.in[I_WGK][r * 2048 + hd * 512 + d];
    const float bias = F.in[I_BGK][hd * 512 + d];
    u32x4 rq[8], rk[8];
#pragma unroll
    for (int j = 0; j < 8; ++j) { const int id = tid + 512 * j, rr = id >> 6, c16 = id & 63; rq[j] = (u32x4){0u, 0u, 0u, 0u}; rk[j] = rq[j];
        if (rr < ntok) { rq[j] = *(const u32x4*)(F.PROJ + pj(row0 + rr, C_QA + hd * 512 + 8 * c16)); rk[j] = *(const u32x4*)(F.PROJ + pj(row0 + rr, C_KA + hd * 512 + 8 * c16)); } }
    if (tid < 128) { const int i = tid >> 1, half = tid & 1; u32x4 w = (u32x4){0u, 0u, 0u, 0u};
        if (i < ntok) w = *(const u32x4*)(F.PROJ + pj(row0 + i, C_RA + 8 * half));
        LAS float* r = RA + i * 16 + 8 * half;
        r[0] = bflo(w.x); r[1] = bfhi(w.x); r[2] = bflo(w.y); r[3] = bfhi(w.y); r[4] = bflo(w.z); r[5] = bfhi(w.z); r[6] = bflo(w.w); r[7] = bfhi(w.w); }
#pragma unroll
    for (int j = 0; j < 8; ++j) { const int id = tid + 512 * j, rr = id >> 6, c16 = id & 63; *(LAS u32x4*)(QL + rr * CL_PITCH + 8 * c16) = rq[j]; *(LAS u32x4*)(KL + rr * CL_PITCH + 8 * c16) = rk[j]; }
    __syncthreads();
    float B[64]; float bc = 0.f;
    unsigned ra_base = (unsigned)(size_t)RA; asm volatile("" : "+v"(ra_base));
    const f32x2 w01 = {wg[0], wg[1]}, w23 = {wg[2], wg[3]}, w45 = {wg[4], wg[5]}, w67 = {wg[6], wg[7]}, w89 = {wg[8], wg[9]}, wab = {wg[10], wg[11]}, wcd = {wg[12], wg[13]}, wef = {wg[14], wg[15]};
#pragma unroll
    for (int i = 0; i < 64; ++i) {
        const LAS f32x4* rp = (const LAS f32x4*)(size_t)(ra_base + (unsigned)(i * 64));
        const f32x4 r0 = rp[0], r1 = rp[1], r2 = rp[2], r3 = rp[3];
        f32x2 a2 = (f32x2){r0.x, r0.y} * w01; a2 += (f32x2){r0.z, r0.w} * w23; a2 += (f32x2){r1.x, r1.y} * w45; a2 += (f32x2){r1.z, r1.w} * w67;
        a2 += (f32x2){r2.x, r2.y} * w89; a2 += (f32x2){r2.z, r2.w} * wab; a2 += (f32x2){r3.x, r3.y} * wcd; a2 += (f32x2){r3.z, r3.w} * wef;
        const float gk = bias + (a2.x + a2.y);
        const float l2 = __builtin_amdgcn_logf(1.f + __builtin_amdgcn_exp2f(-fabsf(gk) * LOG2E_));
        float g = (fminf(gk, 0.f) - l2 * 0.6931471805599453f) * (1.f / 16.f); if (i >= ntok) g = 0.f;
        bc += g; B[i] = bc; }
    const float bmid = (ntok == 64) ? B[32] : B[8], blast = B[63];
    float* VEC = (float*)(F.ws + WS_VEC) + (size_t)(cid * 4 + hd) * 1024;
    VEC[d] = __expf(bmid); VEC[512 + d] = __expf(blast - bmid);
    unsigned kpk[32]; float kprev = 0.f;
#pragma unroll
    for (int i = 0; i < 64; ++i) {
        const float q = bf2f(QL[i * CL_PITCH + d]), k = bf2f(KL[i * CL_PITCH + d]);
        const float qt = q * GLA_QSCALE * __expf(B[i] - bmid), kt = k * __expf(bmid - B[i]);
        QL[i * CL_PITCH + d] = (bf16)(cvtpk(qt, 0.f) & 0xffffu);
        KL[i * CL_PITCH + d] = (bf16)(cvtpk(kt, 0.f) & 0xffffu);
        if (i & 1) kpk[i >> 1] = cvtpk(kprev, kt); else kprev = kt; }
    __syncthreads();
    unsigned char* fq = F.ws + WS_FRAG + (size_t)(cid * 4 + hd) * 131072; unsigned char* fk = fq + 65536;
    { const int dt = (d >> 5) & 1, dl = d & 31;
#pragma unroll
      for (int sp = 0; sp < 4; ++sp)
#pragma unroll
          for (int hh = 0; hh < 2; ++hh) { u32x4 o; o.x = kpk[8 * sp + 4 * hh]; o.y = kpk[8 * sp + 4 * hh + 1]; o.z = kpk[8 * sp + 4 * hh + 2]; o.w = kpk[8 * sp + 4 * hh + 3];
              *(u32x4*)(fk + ((wv * 2 + dt) * 4 + sp) * 1024 + (dl + 32 * hh) * 16) = o; } }
#pragma unroll
    for (int mt = 0; mt < 2; ++mt)
#pragma unroll
        for (int dt = 0; dt < 2; ++dt)
#pragma unroll
            for (int s = 0; s < 2; ++s) { const int i = 32 * mt + (lane & 31), d0 = 64 * wv + 32 * dt + 16 * s + 4 * h;
                const u32x2 a = *(const LAS u32x2*)(QL + i * CL_PITCH + d0), b = *(const LAS u32x2*)(QL + i * CL_PITCH + d0 + 8);
                u32x4 o; o.x = a.x; o.y = a.y; o.z = b.x; o.w = b.y;
                *(u32x4*)(fq + (((wv * 2 + mt) * 2 + dt) * 2 + s) * 1024 + lane * 16) = o; }
    const int tile = wv & 3, jt = tile >> 1, it = tile & 1, kh = wv >> 2;
    f32x16 acc;
#pragma unroll
    for (int r = 0; r < 16; ++r) acc[r] = 0.f;
#pragma unroll
    for (int ks = 0; ks < 16; ++ks) { const int dk = 256 * kh + 16 * ks + 8 * h;
        const bf16x8 a = *(const LAS bf16x8*)(KL + (32 * jt + (lane & 31)) * CL_PITCH + dk);
        const bf16x8 b = *(const LAS bf16x8*)(QL + (32 * it + (lane & 31)) * CL_PITCH + dk);
        acc = MFMA32(a, b, acc); }
    if (kh == 1) {
#pragma unroll
        for (int r = 0; r < 16; ++r) RED[(tile * 16 + r) * 64 + lane] = acc[r]; }
    __syncthreads();
    if (kh == 0) {
        const int i = 32 * it + (lane & 31);
#pragma unroll
        for (int r = 0; r < 16; ++r) { const float v = acc[r] + RED[(tile * 16 + r) * 64 + lane]; const int j = 32 * jt + crow(r, h); acc[r] = (j > i) ? 0.f : v; }
        unsigned char* am = F.ws + WS_AMAT + (size_t)(cid * 4 + hd) * 8192;
#pragma unroll
        for (int s = 0; s < 2; ++s) { const bf16x8 p = pack8(acc, s); *(bf16x8*)(am + (it + 2 * (2 * jt + s)) * 1024 + lane * 16) = p; }
    }
    __syncthreads();
}

constexpr int KS_PITCH = 72, VT_PITCH = 196;
constexpr float LOG2E = 1.4426950408889634f;
constexpr size_t WS_DUMMY = 1600 * MiB;
template <bool SAMPLE, bool DUMMY = false>
__device__ __forceinline__ void swa_unit(Frame& F, int b, int n, int g) {
    const int tid = F.tid, lane = F.lane, wv = F.wave, h = lane >> 5;
    LAS bf16* KS = (LAS bf16*)F.lds; LAS bf16* VT = KS + 192 * KS_PITCH;
    int nk, ntile;
    if (!SAMPLE) {
        nk = 64 * (n + 1 < 3 ? n + 1 : 3); ntile = nk >> 5;
        const int kr0 = b * SEQ + 64 * (n > 2 ? n - 2 : 0);
        for (int task = tid; task < nk * 8; task += NTHR) { const int key = task >> 3, c8 = task & 7;
            *(LAS u32x4*)(KS + key * KS_PITCH + 8 * c8) = *(const u32x4*)(F.PROJ + pj(kr0 + key, C_KB + g * 64 + 8 * c8)); }
        for (int task = tid; task < nk * 8; task += NTHR) { const int kp = task >> 4, dq = task & 15;
            const bf16* vp = F.PROJ + pj(kr0 + 2 * kp, C_VB + g * 64 + 4 * dq);
            const u32x2 a = *(const u32x2*)vp, c = *(const u32x2*)(vp + 256);
            LAS unsigned* o = (LAS unsigned*)(VT + (4 * dq) * VT_PITCH + 2 * kp);
            o[0] = (a.x & 0xffffu) | (c.x << 16); o[VT_PITCH / 2] = (a.x >> 16) | (c.x & 0xffff0000u);
            o[VT_PITCH] = (a.y & 0xffffu) | (c.y << 16); o[3 * (VT_PITCH / 2)] = (a.y >> 16) | (c.y & 0xffff0000u); }
    } else {
        nk = 144; ntile = 5;
        const float* ck = F.in[I_CK]; const float* cv = F.in[I_CV];
        for (int task = tid; task < 160 * 8; task += NTHR) { const int key = task >> 3, t = task & 7; u32x4 o = (u32x4){0u, 0u, 0u, 0u};
            if (key < 128) { const float* p = ck + ((size_t)(b * 128 + key) * 8 + g) * 64; const f32x4 x1 = *(const f32x4*)(p + 4 * t), x2 = *(const f32x4*)(p + 32 + 4 * t);
                o.x = cvtpk(x1.x, x1.y); o.y = cvtpk(x1.z, x1.w); o.z = cvtpk(x2.x, x2.y); o.w = cvtpk(x2.z, x2.w); }
            else if (key < 144) o = *(const u32x4*)(F.PROJ + pj(MP + 16 * b + (key - 128), C_KB + g * 64 + 8 * t));
            *(LAS u32x4*)(KS + key * KS_PITCH + 8 * t) = o; }
        for (int task = tid; task < 80 * 16; task += NTHR) { const int kp = task >> 4, dq = task & 15; unsigned w0 = 0u, w1 = 0u, w2 = 0u, w3 = 0u;
            if (kp < 64) { const float* p = cv + ((size_t)(b * 128 + 2 * kp) * 8 + g) * 64 + 4 * dq; const f32x4 a = *(const f32x4*)p, c = *(const f32x4*)(p + 512);
                w0 = cvtpk(a.x, c.x); w1 = cvtpk(a.y, c.y); w2 = cvtpk(a.z, c.z); w3 = cvtpk(a.w, c.w); }
            else if (kp < 72) { const bf16* vp = F.PROJ + pj(MP + 16 * b + 2 * (kp - 64), C_VB + g * 64 + 4 * dq);
                const u32x2 a = *(const u32x2*)vp, c = *(const u32x2*)(vp + 256);
                w0 = (a.x & 0xffffu) | (c.x << 16); w1 = (a.x >> 16) | (c.x & 0xffff0000u); w2 = (a.y & 0xffffu) | (c.y << 16); w3 = (a.y >> 16) | (c.y & 0xffff0000u); }
            LAS unsigned* o = (LAS unsigned*)(VT + (4 * dq) * VT_PITCH + 2 * kp);
            o[0] = w0; o[VT_PITCH / 2] = w1; o[VT_PITCH] = w2; o[3 * (VT_PITCH / 2)] = w3; }
    }
    __syncthreads();
    const int npass = SAMPLE ? 1 : 2;
    if (!SAMPLE || wv < 4) {
#pragma unroll 1
        for (int pass = 0; pass < npass; ++pass) {
            const int r = lane & 31;
            int head, row;
            if (!SAMPLE) { head = g * 8 + wv; row = b * SEQ + 64 * n + 32 * pass + r; }
            else { head = g * 8 + 2 * wv + (r >> 4); row = MP + 16 * b + (r & 15); }
            const float sink2 = F.in[I_SINK][head] * LOG2E;
            bf16* qptr = F.PROJ + pj(row, C_QB + head * 64);
            bf16x8 qf[4];
#pragma unroll
            for (int t = 0; t < 4; ++t) qf[t] = *(const bf16x8*)(qptr + 16 * t + 8 * h);
            f32x16 st[6];
#pragma unroll
            for (int kt = 0; kt < 6; ++kt) {
#pragma unroll
                for (int rr = 0; rr < 16; ++rr) st[kt][rr] = -INFINITY;
                if (kt < ntile) { f32x16 a;
#pragma unroll
                    for (int rr = 0; rr < 16; ++rr) a[rr] = 0.f;
#pragma unroll
                    for (int t = 0; t < 4; ++t) { const bf16x8 kf = *(const LAS bf16x8*)(KS + (32 * kt + r) * KS_PITCH + 16 * t + 8 * h); a = MFMA32(kf, qf[t], a); }
                    st[kt] = a; } }
            if (SAMPLE) {
#pragma unroll
                for (int rr = 0; rr < 16; ++rr) if (crow(rr, h) >= 16) st[4][rr] = -INFINITY; }
            float m = sink2;
#pragma unroll
            for (int kt = 0; kt < 6; ++kt)
#pragma unroll
                for (int rr = 0; rr < 16; ++rr) m = fmaxf(m, st[kt][rr]);
            m = fmaxf(m, __shfl_xor(m, 32));
            float sum = 0.f;
#pragma unroll
            for (int kt = 0; kt < 6; ++kt)
#pragma unroll
                for (int rr = 0; rr < 16; ++rr) { const float p = __builtin_amdgcn_exp2f(st[kt][rr] - m); st[kt][rr] = p; sum += p; }
            sum += __shfl_xor(sum, 32);
            const float inv = 1.f / (sum + __builtin_amdgcn_exp2f(sink2 - m));
            f32x16 o0, o1;
#pragma unroll
            for (int rr = 0; rr < 16; ++rr) { o0[rr] = 0.f; o1[rr] = 0.f; }
#pragma unroll
            for (int kt = 0; kt < 6; ++kt) if (kt < ntile) {
#pragma unroll
                for (int s = 0; s < 2; ++s) { const bf16x8 pb = pack8(st[kt], s);
                    const LAS bf16* v0 = VT + r * VT_PITCH + 32 * kt + 16 * s + 4 * h; const LAS bf16* v1 = v0 + 32 * VT_PITCH;
                    const u32x2 a0 = *(const LAS u32x2*)v0, a1 = *(const LAS u32x2*)(v0 + 8), c0 = *(const LAS u32x2*)v1, c1 = *(const LAS u32x2*)(v1 + 8);
                    u32x4 va; va.x = a0.x; va.y = a0.y; va.z = a1.x; va.w = a1.y; u32x4 vc; vc.x = c0.x; vc.y = c0.y; vc.z = c1.x; vc.w = c1.y;
                    o0 = MFMA32(__builtin_bit_cast(bf16x8, va), pb, o0); o1 = MFMA32(__builtin_bit_cast(bf16x8, vc), pb, o1); } }
#pragma unroll
            for (int rg = 0; rg < 4; ++rg) { u32x2 w0, w1;
                w0.x = cvtpk(o0[4 * rg] * inv, o0[4 * rg + 1] * inv); w0.y = cvtpk(o0[4 * rg + 2] * inv, o0[4 * rg + 3] * inv);
                w1.x = cvtpk(o1[4 * rg] * inv, o1[4 * rg + 1] * inv); w1.y = cvtpk(o1[4 * rg + 2] * inv, o1[4 * rg + 3] * inv);
                bf16* optr = DUMMY ? (bf16*)(F.ws + WS_DUMMY) + (size_t)(row & 1023) * 4096 + head * 64 : qptr;
                *(u32x2*)(optr + 8 * rg + 4 * h) = w0; *(u32x2*)(optr + 32 + 8 * rg + 4 * h) = w1; }
        }
    }
    __syncthreads();
}

constexpr int P3_CL = 264 * 4, P3_SWAP = 2048, P3_SWAS = 64, P3_UNITS = P3_CL + P3_SWAP + P3_SWAS;
__device__ __forceinline__ void p3_phase(Frame& F) {
    for (int u = F.bid; u < P3_CL; u += F.G) gla_chunk_local(F, u >> 2, u & 3);
#if PROBE_TWICE == 105
    for (int u = F.bid; u < P3_CL; u += F.G) gla_chunk_local(F, u >> 2, u & 3);
#endif
#if PROBE_TWICE == 103
    for (int v = (F.bid + F.G - (P3_CL % F.G)) % F.G; v < P3_SWAP; v += F.G) swa_unit<false, true>(F, v >> 10, (v >> 3) & 127, v & 7);
#endif
    const bool bal = F.G == 256;
    for (int v = (F.bid + F.G - (P3_CL % F.G)) % F.G, k = 0; v < P3_SWAP; v += F.G, ++k) { if (bal && F.bid < 32 && k >= 6) break; swa_unit<false>(F, v >> 10, (v >> 3) & 127, v & 7); }
    if (bal && F.bid >= 96 && F.bid < 160) { const int src = (F.bid - 96) >> 1, v = ((src + F.G - (P3_CL % F.G)) % F.G) + F.G * (6 + ((F.bid - 96) & 1)); swa_unit<false>(F, v >> 10, (v >> 3) & 127, v & 7); }
    for (int v = (F.bid + 2 * F.G - ((P3_CL + P3_SWAP) % F.G)) % F.G; v < P3_SWAS; v += F.G) swa_unit<true>(F, v >> 3, 0, v & 7);
}

__device__ __forceinline__ u32x2 tr_read8(unsigned addr) { u32x2 r; asm volatile("ds_read_b64_tr_b16 %0, %1\n\ts_waitcnt lgkmcnt(0)" : "=&v"(r) : "v"(addr) : "memory"); return r; }
struct ScanQ { bf16x8 qf[2][2][2], af; };
__device__ __forceinline__ void scan_load_q(ScanQ& P, const unsigned char* ws, int cid, int hd, int wv, int lane) {
    const unsigned char* fq = ws + WS_FRAG + (size_t)(cid * 4 + hd) * 131072;
#pragma unroll
    for (int mt = 0; mt < 2; ++mt)
#pragma unroll
        for (int dt = 0; dt < 2; ++dt)
#pragma unroll
            for (int s = 0; s < 2; ++s) P.qf[mt][dt][s] = *(const bf16x8*)(fq + (((wv * 2 + mt) * 2 + dt) * 2 + s) * 1024 + lane * 16);
    P.af = *(const bf16x8*)(ws + WS_AMAT + (size_t)(cid * 4 + hd) * 8192 + wv * 1024 + lane * 16);
}
__device__ __forceinline__ void scan_load_v(u32x4& vt, f32x4& vec, const unsigned char* ws, const bf16* PROJ, int cid, int hd, int row0, int ntok, int e0, int tid) {
    vt = (u32x4){0u, 0u, 0u, 0u}; vec = (f32x4){0.f, 0.f, 0.f, 0.f};
    if (tid < 256) { const int i = tid >> 2, c4 = tid & 3;
        if (i < ntok) vt = *(const u32x4*)(PROJ + pj(row0 + i, C_VA + hd * 1024 + e0 + 8 * c4));
        vec = *(const f32x4*)((const float*)(ws + WS_VEC) + (size_t)(cid * 4 + hd) * 1024 + 4 * tid); }
}
__device__ __forceinline__ void scan_store_v(LAS unsigned char* base, const u32x4& vt, const f32x4& vec, int tid) {
    if (tid < 256) { *(LAS u32x4*)((LAS bf16*)base + (tid >> 2) * 32 + 8 * (tid & 3)) = vt; *(LAS f32x4*)((LAS float*)(base + 4096) + 4 * tid) = vec; }
}
struct ScanK { bf16x8 kf[2][4]; };
__device__ __forceinline__ void scan_load_k(ScanK& P, const unsigned char* ws, int cid, int hd, int wv, int lane) {
    const unsigned char* fk = ws + WS_FRAG + (size_t)(cid * 4 + hd) * 131072 + 65536;
#pragma unroll
    for (int dt = 0; dt < 2; ++dt)
#pragma unroll
        for (int sp = 0; sp < 4; ++sp) P.kf[dt][sp] = *(const bf16x8*)(fk + ((wv * 2 + dt) * 4 + sp) * 1024 + lane * 16);
}
constexpr int SC_BUF = 73728, SC_VEC = 4096, SC_RED = 8192;
struct ScanTr { u32x2 n[8]; };
__device__ __forceinline__ void scan_tr_reads_p(u32x2& p0, u32x2& p1, unsigned aP) {
    asm volatile("ds_read_b64_tr_b16 %0, %2\n\tds_read_b64_tr_b16 %1, %2 offset:512\n\ts_waitcnt lgkmcnt(0)" : "=&v"(p0), "=&v"(p1) : "v"(aP) : "memory");
}
__device__ __forceinline__ void scan_tr_reads_n(ScanTr& T, unsigned aN) {
    asm volatile("ds_read_b64_tr_b16 %0, %8\n\tds_read_b64_tr_b16 %1, %8 offset:256\n\t"
                 "ds_read_b64_tr_b16 %2, %8 offset:1024\n\tds_read_b64_tr_b16 %3, %8 offset:1280\n\t"
                 "ds_read_b64_tr_b16 %4, %8 offset:2048\n\tds_read_b64_tr_b16 %5, %8 offset:2304\n\t"
                 "ds_read_b64_tr_b16 %6, %8 offset:3072\n\tds_read_b64_tr_b16 %7, %8 offset:3328\n\ts_waitcnt lgkmcnt(0)"
                 : "=&v"(T.n[0]), "=&v"(T.n[1]), "=&v"(T.n[2]), "=&v"(T.n[3]), "=&v"(T.n[4]), "=&v"(T.n[5]), "=&v"(T.n[6]), "=&v"(T.n[7])
                 : "v"(aN) : "memory");
}
template <bool DUMMY, int BUF>
__device__ __forceinline__ void scan_reduce(Frame& F, int hd, int row0, int ntok, int e0) {
    const int tid = F.tid; LAS float* RED = (LAS float*)(F.lds + BUF * SC_BUF + SC_RED);
    const int i = tid >> 3, e4 = 4 * (tid & 7); f32x4 sacc = *(const LAS f32x4*)(RED + i * 32 + e4);
#pragma unroll
    for (int w = 1; w < 8; ++w) sacc += *(const LAS f32x4*)(RED + w * 2048 + i * 32 + e4);
    if (i < ntok) { u32x2 o; o.x = cvtpk(sacc.x, sacc.y); o.y = cvtpk(sacc.z, sacc.w);
        bf16* op_ = DUMMY ? (bf16*)(F.ws + WS_DUMMY) + (size_t)((row0 + i) & 1023) * 4096 + hd * 1024 + e0 + e4 : F.PROJ + pj(row0 + i, C_VA + hd * 1024 + e0 + e4);
        *(u32x2*)op_ = o; }
}
template <bool SAMPLE, bool DUMMY, int BUF>
__device__ __forceinline__ void scan_step(Frame& F, f32x16& S0, f32x16& S1, ScanQ& cq, ScanK& ck, int cidn, int hd, int rowp, int rown, int ntok, int e0) {
    const int tid = F.tid, lane = F.lane, wv = F.wave, h = lane >> 5, el = lane & 31;
    LAS unsigned char* base = F.lds + BUF * SC_BUF;
    LAS bf16* VB = (LAS bf16*)base; LAS float* VECL = (LAS float*)(base + SC_VEC); LAS float* RED = (LAS float*)(base + SC_RED);
    __syncthreads();
    u32x4 nvt; f32x4 nvec;
    if (!SAMPLE) scan_load_v(nvt, nvec, F.ws, F.PROJ, cidn, hd, rown, ntok, e0, tid);
    if (!SAMPLE && rowp >= 0) scan_reduce<DUMMY, BUF ^ 1>(F, hd, rowp, ntok, e0);
    const int i16 = lane & 15; const unsigned tro = (unsigned)(size_t)VB + (unsigned)((i16 >> 2) * 64 + 32 * ((lane >> 4) & 1) + 8 * (i16 & 3));
    u32x2 tp0, tp1; scan_tr_reads_p(tp0, tp1, tro + (unsigned)((16 * (wv >> 1) + 4 * h) * 64));
#pragma unroll
    for (int rg = 0; rg < 4; ++rg) { const f32x4 e0v = *(const LAS f32x4*)(VECL + 64 * wv + 8 * rg + 4 * h), e1v = *(const LAS f32x4*)(VECL + 64 * wv + 32 + 8 * rg + 4 * h);
#pragma unroll
        for (int x = 0; x < 4; ++x) { S0[4 * rg + x] *= e0v[x]; S1[4 * rg + x] *= e1v[x]; } }
    bf16x8 vP; { u32x4 vv; vv.x = tp0.x; vv.y = tp0.y; vv.z = tp1.x; vv.w = tp1.y; vP = __builtin_bit_cast(bf16x8, vv); }
    LAS float* rw = RED + wv * 2048;
#pragma unroll
    for (int mt = 0; mt < 2; ++mt) {
        f32x16 op;
#pragma unroll
        for (int r = 0; r < 16; ++r) op[r] = 0.f;
        op = MFMA32(cq.qf[mt][0][0], pack8(S0, 0), op); op = MFMA32(cq.qf[mt][0][1], pack8(S0, 1), op); op = MFMA32(cq.qf[mt][1][0], pack8(S1, 0), op); op = MFMA32(cq.qf[mt][1][1], pack8(S1, 1), op);
        if ((wv & 1) == mt) op = MFMA32(cq.af, vP, op);
#pragma unroll
        for (int r = 0; r < 16; ++r) rw[(32 * mt + crow(r, h)) * 32 + el] = op[r];
    }
    asm volatile("" ::: "memory");
    if (!SAMPLE) scan_load_q(cq, F.ws, cidn, hd, wv, lane);
    ScanTr T; scan_tr_reads_n(T, tro + (unsigned)(8 * h * 64));
#pragma unroll
    for (int sp = 0; sp < 4; ++sp) { u32x4 vv; vv.x = T.n[2 * sp].x; vv.y = T.n[2 * sp].y; vv.z = T.n[2 * sp + 1].x; vv.w = T.n[2 * sp + 1].y;
        const bf16x8 vN = __builtin_bit_cast(bf16x8, vv);
        S0 = MFMA32(ck.kf[0][sp], vN, S0); S1 = MFMA32(ck.kf[1][sp], vN, S1); }
    asm volatile("" ::: "memory");
    if (!SAMPLE) scan_load_k(ck, F.ws, cidn, hd, wv, lane);
#pragma unroll
    for (int rg = 0; rg < 4; ++rg) { const f32x4 e0v = *(const LAS f32x4*)(VECL + 512 + 64 * wv + 8 * rg + 4 * h), e1v = *(const LAS f32x4*)(VECL + 512 + 64 * wv + 32 + 8 * rg + 4 * h);
#pragma unroll
        for (int x = 0; x < 4; ++x) { S0[4 * rg + x] *= e0v[x]; S1[4 * rg + x] *= e1v[x]; } }
    if (!SAMPLE) scan_store_v(F.lds + (BUF ^ 1) * SC_BUF, nvt, nvec, tid);
}
template <bool SAMPLE, bool DUMMY = false>
__device__ __forceinline__ void scan_item(Frame& F, int seq, int slice) {
    const int tid = F.tid, lane = F.lane, wv = F.wave, h = lane >> 5, el = lane & 31;
    const int hd = seq & 3, b = seq >> 2, e0 = slice * 32;
    const int nchunks = SAMPLE ? 1 : 128, cid0 = SAMPLE ? 256 + b : b * 128, ntok = SAMPLE ? 16 : 64, row00 = SAMPLE ? MP + 16 * b : b * SEQ;
    ScanQ qa; ScanK ka;
    scan_load_q(qa, F.ws, cid0, hd, wv, lane);
    scan_load_k(ka, F.ws, cid0, hd, wv, lane);
    { u32x4 vt; f32x4 vec; scan_load_v(vt, vec, F.ws, F.PROJ, cid0, hd, row00, ntok, e0, tid); scan_store_v(F.lds, vt, vec, tid); }
    f32x16 S0, S1;
#pragma unroll
    for (int r = 0; r < 16; ++r) { S0[r] = 0.f; S1[r] = 0.f; }
    if (SAMPLE) { const float* sp = F.in[I_SG] + ((size_t)(b * 4 + hd) * 512 + 64 * wv + 4 * h) * 1024 + e0 + el;
#pragma unroll
        for (int rg = 0; rg < 4; ++rg) {
#pragma unroll
            for (int x = 0; x < 4; ++x) { S0[4 * rg + x] = sp[(size_t)(8 * rg + x) * 1024]; S1[4 * rg + x] = sp[(size_t)(32 + 8 * rg + x) * 1024]; }
            asm volatile("" ::: "memory"); } }
    if (SAMPLE) { scan_step<true, DUMMY, 0>(F, S0, S1, qa, ka, cid0, hd, -1, row00, ntok, e0); __syncthreads(); scan_reduce<DUMMY, 0>(F, hd, row00, ntok, e0); __syncthreads(); }
    else {
#pragma unroll 1
        for (int c = 0; c < nchunks; c += 2) {
            const int c2 = c + 2 < nchunks ? c + 2 : c + 1;
            scan_step<false, DUMMY, 0>(F, S0, S1, qa, ka, cid0 + c + 1, hd, c > 0 ? row00 + 64 * (c - 1) : -1, row00 + 64 * (c + 1), ntok, e0);
            scan_step<false, DUMMY, 1>(F, S0, S1, qa, ka, cid0 + c2, hd, row00 + 64 * c, row00 + 64 * c2, ntok, e0);
        }
        __syncthreads();
        scan_reduce<DUMMY, 1>(F, hd, row00 + 64 * (nchunks - 1), ntok, e0);
        __syncthreads();
    }
    { int h2 = h; asm volatile("" : "+v"(h2));
      float* so = F.out + (SAMPLE ? OUT_SGS : OUT_SGP) + ((size_t)(b * 4 + hd) * 512) * 1024 + e0 + (lane & 31) + (size_t)(64 * wv + 4 * h2) * 1024;
#pragma unroll
      for (int r = 0; r < 16; ++r) { so[(size_t)((r & 3) + 8 * (r >> 2)) * 1024] = S0[r]; so[(size_t)(32 + (r & 3) + 8 * (r >> 2)) * 1024] = S1[r]; } }
}
__device__ __forceinline__ void p4_phase(Frame& F) {
#if PROBE_TWICE == 104
    for (int it = F.bid; it < 256; it += F.G) scan_item<false, true>(F, it >> 5, it & 31);
#endif
    for (int it = F.bid; it < 256; it += F.G) scan_item<false>(F, it & 7, (it >> 3) & 31);
    { int t_ = threadIdx.x; asm volatile("" : "+v"(t_)); F.tid = t_; F.lane = t_ & 63; F.wave = __builtin_amdgcn_readfirstlane(t_ >> 6); }
    for (int it = F.bid; it < 1024; it += F.G) scan_item<true>(F, (it & 7) + 8 * (it >> 8), (it >> 3) & 31);
}

__device__ __forceinline__ void unpack8(const u32x4 w, float (&f)[8]) { f[0] = bflo(w.x); f[1] = bfhi(w.x); f[2] = bflo(w.y); f[3] = bfhi(w.y); f[4] = bflo(w.z); f[5] = bfhi(w.z); f[6] = bflo(w.w); f[7] = bfhi(w.w); }
__device__ __forceinline__ void p5_merge(Frame& F) {
    const int gw = F.bid * NWAVES + F.wave, NGW = F.G * NWAVES, lane = F.lane;
    const float* gg = F.in[I_GGLA] + 16 * lane;
    for (int row = gw; row < MPAD; row += NGW) {
        if (row >= MREAL) {
#pragma unroll
            for (int j = 0; j < 8; ++j) *(u32x4*)((unsigned char*)F.H + pg8::img_off(row, 512 * j + 8 * lane, D / 64, false)) = (u32x4){0u, 0u, 0u, 0u};
            continue; }
#pragma unroll 2
        for (int hd = 0; hd < 4; ++hd) {
            const int c = hd * 1024 + 16 * lane;
            const u32x4 wo0 = *(const u32x4*)(F.PROJ + pj(row, C_VA + c)), wo1 = *(const u32x4*)(F.PROJ + pj(row, C_VA + c) + 8);
            const u32x4 wg0 = *(const u32x4*)(F.PROJ + pj(row, C_GA + c)), wg1 = *(const u32x4*)(F.PROJ + pj(row, C_GA + c) + 8);
            const u32x4 wb0 = *(const u32x4*)(F.PROJ + pj(row, C_ZB + c)), wb1 = *(const u32x4*)(F.PROJ + pj(row, C_ZB + c) + 8);
            const u32x4 wq0 = *(const u32x4*)(F.PROJ + pj(row, C_QB + c)), wq1 = *(const u32x4*)(F.PROJ + pj(row, C_QB + c) + 8);
            float o[16], ga[16], zb[16], ob[16];
#define UP16(dst, w0, w1) { float t[8]; unpack8(w0, t); _Pragma("unroll") for (int x = 0; x < 8; ++x) dst[x] = t[x]; unpack8(w1, t); _Pragma("unroll") for (int x = 0; x < 8; ++x) dst[8 + x] = t[x]; }
            UP16(o, wo0, wo1)
            float ss = 0.f;
#pragma unroll
            for (int x = 0; x < 16; ++x) ss += o[x] * o[x];
            const float r = 1.0f / sqrtf(wave_sum(ss) * (1.f / 1024.f) + NORM_EPS);
            UP16(ga, wg0, wg1) UP16(zb, wb0, wb1) UP16(ob, wq0, wq1)
#undef UP16
            float mg[16];
#pragma unroll
            for (int x = 0; x < 16; ++x) mg[x] = (o[x] * r * gg[x]) * ga[x] + zb[x] * ob[x];
            u32x4 w0, w1; w0.x = cvtpk(mg[0], mg[1]); w0.y = cvtpk(mg[2], mg[3]); w0.z = cvtpk(mg[4], mg[5]); w0.w = cvtpk(mg[6], mg[7]);
            w1.x = cvtpk(mg[8], mg[9]); w1.y = cvtpk(mg[10], mg[11]); w1.z = cvtpk(mg[12], mg[13]); w1.w = cvtpk(mg[14], mg[15]);
            *(u32x4*)((unsigned char*)F.H + pg8::img_off(row, c, D / 64, false)) = w0; *(u32x4*)((unsigned char*)F.H + pg8::img_off(row, c + 8, D / 64, false)) = w1;
        }
    }
}

template <int MODE> struct EpiRes {
    static constexpr bool PERM = true;
    const float* srcf; const bf16* srcb; float* outf; bf16* outb; const float* mod; int off_gt;
    __device__ __forceinline__ void operator()(const f32x4 (&acc)[2][2][4][2], const pg8::Unit& u, int wr, int wc, int fr, int fq) const {
        const int col0 = u.pn * 256 + wc * 32 + 8 * fq;
        const float* gt = mod + (size_t)(u.pm >> 5) * NMOD + off_gt + col0;
        f32x4 g[2][2];
#pragma unroll
        for (int bj = 0; bj < 2; ++bj)
#pragma unroll
            for (int n = 0; n < 2; ++n) g[bj][n] = *(const f32x4*)(gt + bj * 128 + n * 4);
#pragma unroll
        for (int ai = 0; ai < 2; ++ai) {
            const size_t rbase = (size_t)(u.pm * 256 + ai * 128 + wr * 64 + fr) * D + col0;
            if (MODE == 0) {
                f32x4 x[4][2][2];
#pragma unroll
                for (int m = 0; m < 4; ++m)
#pragma unroll
                    for (int bj = 0; bj < 2; ++bj)
#pragma unroll
                        for (int n = 0; n < 2; ++n) x[m][bj][n] = *(const f32x4*)(srcf + rbase + (size_t)(m * 16) * D + bj * 128 + n * 4);
#pragma unroll
                for (int m = 0; m < 4; ++m)
#pragma unroll
                    for (int bj = 0; bj < 2; ++bj) { const f32x4 a = x[m][bj][0] + g[bj][0] * acc[ai][bj][m][0], b = x[m][bj][1] + g[bj][1] * acc[ai][bj][m][1];
                        u32x4 w; w.x = cvtpk(a.x, a.y); w.y = cvtpk(a.z, a.w); w.z = cvtpk(b.x, b.y); w.w = cvtpk(b.z, b.w);
                        *(u32x4*)(outb + rbase + (size_t)(m * 16) * D + bj * 128) = w; }
            } else {
                u32x4 x[4][2];
#pragma unroll
                for (int m = 0; m < 4; ++m)
#pragma unroll
                    for (int bj = 0; bj < 2; ++bj) x[m][bj] = *(const u32x4*)(srcb + rbase + (size_t)(m * 16) * D + bj * 128);
#pragma unroll
                for (int m = 0; m < 4; ++m)
#pragma unroll
                    for (int bj = 0; bj < 2; ++bj) { const u32x4 w = x[m][bj];
                        const f32x4 xa = (f32x4){bflo(w.x), bfhi(w.x), bflo(w.y), bfhi(w.y)}, xb = (f32x4){bflo(w.z), bfhi(w.z), bflo(w.w), bfhi(w.w)};
                        const f32x4 a = xa + g[bj][0] * acc[ai][bj][m][0], b = xb + g[bj][1] * acc[ai][bj][m][1];
                        u32x4 o; o.x = cvtpk(a.x, a.y); o.y = cvtpk(a.z, a.w); o.z = cvtpk(b.x, b.y); o.w = cvtpk(b.z, b.w);
                        *(u32x4*)(outb + rbase + (size_t)(m * 16) * D + bj * 128) = o; }
            }
        }
    }
};
template <int K, int MODE, bool BIMG, bool AIMG>
__device__ __forceinline__ void skinny_res(Frame& F, const bf16* A, const bf16* Bt, const float* srcf, const bf16* srcb, float* dstf, bf16* dstb, int off_gt) {
    const int lane = F.lane, wv = F.wave, fr = lane & 15, fq = lane >> 4;
    for (int nb = F.bid; nb < D / 16; nb += F.G) {
        const bf16* ap = A + (size_t)(MP + 16 * wv + fr) * K + 8 * fq;
        const int nrow = 16 * nb + fr;
        int sl = nrow & 127; { const int m = sl & 31; sl = (sl & ~31) + 16 * ((m >> 2) & 1) + 4 * (m >> 3) + (m & 3); }
        const unsigned char* bimg = (const unsigned char*)Bt + (size_t)(nrow >> 7) * (K / 64) * (size_t)pg8::HTB;
        const int oc0 = pg8::lds_byte(sl, 8 * fq), oc1 = pg8::lds_byte(sl, 32 + 8 * fq);
        const bf16* bp = Bt + (size_t)nrow * K + 8 * fq;
        const int arow = MP + 16 * wv + fr;
        const unsigned char* aimg = (const unsigned char*)A + (size_t)(arow >> 7) * (K / 64) * (size_t)pg8::HTB;
        const int ac0 = pg8::lds_byte(arow & 127, 8 * fq), ac1 = pg8::lds_byte(arow & 127, 32 + 8 * fq);
#define SK_ALOAD(kk, u) (AIMG ? *(const bf16x8*)(aimg + (size_t)(((kk) >> 6) + ((u) >> 1)) * pg8::HTB + (((u) & 1) ? ac1 : ac0)) : *(const bf16x8*)(ap + (kk) + 32 * (u)))
#define SK_BLOAD(kk, u) (BIMG ? *(const bf16x8*)(bimg + (size_t)(((kk) >> 6) + ((u) >> 1)) * pg8::HTB + (((u) & 1) ? oc1 : oc0)) : *(const bf16x8*)(bp + (kk) + 32 * (u)))
        f32x4 acc0 = (f32x4){0.f, 0.f, 0.f, 0.f}, acc1 = acc0;
        bf16x8 a[8], b[8], a2[8], b2[8];
#pragma unroll
        for (int u = 0; u < 8; ++u) { a[u] = SK_ALOAD(0, u); b[u] = SK_BLOAD(0, u); }
#pragma unroll 1
        for (int k = 0; k < K; k += 512) {
            const int k1 = k + 256 < K ? k + 256 : k, k2 = k + 512 < K ? k + 512 : k1;
#pragma unroll
            for (int u = 0; u < 8; ++u) { a2[u] = SK_ALOAD(k1, u); b2[u] = SK_BLOAD(k1, u); }
#pragma unroll
            for (int u = 0; u < 8; u += 2) { acc0 = __builtin_amdgcn_mfma_f32_16x16x32_bf16(b[u], a[u], acc0, 0, 0, 0); acc1 = __builtin_amdgcn_mfma_f32_16x16x32_bf16(b[u + 1], a[u + 1], acc1, 0, 0, 0); }
#pragma unroll
            for (int u = 0; u < 8; ++u) { a[u] = SK_ALOAD(k2, u); b[u] = SK_BLOAD(k2, u); }
            if (k + 256 < K) {
#pragma unroll
                for (int u = 0; u < 8; u += 2) { acc0 = __builtin_amdgcn_mfma_f32_16x16x32_bf16(b2[u], a2[u], acc0, 0, 0, 0); acc1 = __builtin_amdgcn_mfma_f32_16x16x32_bf16(b2[u + 1], a2[u + 1], acc1, 0, 0, 0); } }
        }
        const int row = MP + 16 * wv + fr, col = 16 * nb + 4 * fq;
        const f32x4 g = *(const f32x4*)(F.MOD + (size_t)row_batch(row) * NMOD + off_gt + col), r = g * (acc0 + acc1);
        if (MODE == 0) { const f32x4 x = *(const f32x4*)(srcf + (size_t)(row - MP) * D + col) + r; u32x2 w; w.x = cvtpk(x.x, x.y); w.y = cvtpk(x.z, x.w); *(u32x2*)(dstb + (size_t)row * D + col) = w; }
        else { const u32x2 w = *(const u32x2*)(srcb + (size_t)row * D + col); const f32x4 x = (f32x4){bflo(w.x), bfhi(w.x), bflo(w.y), bfhi(w.y)} + r;
            u32x2 o; o.x = cvtpk(x.x, x.y); o.y = cvtpk(x.z, x.w); *(u32x2*)(dstb + (size_t)row * D + col) = o; }
    }
}

struct EpiGU {
    static constexpr bool PERM = true;
    bf16* ACT;
    __device__ __forceinline__ void operator()(const f32x4 (&acc)[2][2][4][2], const pg8::Unit& u, int wr, int wc, int fr, int fq) const {
#pragma unroll
        for (int ai = 0; ai < 2; ++ai)
#pragma unroll
            for (int m = 0; m < 4; ++m) {
                const int row = u.pm * 256 + ai * 128 + wr * 64 + m * 16 + fr;
                const f32x4 g0 = acc[ai][0][m][0], g1 = acc[ai][0][m][1], u0 = acc[ai][1][m][0], u1 = acc[ai][1][m][1];
                float a[8];
#pragma unroll
                for (int x = 0; x < 4; ++x) { a[x] = g0[x] * sigmoidf_(g0[x]) * u0[x]; a[4 + x] = g1[x] * sigmoidf_(g1[x]) * u1[x]; }
                u32x4 w; w.x = cvtpk(a[0], a[1]); w.y = cvtpk(a[2], a[3]); w.z = cvtpk(a[4], a[5]); w.w = cvtpk(a[6], a[7]);
                *(u32x4*)((unsigned char*)ACT + pg8::img_off(row, u.pn * 128 + wc * 32 + 8 * fq, DFF / 64, false)) = w;
            }
    }
};
__device__ __forceinline__ void p10_final(Frame& F, const bf16* X2B) {
    const int gw = F.bid * NWAVES + F.wave, NGW = F.G * NWAVES;
    for (int row = gw; row < MREAL; row += NGW) {
        const GAS u32x2* xr = (const GAS u32x2*)(X2B + (size_t)row * D) + F.lane;
        GAS f32x4* yr = (GAS f32x4*)(F.out + (size_t)row * D) + F.lane;
        f32x4 v[16]; float s = 0.f;
#pragma unroll
        for (int j = 0; j < 16; ++j) { const u32x2 w = xr[64 * j]; v[j] = (f32x4){bflo(w.x), bfhi(w.x), bflo(w.y), bfhi(w.y)}; s += (v[j].x * v[j].x + v[j].y * v[j].y) + (v[j].z * v[j].z + v[j].w * v[j].w); }
        const float r = 1.0f / sqrtf(wave_sum(s) * (1.f / D) + NORM_EPS);
#pragma unroll
        for (int j = 0; j < 16; ++j) { const f32x4 gg = *(const f32x4*)(F.in[I_GF] + 256 * j + 4 * F.lane); yr[64 * j] = (v[j] * r) * gg; }
    }
}

#if DBG_CHECK
__device__ __forceinline__ unsigned hash32(unsigned x) { x ^= x >> 16; x *= 0x7feb352du; x ^= x >> 15; x *= 0x846ca68bu; x ^= x >> 16; return x; }
__device__ __forceinline__ void dbg_report(Frame& F, int k, float e) { if (!(e == e) || e > 1e30f) e = 1e30f; atomicMax((unsigned*)F.DBG + k, __float_as_uint(e)); }
__device__ __forceinline__ float relerr(float got, float ref, float floor_) { return fabsf(got - ref) / (fabsf(ref) + floor_); }
__device__ __forceinline__ int win_fwd(int c) {
    if (c < 12288) return c;
    if (c < 12304) return 25600 + (c - 12288);
    if (c < 16912) { const bool isq = c < 16400; const int r = c - (isq ? 12304 : 16400), hh = r >> 6, d = r & 63;
        const int t = (d & 31) >> 2, e = (d & 3) + 4 * (d >> 5); return (isq ? 12288 : 16384) + 64 * hh + 8 * t + e; }
    return c - 16;
}
__device__ __forceinline__ int win_fwd_w(int c) {
    if (c >= 8192 && c < 12288) { const int i = c - 8192, ct = i >> 7; return (ct < 16 ? 8192 + 256 * ct : 17408 + 256 * (ct - 16)) + (i & 127); }
    if (c >= 17424 && c < 21520) { const int i = c - 17424, ct = i >> 7; return (ct < 16 ? 8192 + 256 * ct : 17408 + 256 * (ct - 16)) + 128 + (i & 127); }
    return win_fwd(c);
}
__device__ __forceinline__ int wgu_fwd(int c) { if (c < DFF) return 256 * (c >> 7) + (c & 127); const int c2 = c - DFF; return 256 * (c2 >> 7) + 128 + (c2 & 127); }
__device__ __forceinline__ float silu_ref(float x) { return x / (1.f + expf(-x)); }
__device__ __forceinline__ float cvec(const Frame& F, int b, int k) { return b < 2 ? F.in[I_CP][b * D + k] : F.in[I_CS][(b - 2) * D + k]; }
__device__ __forceinline__ float bfround(float x) { return bflo(cvtpk(x, 0.f)); }
__device__ __forceinline__ float dbg_h(const Frame& F, int row, int k) { return bf2f(*(const bf16*)((const unsigned char*)F.H + pg8::img_off(row, k & ~7, D / 64, false) + 2 * (k & 7))); }

__device__ __forceinline__ void dbg_check_p0p1(Frame& F) {
    const int gt = F.bid * NTHR + F.tid;
    if (gt < 512) {
        const unsigned h = hash32(gt * 7919u + 13u); const int b = gt % 10, col = (int)(h % NMOD);
        float s = 0.f; for (int k = 0; k < D; ++k) s += silu_ref(cvec(F, b, k)) * F.in[I_WADA][(size_t)k * NMOD + col];
        s += F.in[I_BADA][col];
        dbg_report(F, 0, relerr(F.MOD[b * NMOD + col], s, 0.05f));
    } else if (gt < 1024) {
        const unsigned h = hash32(gt * 31u + 5u); const int pos = (int)(h % 8192u), f = (int)((h >> 16) % 32u);
        const double inv = pow(10000.0, -(double)f / 32.0), a = (double)pos * inv;
        dbg_report(F, 1, fmaxf(fabsf(F.ROPEC[pos * 32 + f] - (float)cos(a)), fabsf(F.ROPES[pos * 32 + f] - (float)sin(a))) * 0.2f);
    } else if (gt < 1024 + 4096) {
        const int i = gt - 1024; const unsigned h = hash32(i * 2654435761u + 77u), h2 = hash32(h + 12345u);
        const int which = 0; float ref, got;
        if (which == 0) { const int k = (int)(h % D), c = (int)(h2 % N_IN); ref = bfround(F.in[I_WIN][(size_t)k * N_IN + c]); got = bf2f(*(const bf16*)((const unsigned char*)F.WIN + pg8::img_off(win_fwd_w(c), k & ~7, D / 64, true) + 2 * (k & 7))); }
        else if (which == 1) { const int k = (int)(h % D), c = (int)(h2 % D); ref = bfround(F.in[I_WOUT][(size_t)k * D + c]); got = bf2f(*(const bf16*)((const unsigned char*)F.WOUT + pg8::img_off(c, k & ~7, D / 64, true) + 2 * (k & 7))); }
        else if (which == 2) { const int k = (int)(h % D), c = (int)(h2 % N_GU); ref = bfround(F.in[I_WGU][(size_t)k * N_GU + c]); got = bf2f(*(const bf16*)((const unsigned char*)F.WGU + pg8::img_off(wgu_fwd(c), k & ~7, D / 64, true) + 2 * (k & 7))); }
        else { const int k = (int)(h % DFF), c = (int)(h2 % D); ref = bfround(F.in[I_WDN][(size_t)k * D + c]); got = bf2f(*(const bf16*)((const unsigned char*)F.WDN + pg8::img_off(c, k & ~7, DFF / 64, true) + 2 * (k & 7))); }
        dbg_report(F, 2, fabsf(got - ref) * 100.f);
        if (i < 240) { const int k = (int)(h % D); dbg_report(F, 2, fabsf(bf2f(*(const bf16*)((const unsigned char*)F.WIN + pg8::img_off(25616 + i, k & ~7, D / 64, true) + 2 * (k & 7)))) * 100.f); }
    } else if (gt < 1024 + 4096 + 96) {
        const int i = gt - 5120; const unsigned h = hash32(i * 977u + 3u);
        const int row = i < 64 ? (int)(h % MP) : (i < 88 ? MP + (int)(h % MS) : MREAL + (int)(h % 128u));
        if (row >= MREAL) { float m = 0.f; for (int c = 0; c < D; ++c) m = fmaxf(m, fabsf(dbg_h(F, row, c))); dbg_report(F, 3, m); }
        else { const float* x = x_row(F, row); float s = 0.f; for (int c = 0; c < D; ++c) s += x[c] * x[c];
            const float r = 1.f / sqrtf(s / D + NORM_EPS); const float* mod = F.MOD + row_batch(row) * NMOD; float e = 0.f;
            for (int c = 0; c < D; ++c) { const float y = x[c] * r * F.in[I_G1][c] * (1.f + mod[D + c]) + mod[c]; e = fmaxf(e, relerr(dbg_h(F, row, c), y, 0.2f)); }
            dbg_report(F, 3, e); }
    }
}
__device__ __forceinline__ float dbg_dot_h_win(Frame& F, int row, int c) { float s = 0.f; const float* w = F.in[I_WIN] + c; for (int k = 0; k < D; ++k) s += dbg_h(F, row, k) * w[(size_t)k * N_IN]; return s; }
__device__ __forceinline__ void dbg_check_p2(Frame& F) {
    const int gt = F.bid * NTHR + F.tid;
    if (gt >= 2048) return;
    const unsigned h = hash32(gt * 2246822519u + 99u), h2 = hash32(h ^ 0x9e3779b9u);
    int row = (gt & 7) == 7 ? MP + (int)(h % MS) : (int)(h % MP);
    int c;
    const int cls = gt % 5;
    if (cls == 0) c = (int)(h2 % N_IN); else if (cls == 1) c = O_QB + (int)(h2 % 4096u); else if (cls == 2) c = O_KB + (int)(h2 % 512u); else if (cls == 3) c = O_VB + (int)(h2 % 512u); else c = O_RA + (int)(h2 % 16u);
    if (gt >= 1024) {
        if (cls != 2 && cls != 3) return;
        if (gt & 8) { const int b = (h >> 3) & 1, tt = 8064 + (int)((h >> 8) % 128u); row = b * 8192 + tt; } else row = MP + (int)(h % MS);
    }
    const bool isq = c >= O_QB && c < O_KB, isk = c >= O_KB && c < O_VB, isv = c >= O_VB && c < O_VB + 512;
    float ref;
    if (isq || isk) { const int base = isq ? O_QB : O_KB, r = c - base, hh = r >> 6, d = r & 63, dl = d & 31;
        const float x1 = dbg_dot_h_win(F, row, base + 64 * hh + dl), x2 = dbg_dot_h_win(F, row, base + 64 * hh + dl + 32);
        const double inv = pow(10000.0, -(double)dl / 32.0), a = (double)row_pos(row) * inv; const float cs = (float)cos(a), sn = (float)sin(a);
        ref = d < 32 ? x1 * cs - x2 * sn : x2 * cs + x1 * sn; }
    else ref = dbg_dot_h_win(F, row, c);
    if (gt < 1024) {
        int pc = win_fwd(c);
        if ((c >= 8192 && c < 12288) || (c >= 17424 && c < 21520)) { const int i = c >= 17424 ? c - 17424 : c - 8192; const float gv = dbg_dot_h_win(F, row, 8192 + i), zv = dbg_dot_h_win(F, row, 17424 + i);
            ref = silu_ref(gv) / (1.f + expf(-zv)); pc = C_GA + i; }
        else if (c >= 21520) ref = 1.f / (1.f + expf(-ref));
        const float got = bf2f(F.PROJ[pj(row, pc)]); dbg_report(F, 4, relerr(got, isq ? ref * QSCALE : ref, 1.0f)); }
    else { const int r = c - (isk ? O_KB : O_VB), g = r >> 6, d = r & 63; long o;
        if (row < MP) o = (isk ? OUT_KP : OUT_VP) + ((long)(((row >> 13) * 128 + ((row & 8191) - 8064)) * 8 + g)) * 64 + d;
        else { const int r2 = row - MP; o = (isk ? OUT_KS : OUT_VS) + ((long)(((r2 >> 4) * 16 + (r2 & 15)) * 8 + g)) * 64 + d; }
        dbg_report(F, 5, relerr(F.out[o], ref, 1.0f)); }
}
__device__ __forceinline__ float logsig_ref(float x) { return x < 0.f ? x - log1pf(expf(x)) : -log1pf(expf(-x)); }
__device__ __forceinline__ float dbg_bcum(Frame& F, int row0, int ntok, int hd, int d, int upto) {
    float bc = 0.f; const float bias = F.in[I_BGK][hd * 512 + d];
    for (int t = 0; t <= upto && t < ntok; ++t) { float gk = bias; const bf16* ra = F.PROJ + pj(row0 + t, C_RA);
        for (int r = 0; r < 16; ++r) gk += bf2f(ra[r]) * F.in[I_WGK][r * 2048 + hd * 512 + d];
        bc += logsig_ref(gk) * (1.f / 16.f); }
    return bc;
}
__device__ __forceinline__ float dbg_qfrag(Frame& F, int cid, int hd, int i, int d) { const int w = d >> 6, dl = d & 63, dt = dl >> 5, r32 = dl & 31, s = r32 >> 4, r16 = r32 & 15, h = (r16 >> 2) & 1, jj = (r16 & 3) + 4 * (r16 >> 3);
    const int mt = i >> 5, ln = (i & 31) + 32 * h, fb = ((w * 2 + mt) * 2 + dt) * 2 + s; return bf2f(((const bf16*)(F.ws + WS_FRAG + (size_t)(cid * 4 + hd) * 131072))[fb * 512 + ln * 8 + jj]); }
__device__ __forceinline__ float dbg_kfrag(Frame& F, int cid, int hd, int j, int d) { const int w = d >> 6, dt = (d >> 5) & 1, dl = d & 31, sp = j >> 4, h = (j >> 3) & 1, jj = j & 7;
    const int ln = dl + 32 * h, fb = (w * 2 + dt) * 4 + sp; return bf2f(((const bf16*)(F.ws + WS_FRAG + (size_t)(cid * 4 + hd) * 131072 + 65536))[fb * 512 + ln * 8 + jj]); }
__device__ __forceinline__ float dbg_afrag(Frame& F, int cid, int hd, int i, int j) { const int it = i >> 5, jt = j >> 5, jl = j & 31, s = jl >> 4, r16 = jl & 15, h = (r16 >> 2) & 1, jj = (r16 & 3) + 4 * (r16 >> 3);
    const int blk = it + 2 * (2 * jt + s), ln = (i & 31) + 32 * h; return bf2f(((const bf16*)(F.ws + WS_AMAT + (size_t)(cid * 4 + hd) * 8192))[blk * 512 + ln * 8 + jj]); }
__device__ __forceinline__ void dbg_check_cl(Frame& F) {
    const int gt = F.bid * NTHR + F.tid;
    if (gt >= 2048) return;
    const unsigned hs = hash32(gt * 40503u + 17u), h2 = hash32(hs + 0x51ed27u);
    const int cid = (gt & 7) == 7 ? 256 + (int)(hs % 8u) : (int)(hs % 256u), hd = (int)((hs >> 8) & 3u);
    const int ntok = cid < 256 ? 64 : 16, row0 = cid < 256 ? cid * 64 : MP + 16 * (cid - 256), mid = ntok >> 1;
    const int i = (int)((hs >> 10) % (unsigned)ntok), j = (int)((h2) % (unsigned)ntok), d = (int)((h2 >> 8) % 512u);
    if (gt >= 256) {
        const float bi = dbg_bcum(F, row0, ntok, hd, d, i), bj = dbg_bcum(F, row0, ntok, hd, d, j), bm = dbg_bcum(F, row0, ntok, hd, d, mid), bl = dbg_bcum(F, row0, ntok, hd, d, 63);
        const float q = bf2f(F.PROJ[pj(row0 + i, C_QA + hd * 512 + d)]), k = bf2f(F.PROJ[pj(row0 + j, C_KA + hd * 512 + d)]);
        dbg_report(F, 6, relerr(dbg_qfrag(F, cid, hd, i, d), q * GLA_QSCALE * expf(bi - bm), 0.02f));
        dbg_report(F, 6, relerr(dbg_kfrag(F, cid, hd, j, d), k * expf(bm - bj), 0.3f));
        const float* VEC = (const float*)(F.ws + WS_VEC) + (size_t)(cid * 4 + hd) * 1024;
        dbg_report(F, 6, relerr(VEC[d], expf(bm), 0.01f)); dbg_report(F, 6, relerr(VEC[512 + d], expf(bl - bm), 0.01f));
        if (cid >= 256) { dbg_report(F, 6, fabsf(dbg_qfrag(F, cid, hd, 16 + (i % 48), d))); dbg_report(F, 6, fabsf(dbg_kfrag(F, cid, hd, 16 + (j % 48), d))); }
    } else {
        float s = 0.f;
        for (int dd = 0; dd < 512; ++dd) { float bi = 0.f, bj = 0.f, bm = 0.f, bc = 0.f; const float bias = F.in[I_BGK][hd * 512 + dd];
            for (int t = 0; t < ntok; ++t) { float gk = bias; const bf16* ra = F.PROJ + pj(row0 + t, C_RA);
                for (int r = 0; r < 16; ++r) gk += bf2f(ra[r]) * F.in[I_WGK][r * 2048 + hd * 512 + dd];
                bc += logsig_ref(gk) * (1.f / 16.f); if (t == i) bi = bc; if (t == j) bj = bc; if (t == mid) bm = bc; }
            const float q = bf2f(F.PROJ[pj(row0 + i, C_QA + hd * 512 + dd)]), k = bf2f(F.PROJ[pj(row0 + j, C_KA + hd * 512 + dd)]);
            s += bfround(q * GLA_QSCALE * expf(bi - bm)) * bfround(k * expf(bm - bj)); }
        if (j > i) s = 0.f;
        dbg_report(F, 6, relerr(dbg_afrag(F, cid, hd, i, j), s, 0.1f));
    }
}
__device__ __forceinline__ void dbg_check_swa(Frame& F) {
    LAS float* part = (LAS float*)F.lds;
    LAS float* qh = part + 512;
    LAS float* lg = qh + 64;
    LAS float* sm = lg + 192;
    const int tid = F.tid; const unsigned hs = hash32(F.bid * 7349u + 1234567u);
    const bool smp = (F.bid & 3) == 3;
    int row, b, tt;
    if (!smp) { b = hs & 1; tt = (F.bid & 7) == 0 ? (int)((hs >> 4) % 128u) : (int)((hs >> 4) % 8192u); row = b * SEQ + tt; } else { b = (hs >> 1) & 7; tt = (hs >> 4) & 15; row = MP + 16 * b + tt; }
    const int head = (int)((hs >> 20) & 63u), g = head >> 3;
    { const int d = tid >> 3, pt = tid & 7; float s = 0.f; const float* w = F.in[I_WIN] + O_QB + head * 64 + d;
      for (int k = 512 * pt; k < 512 * pt + 512; ++k) s += dbg_h(F, row, k) * w[(size_t)k * N_IN];
      part[d * 8 + pt] = s; }
    __syncthreads();
    float xq = 0.f; if (tid < 64) { for (int p = 0; p < 8; ++p) xq += part[tid * 8 + p]; }
    __syncthreads();
    if (tid < 64) part[tid] = xq;
    __syncthreads();
    if (tid < 64) { const int dl = tid & 31; const double inv = pow(10000.0, -(double)dl / 32.0), a = (double)row_pos(row) * inv; const float cs = (float)cos(a), sn = (float)sin(a);
        const float x1 = part[dl], x2 = part[dl + 32]; qh[tid] = (tid < 32 ? x1 * cs - x2 * sn : x2 * cs + x1 * sn) * QSCALE; }
    __syncthreads();
    int nk, kr0 = 0;
    if (!smp) { const int n = tt >> 6; nk = 64 * (n + 1 < 3 ? n + 1 : 3); kr0 = b * SEQ + 64 * (n > 2 ? n - 2 : 0); } else nk = 144;
    if (tid < nk) { float s = 0.f;
        for (int d = 0; d < 64; ++d) { float kv;
            if (smp && tid < 128) kv = bfround(F.in[I_CK][((size_t)(b * 128 + tid) * 8 + g) * 64 + d]);
            else { const int krow = smp ? MP + 16 * b + (tid - 128) : kr0 + tid; const int p = 8 * ((d & 31) >> 2) + (d & 3) + 4 * (d >> 5); kv = bf2f(F.PROJ[pj(krow, C_KB + g * 64 + p)]); }
            s += qh[d] * kv; }
        lg[tid] = s; }
    __syncthreads();
    if (tid == 0) { const float sk = F.in[I_SINK][head] * LOG2E; float m = sk; for (int k = 0; k < nk; ++k) m = fmaxf(m, lg[k]); float su = exp2f(sk - m); for (int k = 0; k < nk; ++k) su += exp2f(lg[k] - m); sm[0] = m; sm[1] = su; }
    __syncthreads();
    if (tid < 64) { float o = 0.f; const float m = sm[0];
        for (int k = 0; k < nk; ++k) { float vv;
            if (smp && k < 128) vv = bfround(F.in[I_CV][((size_t)(b * 128 + k) * 8 + g) * 64 + tid]);
            else { const int krow = smp ? MP + 16 * b + (k - 128) : kr0 + k; vv = bf2f(F.PROJ[pj(krow, C_VB + g * 64 + tid)]); }
            o += exp2f(lg[k] - m) * vv; }
        o /= sm[1];
        dbg_report(F, 7, relerr(bf2f(F.PROJ[pj(row, C_QB + head * 64 + tid)]), o, 0.3f)); }
    __syncthreads();
}
constexpr size_t WS_DBGV = 1596 * MiB;
__device__ __forceinline__ void dbg_check_scan(Frame& F) {
    LAS float* red = (LAS float*)F.lds;
    const int tid = F.tid; const unsigned hs = hash32(F.bid * 92821u + 777u);
    const bool smp = (F.bid & 1) == 1;
    const int b = smp ? (int)((hs >> 2) & 7u) : (int)((hs >> 2) & 1u), hd = (int)((hs >> 6) & 3u), e = (int)((hs >> 8) & 1023u);
    const int T = smp ? 16 : SEQ, row00 = smp ? MP + 16 * b : b * SEQ;
    float* vcol = (float*)(F.ws + WS_DBGV) + (size_t)F.bid * SEQ;
    for (int t = tid; t < T; t += NTHR) { float s = 0.f; const float* w = F.in[I_WIN] + C_VA + hd * 1024 + e;
        for (int k = 0; k < D; ++k) s += dbg_h(F, row00 + t, k) * w[(size_t)k * N_IN];
        vcol[t] = s; }
    __syncthreads();
    const int d = tid; float wg[16];
#pragma unroll
    for (int r = 0; r < 16; ++r) wg[r] = F.in[I_WGK][r * 2048 + hd * 512 + d];
    const float bias = F.in[I_BGK][hd * 512 + d];
    float S = smp ? F.in[I_SG][((size_t)(b * 4 + hd) * 512 + d) * 1024 + e] : 0.f;
    for (int t = 0; t < T; ++t) {
        const int row = row00 + t;
        const u32x4 ra0 = *(const u32x4*)(F.PROJ + pj(row, C_RA)), ra1 = *(const u32x4*)(F.PROJ + pj(row, C_RA) + 8);
        float gk = bias + bflo(ra0.x) * wg[0] + bfhi(ra0.x) * wg[1] + bflo(ra0.y) * wg[2] + bfhi(ra0.y) * wg[3] + bflo(ra0.z) * wg[4] + bfhi(ra0.z) * wg[5] + bflo(ra0.w) * wg[6] + bfhi(ra0.w) * wg[7]
                 + bflo(ra1.x) * wg[8] + bfhi(ra1.x) * wg[9] + bflo(ra1.y) * wg[10] + bfhi(ra1.y) * wg[11] + bflo(ra1.z) * wg[12] + bfhi(ra1.z) * wg[13] + bflo(ra1.w) * wg[14] + bfhi(ra1.w) * wg[15];
        const float a = expf(logsig_ref(gk) * (1.f / 16.f));
        S = a * S + bf2f(F.PROJ[pj(row, C_KA + hd * 512 + d)]) * vcol[t];
        const bool chk = smp || t < 2 || t == 31 || t == 63 || t == 64 || t == 65 || t == 127 || t == 128 || t == 1000 || t == 4095 || t == 8191;
        if (chk) { red[tid] = bf2f(F.PROJ[pj(row, C_QA + hd * 512 + d)]) * GLA_QSCALE * S; __syncthreads();
            if (tid == 0) { float o = 0.f; for (int x = 0; x < 512; ++x) o += red[x]; const float got = bf2f(F.PROJ[pj(row, C_VA + hd * 1024 + e)]); dbg_report(F, 8, relerr(got, o, 5.0f)); atomicAdd(F.DBG + 32, (got - o) * (got - o)); atomicAdd(F.DBG + 33, o * o); }
            __syncthreads(); }
    }
    { const float got = F.out[(smp ? OUT_SGS : OUT_SGP) + ((size_t)(b * 4 + hd) * 512 + d) * 1024 + e]; dbg_report(F, 8, relerr(got, S, 5.0f));
      const float se = wave_sum((got - S) * (got - S)), sr = wave_sum(S * S); if (F.lane == 0) { atomicAdd(F.DBG + 34, se); atomicAdd(F.DBG + 35, sr); } }
}

constexpr int DBG_NCHECK = 11;
__device__ __forceinline__ void dbg_final(Frame& F) {
    if (F.bid != 0 || F.tid != 0) return;
    const float tol[DBG_NCHECK] = {2e-3f, 1e-3f, 1e-3f, 1e-2f, 3e-2f, 3e-2f, 2e-2f, 3e-2f, 3e-2f, 1e-2f, 1e-2f};
    for (int k = 0; k < DBG_NCHECK; ++k) { float e = __uint_as_float(__hip_atomic_load((unsigned*)F.DBG + k, RLX_AGENT));
        if (k == 9) e = sqrtf(F.DBG[32] / F.DBG[33]); if (k == 10) e = sqrtf(F.DBG[34] / F.DBG[35]);
        if (!(e <= tol[k])) { const int m = e >= 1.f ? 9 : e >= 0.3f ? 8 : e >= 0.1f ? 7 : e >= 0.03f ? 6 : e >= 0.01f ? 5 : e >= 0.003f ? 4 : e >= 0.001f ? 3 : e >= 3e-4f ? 2 : 1;
            float x = (1.f + 0.1f * m) * 1e4f; for (int j = 0; j < k; ++j) x *= 10.f; F.out[0] = x; return; } }
}
#endif

#define PHASE_BEGIN() do { int t_ = threadIdx.x; asm volatile("" : "+v"(t_)); F.tid = t_; F.lane = t_ & 63; F.wave = __builtin_amdgcn_readfirstlane(t_ >> 6); } while (0)
__global__ void __launch_bounds__(NTHR, 2) mega_fwd(Args args) {
    extern __shared__ __attribute__((aligned(16))) unsigned char lds[];
    Frame F;
    F.lds = (LAS unsigned char*)lds;
    F.MISC = (volatile LAS unsigned*)(F.lds + MISC_OFF);
    F.tid = threadIdx.x; F.lane = F.tid & 63; F.wave = __builtin_amdgcn_readfirstlane(F.tid >> 6);
    F.G = gridDim.x; F.bid = blockIdx.x;
    unsigned char* ws = args.ws; F.ws = ws; F.out = args.out;
#pragma unroll
    for (int i = 0; i < 20; ++i) F.in[i] = args.in[i];
    F.ctl = (gu32*)(ws + WS_CTL);
    F.MOD = (float*)(ws + WS_MOD); F.ROPEC = (float*)(ws + WS_ROPE); F.ROPES = (float*)(ws + WS_ROPE + MiB); F.SC = (float*)(ws + WS_SC); F.DBG = (float*)(ws + WS_DBG);
    F.WIN = (bf16*)(ws + WS_WIN); F.WOUT = (bf16*)(ws + WS_WOUT); F.WGU = (bf16*)(ws + WS_WGU); F.WDN = (bf16*)(ws + WS_WDN); F.H = (bf16*)(ws + WS_H); F.PROJ = (bf16*)(ws + WS_PROJ);
    for (int u = F.tid; u < 64; u += NTHR) ((LAS unsigned*)(F.lds + MISC_OFF))[u] = 0u;
    __syncthreads();
    XcdBarrier bar = xcd_barrier_post((unsigned*)(F.ctl + CW_BAR), F.MISC + 8);
    const int gtid = F.bid * NTHR + F.tid;

#if DBG_CHECK
    if (gtid < 64) F.DBG[gtid] = 0.f;
    xcd_barrier(bar);
#endif
    PHASE_BEGIN();
    p0_phase(F, CW_Q0);
#if PROBE_TWICE == 100
    xcd_barrier(bar); p0_phase(F, CW_Q0 + 64);
#endif
    xcd_barrier(bar);
    PHASE_BEGIN();
    norm_mod_rows<false>(F, F.in[I_XP], F.in[I_XS], nullptr, F.in[I_G1], 0, D, F.H);
#if PROBE_TWICE == 101
    xcd_barrier(bar); norm_mod_rows<false>(F, F.in[I_XP], F.in[I_XS], nullptr, F.in[I_G1], 0, D, F.H);
#endif
    xcd_barrier(bar);
#if DBG_CHECK
    dbg_check_p0p1(F);
#endif
    PHASE_BEGIN();
    { pg8::Gemm g{F.H, F.WIN, MPAD, NP_IN, D}; pg8::StaticOrder S; S.init(MPAD, NP_IN, F.G, F.bid);
      EpiIn E{F.PROJ, F.ROPEC, F.ROPES, F.out};
#if PROBE_TWICE == 110
      S.force0 = 1; pg8::gemm_phase<EpiIn, true, true>(F.lds, g, S, E); S.force0 = 0; xcd_barrier(bar);
#endif
      pg8::gemm_phase<EpiIn, true, true>(F.lds, g, S, E);
      drain_weights<0>(F);
#if PROBE_TWICE == 102
      xcd_barrier(bar); pg8::gemm_phase<EpiIn, true, true>(F.lds, g, S, E);
#endif
    }
    xcd_barrier(bar);
#if DBG_CHECK
    dbg_check_p2(F);
    xcd_barrier(bar);
#endif
    PHASE_BEGIN();
    p3_phase(F);
    xcd_barrier(bar);
#if DBG_CHECK
    dbg_check_cl(F);
    dbg_check_swa(F);
    xcd_barrier(bar);
#endif
    PHASE_BEGIN();
    p4_phase(F);
    xcd_barrier(bar);
#if DBG_CHECK
    dbg_check_scan(F);
    xcd_barrier(bar);
#endif
    PHASE_BEGIN();
    p5_merge(F);
#if PROBE_TWICE == 105
    xcd_barrier(bar); p5_merge(F);
#endif
    xcd_barrier(bar);
    PHASE_BEGIN();
    bf16* const X1B = (bf16*)(F.ws + WS_FRAG);
    { pg8::Gemm g{F.H, F.WOUT, MP, D, D}; pg8::StaticOrder S; S.init(MP, D, F.G, F.bid);
      EpiRes<0> E{F.in[I_XP], nullptr, nullptr, X1B, F.MOD, 2 * D};
      pg8::gemm_phase<EpiRes<0>, true, true>(F.lds, g, S, E); }
    skinny_res<D, 0, true, true>(F, F.H, F.WOUT, F.in[I_XS], nullptr, nullptr, X1B, 2 * D);
    xcd_barrier(bar);
    PHASE_BEGIN();
    norm_mod_rows<true>(F, nullptr, nullptr, X1B, F.in[I_G2], 3 * D, 4 * D, F.H);
#if PROBE_TWICE == 101
    xcd_barrier(bar); norm_mod_rows<true>(F, nullptr, nullptr, X1B, F.in[I_G2], 3 * D, 4 * D, F.H);
#endif
    xcd_barrier(bar);
    PHASE_BEGIN();
    { pg8::Gemm g{F.H, F.WGU, MPAD, N_GU, D}; pg8::StaticOrder S; S.init(MPAD, N_GU, F.G, F.bid);
      EpiGU E{F.PROJ};
      pg8::gemm_phase<EpiGU, true, true>(F.lds, g, S, E);
      drain_weights<1>(F); }
    xcd_barrier(bar);
    PHASE_BEGIN();
    { pg8::Gemm g{F.PROJ, F.WDN, MP, D, DFF}; pg8::StaticOrder S; S.init(MP, D, F.G, F.bid); S.fatk = 1;
      EpiRes<1> E{nullptr, X1B, nullptr, X1B, F.MOD, 5 * D};
      pg8::gemm_phase<EpiRes<1>, true, true>(F.lds, g, S, E); }
    skinny_res<DFF, 1, true, true>(F, F.PROJ, F.WDN, nullptr, X1B, nullptr, X1B, 5 * D);
    xcd_barrier(bar);
    PHASE_BEGIN();
    p10_final(F, X1B);
#if DBG_CHECK
    xcd_barrier(bar);
    dbg_final(F);
#endif
}

extern "C" void kernel_launch(void* const* d_in, const int* in_sizes, int n_in, void* d_out, int out_size, void* d_ws, size_t ws_size, hipStream_t stream) {
    static int grid = 0;
    if (grid == 0) {
        int dev = 0, cus = 0, per_cu = 0;
        if (n_in != 20 || out_size != (int)OUT_TOTAL || ws_size < WS_END + 32 * MiB) { fprintf(stderr, "kernel_launch: unexpected sizes n_in %d out %d ws %zu (need %zu); nothing launched\n", n_in, out_size, ws_size, (size_t)WS_END); grid = -1; return; }
        if (hipGetDevice(&dev) != hipSuccess || hipDeviceGetAttribute(&cus, hipDeviceAttributeMultiprocessorCount, dev) != hipSuccess) { fprintf(stderr, "kernel_launch: device query failed\n"); grid = -1; return; }
        if (hipFuncSetAttribute((const void*)mega_fwd, hipFuncAttributeMaxDynamicSharedMemorySize, LDS_BYTES) != hipSuccess) { fprintf(stderr, "kernel_launch: hipFuncSetAttribute failed\n"); grid = -1; return; }
        if (hipOccupancyMaxActiveBlocksPerMultiprocessor(&per_cu, (const void*)mega_fwd, NTHR, LDS_BYTES) != hipSuccess || per_cu < 1)
            fprintf(stderr, "kernel_launch: occupancy query reports %d blocks per CU\n", per_cu);
        (void)hipGetLastError();
        grid = cus;
    }
    if (grid < 0) return;
    if (hipMemsetAsync((char*)d_ws + WS_CTL, 0, CTL_ZERO_BYTES, stream) != hipSuccess) { fprintf(stderr, "kernel_launch: memset failed\n"); return; }
    Args a{};
    for (int i = 0; i < 20; ++i) a.in[i] = (const float*)d_in[i];
    a.out = (float*)d_out; a.ws = (unsigned char*)d_ws;
    hipLaunchKernelGGL(mega_fwd, dim3(grid), dim3(NTHR), LDS_BYTES, stream, a);
}
```

```cpp
#include <hip/hip_runtime.h>
#include <cstdio>

#ifndef DBG_CHECK
#define DBG_CHECK 0
#endif
#ifndef PROBE_TWICE
#define PROBE_TWICE 0
#endif
#ifndef ZERO_FILL
#define ZERO_FILL 0
#endif

#define LAS __attribute__((address_space(3)))
#define GAS __attribute__((address_space(1)))
typedef GAS unsigned gu32;
typedef unsigned short bf16;
typedef short bf16x8 __attribute__((ext_vector_type(8)));
typedef float f32x2 __attribute__((ext_vector_type(2)));
typedef float f32x4 __attribute__((ext_vector_type(4)));
typedef float f32x16 __attribute__((ext_vector_type(16)));
typedef unsigned u32x2 __attribute__((ext_vector_type(2)));
typedef unsigned u32x4 __attribute__((ext_vector_type(4)));
typedef __bf16 bf16x2_t __attribute__((ext_vector_type(2)));
#define RLX_AGENT __ATOMIC_RELAXED, __HIP_MEMORY_SCOPE_AGENT
#define LDS_WAIT() asm volatile("s_waitcnt lgkmcnt(0)" ::: "memory")
#define VM_WAIT() asm volatile("s_waitcnt vmcnt(0)" ::: "memory")

__device__ __forceinline__ unsigned cvtpk(float lo, float hi) { f32x2 v = {lo, hi}; bf16x2_t b = __builtin_convertvector(v, bf16x2_t); return __builtin_bit_cast(unsigned, b); }
__device__ __forceinline__ float bf2f(unsigned short b) { return __uint_as_float(((unsigned)b) << 16); }
__device__ __forceinline__ float bflo(unsigned w) { return __uint_as_float(w << 16); }
__device__ __forceinline__ float bfhi(unsigned w) { return __uint_as_float(w & 0xffff0000u); }
__device__ __forceinline__ float wave_sum(float v) {
#pragma unroll
    for (int o = 1; o < 64; o <<= 1) v += __shfl_xor(v, o);
    return v;
}

constexpr int NWAVES = 8, NTHR = 512;
constexpr int D = 4096, SEQ = 8192, MP = 16384, MS = 128, MREAL = 16512, MPAD = 16640;
constexpr int N_IN = 25616, NP_IN = 25856, DFF = 11008, N_GU = 22016, NMOD = 24576;
constexpr int C_QA = 0, C_KA = 2048, C_VA = 4096, C_GA = 8192, C_QB = 12288, C_KB = 16384, C_VB = 16896, C_ZA = 17408, C_ZB = 21504, C_RA = 25600;
constexpr int O_RA = 12288, O_QB = 12304, O_KB = 16400, O_VB = 16912;
constexpr float NORM_EPS = 1e-6f;
__host__ __device__ __forceinline__ size_t pj(int row, int col) { return ((size_t)((row >> 8) * 101 + (col >> 8)) << 16) + (size_t)(((row & 255) << 8) + (col & 255)); }
constexpr float QSCALE = 0.125f * 1.4426950408889634f;
constexpr long OUT_YP = 0, OUT_YS = 67108864L, OUT_SGP = 67633152L, OUT_KP = 71827456L, OUT_VP = 71958528L, OUT_SGS = 72089600L, OUT_KS = 88866816L, OUT_VS = 88932352L, OUT_TOTAL = 88997888L;

constexpr size_t MiB = 1u << 20;
constexpr size_t WS_CTL = 0, CTL_ZERO_BYTES = 2 * MiB;
constexpr size_t WS_MOD = 1 * MiB, WS_ROPE = 2 * MiB, WS_VEC = 4 * MiB, WS_AMAT = 9 * MiB, WS_SC = 18 * MiB, WS_DBG = 19 * MiB;
constexpr size_t WS_WIN = 20 * MiB, WS_WOUT = 222 * MiB, WS_WGU = 254 * MiB, WS_WDN = 426 * MiB, WS_H = 512 * MiB, WS_PROJ = 642 * MiB, WS_FRAG = 1463 * MiB, WS_END = 1595 * MiB;
static_assert(WS_WIN + (size_t)NP_IN * D * 2 <= WS_WOUT && WS_WGU + (size_t)N_GU * D * 2 <= WS_WDN && WS_WDN + (size_t)D * DFF * 2 <= WS_H, "ws map");
static_assert(WS_H + (size_t)MPAD * D * 2 <= WS_PROJ && WS_PROJ + (size_t)MPAD * NP_IN * 2 <= WS_FRAG && WS_FRAG + (size_t)264 * 4 * 131072 <= WS_END, "ws map");
constexpr int CW_Q0 = 64, CW_BAR = 4096;

constexpr int LDS_BYTES = 160 * 1024;
constexpr int MISC_OFF = LDS_BYTES - 256;

#define XB_TMO      128
#define XB_XCNT(j)  (256  + 64 * (j))
#define XB_XSUB(j)  (1280 + 64 * (j))
#define XB_XGEN(j)  (2304 + 64 * (j))
#define XB_TOP      3328
#define XB_TOPGEN   3392
#define XCD_BAR_WORDS 3456
#define XB_SPIN_CAP (1u << 24)
__device__ __forceinline__ unsigned xb_ld(unsigned* p)              { return __hip_atomic_load(p, __ATOMIC_RELAXED, __HIP_MEMORY_SCOPE_AGENT); }
__device__ __forceinline__ unsigned xb_add(unsigned* p, unsigned v) { return __hip_atomic_fetch_add(p, v, __ATOMIC_RELAXED, __HIP_MEMORY_SCOPE_AGENT); }
__device__ __forceinline__ unsigned xb_xcc_id() { return (unsigned)__builtin_amdgcn_s_getreg((3 << 11) | 20) & 0xFu; }
#define XB_SPIN(cond, bar) do { unsigned _sp = 0; while (cond) { __builtin_amdgcn_s_sleep(1); \
    if ((++_sp & 255u) == 0u) { if (xb_ld(&(bar)[XB_TMO])) break; if (_sp > XB_SPIN_CAP) { atomicAdd(&(bar)[XB_TMO], 1u); break; } } } } while (0)
struct XcdBarrier { unsigned* bar; unsigned x; volatile LAS unsigned* st; };
__device__ __forceinline__ XcdBarrier xcd_barrier_post(unsigned* bar, volatile LAS unsigned* st) {
    XcdBarrier b; b.bar = bar; b.x = xb_xcc_id(); b.st = st;
    if (threadIdx.x == 0) (void)xb_add(&bar[XB_XCNT(b.x)], 1u);
    return b;
}
__device__ __forceinline__ void xcd_barrier_complete(unsigned* bar, unsigned x, unsigned& nloc, unsigned& nx) {
    const unsigned G = gridDim.x * gridDim.y * gridDim.z;
    unsigned sum, cnt, mine, sp = 0u;
    for (;;) {
        sum = 0u; cnt = 0u; mine = 0u;
#pragma unroll
        for (unsigned j = 0; j < 16; ++j) { const unsigned c = xb_ld(&bar[XB_XCNT(j)]); sum += c; cnt += (c > 0u) ? 1u : 0u; mine = (j == x) ? c : mine; }
        if (sum == G) break;
        __builtin_amdgcn_s_sleep(1);
        if ((++sp & 255u) == 0u) { if (xb_ld(&bar[XB_TMO])) break; if (sp > XB_SPIN_CAP) { atomicAdd(&bar[XB_TMO], 1u); break; } }
    }
    nloc = mine > 0u ? mine : 1u; nx = cnt > 0u ? cnt : 1u;
}
__device__ __forceinline__ void xcd_barrier(const XcdBarrier& b) {
    asm volatile("s_waitcnt vmcnt(0)" ::: "memory");
    __syncthreads();
    if (threadIdx.x == 0) {
        unsigned* bar = b.bar;
        __builtin_amdgcn_s_waitcnt(0);
        unsigned nloc = b.st[0], nx = b.st[1];
        if (nloc == 0u) { xcd_barrier_complete(bar, b.x, nloc, nx); b.st[0] = nloc; b.st[1] = nx; }
        const unsigned old = xb_add(&bar[XB_XSUB(b.x)], 1u);
        const unsigned gen = old / nloc;
        if (old + 1u == (gen + 1u) * nloc) {
            __builtin_amdgcn_fence(__ATOMIC_RELEASE, "agent");
            asm volatile("s_waitcnt vmcnt(0)" ::: "memory");
            const unsigned og = xb_add(&bar[XB_TOP], 1u);
            const unsigned tg = og / nx;
            if (og + 1u == (tg + 1u) * nx) xb_add(&bar[XB_TOPGEN], 1u);
            else XB_SPIN(xb_ld(&bar[XB_TOPGEN]) == tg, bar);
            __builtin_amdgcn_fence(__ATOMIC_ACQUIRE, "agent");
            xb_add(&bar[XB_XGEN(b.x)], 1u);
            asm volatile("s_waitcnt vmcnt(0)" ::: "memory");
        } else {
            XB_SPIN(xb_ld(&bar[XB_XGEN(b.x)]) == gen, bar);
            __builtin_amdgcn_fence(__ATOMIC_ACQUIRE, "agent");
            asm volatile("s_waitcnt vmcnt(0)" ::: "memory");
        }
    }
    __syncthreads();
}

namespace pg8 {
constexpr int BM = 256, BK = 64, HALF = 128, HTB = HALF * BK * 2, STAGE_BYTES = 8 * HTB, NXCD = 8, WGM = 8;
__host__ __device__ __forceinline__ int lds_byte(int r, int c) { const int st = (r >> 4) * 2 + (c >> 5), rr = r & 15, cc = c & 31, ob = rr * 64 + cc * 2; return st * 1024 + (ob ^ (((ob >> 9) & 1) << 5)); }
__host__ __device__ __forceinline__ void stage_rc(int b, int& R, int& C) { const int st = b / 1024, sb = b % 1024, swz = sb ^ (((sb >> 9) & 1) << 5); R = (st >> 1) * 16 + swz / 64; C = (st & 1) * 32 + (swz % 64) / 2; }
__host__ __device__ __forceinline__ int perm32(int rho) { const int n = rho >> 4, i = rho & 15; return 8 * (i >> 2) + 4 * n + (i & 3); }
struct Unit { int pm, pn, k0, ntu, sp; };
struct Gemm { const bf16* A; const bf16* Bt; int M, N, K; };
struct StaticOrder {
    int nM, nN, nwg, G, c; int force0 = 0; int fatk = 0;
    __host__ __device__ void init(int M, int N, int G_, int c_) { nM = M / BM; nN = N / BM; nwg = nM * nN; G = G_; c = c_; }
    __host__ __device__ bool next(int i, Unit& u) const {
        const long L = (long)i * G + c; if (L >= nwg) return false;
        if (fatk && G == 256 && nM == 64 && nN == 16) { const int x = c & 7, l = c >> 3; u.pm = 8 * (2 * i + (x >> 2)) + (l & 7); u.pn = 4 * (x & 3) + (l >> 3); return true; }
        int wgid = (int)L; { const int q = nwg / NXCD, r = nwg % NXCD, xcd = wgid % NXCD, off = wgid / NXCD; wgid = (xcd < r ? xcd * (q + 1) : r * (q + 1) + (xcd - r) * q) + off; }
        const int nig = WGM * nN, gid = wgid / nig, fm = gid * WGM, gsz = (nM - fm) < WGM ? (nM - fm) : WGM;
        u.pm = fm + ((wgid % nig) % gsz); u.pn = (wgid % nig) / gsz; if (force0) { u.pm = 0; u.pn = 0; } return true;
    }
};
struct SplitOrder {
    int G, c, pm, pairs;
    __device__ bool next(int i, Unit& u) const {
        const int L = i * G + c; if (L >= 256) return false;
        const int s = 2 * (L & 7) + (L >> 7), base = pairs >> 4, rem = pairs & 15;
        u.pm = pm; u.pn = (L >> 3) & 15; u.sp = s; u.ntu = 2 * (base + (s < rem ? 1 : 0)); u.k0 = 2 * (s * base + (s < rem ? s : rem)); return true;
    }
};
template <class Epi, bool AIMG = false, bool BIMG = false, class Order = StaticOrder, bool SPLIT = false>
__device__ __forceinline__ void gemm_phase(LAS unsigned char* lds, const Gemm g, const Order& S, const Epi& E) {
    int tid_ = threadIdx.x; asm volatile("" : "+v"(tid_));
    const int tid = tid_, wid = __builtin_amdgcn_readfirstlane(tid >> 6), lane = tid & 63, wr = wid >> 2, wc = wid & 3, fr = lane & 15, fq = lane >> 4;
    const int K = g.K, nt = K / BK;
    unsigned voffA[2], voffB[2];
#pragma unroll
    for (int i = 0; i < 2; ++i) { int R, C; stage_rc(tid * 16 + i * 8192, R, C); const int Rb = Epi::PERM ? ((R & ~31) + perm32(R & 31)) : R;
        voffA[i] = AIMG ? (unsigned)(tid * 16 + i * 8192) : (unsigned)(R * K + C) * 2u; voffB[i] = BIMG ? (unsigned)(tid * 16 + i * 8192) : (unsigned)(Rb * K + C) * 2u; }
    const size_t kstepA = AIMG ? (size_t)HTB : (size_t)(BK * 2), kstepB = BIMG ? (size_t)HTB : (size_t)(BK * 2);
    const size_t hstepA = AIMG ? (size_t)nt * HTB : (size_t)HALF * K * 2, hstepB = BIMG ? (size_t)nt * HTB : (size_t)HALF * K * 2;
    const size_t tstepA = 2 * hstepA, tstepB = 2 * hstepB;
    const unsigned ldsw = (unsigned)wid * 1024u;
    const int aoff = lds_byte(wr * 64 + fr, fq * 8), boff = lds_byte(wc * 32 + fr, fq * 8);
#define PG8_SA(b, h) (((b) * 2 + (h)) * HTB)
#define PG8_SB(b, h) ((4 + (b) * 2 + (h)) * HTB)
#define PG8_STAGE(bufoff, gbase, voff) do { _Pragma("unroll") for (int _i = 0; _i < 2; ++_i) \
        __builtin_amdgcn_global_load_lds((const unsigned*)((const char*)(gbase) + (voff)[_i]), (LAS unsigned*)(lds + (bufoff) + ldsw + _i * 8192), 16, 0, 0); } while (0)
#define PG8_LDA(dst, b, h) do { _Pragma("unroll") for (int m = 0; m < 4; ++m) _Pragma("unroll") for (int k = 0; k < 2; ++k) dst[m][k] = *(const LAS bf16x8*)(lds + PG8_SA(b, h) + aoff + m * 2048 + k * 1024); } while (0)
#define PG8_LDB(dst, b, h) do { _Pragma("unroll") for (int n = 0; n < 2; ++n) _Pragma("unroll") for (int k = 0; k < 2; ++k) dst[n][k] = *(const LAS bf16x8*)(lds + PG8_SB(b, h) + boff + n * 2048 + k * 1024); } while (0)
#define PG8_MMA(ai, bj, At, Bt) do { __builtin_amdgcn_s_setprio(1); _Pragma("unroll") for (int m = 0; m < 4; ++m) _Pragma("unroll") for (int n = 0; n < 2; ++n) _Pragma("unroll") for (int k = 0; k < 2; ++k) \
        acc[ai][bj][m][n] = __builtin_amdgcn_mfma_f32_16x16x32_bf16(Bt[n][k], At[m][k], acc[ai][bj][m][n], 0, 0, 0); __builtin_amdgcn_s_setprio(0); } while (0)
#define PG8_WAIT_V(n) asm volatile("s_waitcnt vmcnt(" #n ")" ::: "memory")
#define PG8_WAIT_L(n) asm volatile("s_waitcnt lgkmcnt(" #n ")" ::: "memory")
#define PG8_BAR __builtin_amdgcn_s_barrier()
#define PG8_SCHED __builtin_amdgcn_sched_barrier(0)
    Unit cur, nxt; int ui = 0;
    if (!S.next(0, cur)) return;
    f32x4 acc[2][2][4][2];
#pragma unroll
    for (int a = 0; a < 2; ++a)
#pragma unroll
        for (int b = 0; b < 2; ++b)
#pragma unroll
            for (int m = 0; m < 4; ++m)
#pragma unroll
                for (int n = 0; n < 2; ++n) acc[a][b][m][n] = (f32x4){0.f, 0.f, 0.f, 0.f};
    bf16x8 At[4][2], B0[2][2], B1[2][2];
    const char* cA = (const char*)g.A + (size_t)cur.pm * tstepA + (SPLIT ? (size_t)cur.k0 * kstepA : (size_t)0); const char* cB = (const char*)g.Bt + (size_t)cur.pn * tstepB + (SPLIT ? (size_t)cur.k0 * kstepB : (size_t)0);
    PG8_STAGE(PG8_SB(0, 0), cB, voffB); PG8_STAGE(PG8_SB(0, 1), cB + hstepB, voffB); PG8_STAGE(PG8_SA(0, 0), cA, voffA); PG8_STAGE(PG8_SA(0, 1), cA + hstepA, voffA);
    if (wr == 1) PG8_BAR;
    PG8_WAIT_V(2); PG8_BAR;
    PG8_STAGE(PG8_SB(1, 0), cB + kstepB, voffB); PG8_STAGE(PG8_SA(1, 0), cA + kstepA, voffA); PG8_STAGE(PG8_SB(1, 1), cB + hstepB + kstepB, voffB);
    PG8_WAIT_V(6); PG8_BAR;
    for (;;) {
        const bool has_next = S.next(ui + 1, nxt);
        const char* nA = has_next ? (const char*)g.A + (size_t)nxt.pm * tstepA + (SPLIT ? (size_t)nxt.k0 * kstepA : (size_t)0) : cA;
        const char* nB = has_next ? (const char*)g.Bt + (size_t)nxt.pn * tstepB + (SPLIT ? (size_t)nxt.k0 * kstepB : (size_t)0) : cB;
        const int ntu = SPLIT ? cur.ntu : nt;
        for (int t = 0; t < ntu; t += 2) {
            const bool last = (t == ntu - 2);
            const char* a1 = cA + (size_t)(t + 1) * kstepA;
            const char* a2 = last ? nA : cA + (size_t)(t + 2) * kstepA; const char* b2 = last ? nB : cB + (size_t)(t + 2) * kstepB;
            const char* a3 = a2 + kstepA; const char* b3 = b2 + kstepB;
            PG8_LDB(B0, 0, 0); PG8_LDB(B1, 0, 1); PG8_SCHED; PG8_LDA(At, 0, 0); PG8_STAGE(PG8_SA(1, 1), a1 + hstepA, voffA);
            PG8_WAIT_V(8); PG8_WAIT_L(0); PG8_BAR; PG8_MMA(0, 0, At, B0); PG8_MMA(0, 1, At, B1); PG8_BAR; PG8_SCHED;
            PG8_LDA(At, 0, 1); PG8_STAGE(PG8_SB(0, 0), b2, voffB); PG8_STAGE(PG8_SB(0, 1), b2 + hstepB, voffB); PG8_STAGE(PG8_SA(0, 0), a2, voffA);
            PG8_WAIT_V(8); PG8_WAIT_L(0); PG8_BAR; PG8_MMA(1, 0, At, B0); PG8_MMA(1, 1, At, B1); PG8_BAR; PG8_SCHED;
            PG8_LDB(B0, 1, 0); PG8_LDB(B1, 1, 1); PG8_SCHED; PG8_LDA(At, 1, 0); PG8_STAGE(PG8_SA(0, 1), a2 + hstepA, voffA);
            PG8_WAIT_V(8); PG8_WAIT_L(0); PG8_BAR; PG8_MMA(0, 0, At, B0); PG8_MMA(0, 1, At, B1); PG8_BAR; PG8_SCHED;
            PG8_LDA(At, 1, 1); PG8_STAGE(PG8_SB(1, 0), b3, voffB); PG8_STAGE(PG8_SB(1, 1), b3 + hstepB, voffB); PG8_STAGE(PG8_SA(1, 0), a3, voffA);
            PG8_WAIT_V(8); PG8_WAIT_L(0); PG8_BAR; PG8_MMA(1, 0, At, B0); PG8_MMA(1, 1, At, B1); PG8_BAR; PG8_SCHED;
        }
        if (wr == 0) PG8_BAR;
        E(acc, cur, wr, wc, fr, fq);
        if (!has_next) break;
#pragma unroll
        for (int a = 0; a < 2; ++a)
#pragma unroll
            for (int b = 0; b < 2; ++b)
#pragma unroll
                for (int m = 0; m < 4; ++m)
#pragma unroll
                    for (int n = 0; n < 2; ++n) acc[a][b][m][n] = (f32x4){0.f, 0.f, 0.f, 0.f};
        cur = nxt; cA = nA; cB = nB; ++ui;
        if (wr == 1) PG8_BAR;
    }
    PG8_WAIT_V(0);
    PG8_BAR;
#undef PG8_SA
#undef PG8_SB
#undef PG8_STAGE
#undef PG8_LDA
#undef PG8_LDB
#undef PG8_MMA
#undef PG8_WAIT_V
#undef PG8_WAIT_L
#undef PG8_BAR
#undef PG8_SCHED
}
__device__ __forceinline__ size_t img_off(int row, int k, int nt, bool permb) {
    int r = row & 127; if (permb) { const int m = r & 31; r = (r & ~31) + 16 * ((m >> 2) & 1) + 4 * (m >> 3) + (m & 3); }
    return ((size_t)(row >> 7) * nt + (k >> 6)) * (size_t)HTB + (size_t)lds_byte(r, k & 63);
}
}

struct Args { const float* in[20]; float* out; unsigned char* ws; };
enum { I_XP = 0, I_XS, I_SG, I_CK, I_CV, I_CP, I_CS, I_WADA, I_BADA, I_G1, I_WIN, I_WGK, I_BGK, I_GGLA, I_SINK, I_WOUT, I_G2, I_WGU, I_WDN, I_GF };

struct Frame {
    LAS unsigned char* lds;
    volatile LAS unsigned* MISC;
    gu32* ctl;
    int tid, lane, wave, G, bid;
    const float* in[20];
    float* out; unsigned char* ws;
    float* MOD; float* ROPEC; float* ROPES; float* SC; float* DBG;
    bf16 *WIN, *WOUT, *WGU, *WDN, *H, *PROJ;
};

__device__ __forceinline__ int row_batch(int row) { return row < MP ? (row >> 13) : 2 + ((row - MP) >> 4); }
__device__ __forceinline__ int row_pos(int row) { return row < MP ? (row & 8191) : 2048 + (row & 15); }
__device__ __forceinline__ const float* x_row(const Frame& F, int row) { return row < MP ? F.in[I_XP] + (size_t)row * D : F.in[I_XS] + (size_t)(row - MP) * D; }

__device__ __forceinline__ int win_src_col(int n) {
    if (n < 8192) return n;
    if (n < 12288 || (n >= 17408 && n < 21504)) {
        const int ct = n < 12288 ? (n - 8192) >> 8 : 16 + ((n - 17408) >> 8), j = n & 255; return j < 128 ? 8192 + 128 * ct + j : 17424 + 128 * ct + (j - 128); }
    if (n < 16896) { const bool isq = n < 16384; const int r = n - (isq ? 12288 : 16384), hh = r >> 6, p = r & 63, t = p >> 3, e = p & 7;
        const int d = (e < 4) ? (4 * t + e) : (32 + 4 * t + (e - 4)); return (isq ? O_QB : O_KB) + 64 * hh + d; }
    if (n < 25600) return n + 16;
    if (n < 25616) return O_RA + (n - 25600);
    return -1;
}
__device__ __forceinline__ int wgu_src_col(int n) { const int pn = n >> 8, j = n & 255; return j < 128 ? 128 * pn + j : DFF + 128 * pn + (j - 128); }

__device__ __forceinline__ void p0_transpose(const float* W, int K, int N, bf16* WT, int mode, LAS float* scr, int n0, int k0, int lane, int imgnt = 0, bool permb = false) {
    const int cg = lane & 15, kr = lane >> 4;
    const int n = n0 + 4 * cg; const int src = mode == 1 ? win_src_col(n) : (mode == 2 ? wgu_src_col(n) : n);
    const float* wp = W + (size_t)(k0 + kr) * N + (src < 0 ? 0 : src);
    f32x4 v[16];
#pragma unroll
    for (int j = 0; j < 16; ++j) v[j] = src >= 0 ? *(const f32x4*)(wp + (size_t)(4 * j) * N) : (f32x4){0.f, 0.f, 0.f, 0.f};
#pragma unroll
    for (int j = 0; j < 16; ++j) { LAS float* d = scr + (4 * j + kr) * 65 + 4 * cg; d[0] = v[j].x; d[1] = v[j].y; d[2] = v[j].z; d[3] = v[j].w; }
    LDS_WAIT(); asm volatile("" ::: "memory");
    const int c = lane & 7;
#pragma unroll
    for (int j = 0; j < 8; ++j) { const int nn = (lane >> 3) + 8 * j; const LAS float* q = scr + (8 * c) * 65 + nn;
        u32x4 o; o.x = cvtpk(q[0], q[65]); o.y = cvtpk(q[2 * 65], q[3 * 65]); o.z = cvtpk(q[4 * 65], q[5 * 65]); o.w = cvtpk(q[6 * 65], q[7 * 65]);
        if (imgnt) *(u32x4*)((unsigned char*)WT + pg8::img_off(n0 + nn, k0 + 8 * c, imgnt, permb)) = o;
        else *(u32x4*)(WT + (size_t)(n0 + nn) * K + k0 + 8 * c) = o; }
    LDS_WAIT(); asm volatile("" ::: "memory");
}

constexpr int I_MOD = 384, I_TWIN = (NP_IN / 64) * 8, I_TWOUT = (D / 64) * 8, I_TWGU = (N_GU / 64) * 8, I_TWDN = (D / 64) * 22, I_ROPE = 32;
constexpr int P0_ITEMS = I_MOD + I_ROPE + I_TWIN;
constexpr int CW_QGU = 192, CW_QDN = 320;

__device__ __forceinline__ void p0_mod_item(Frame& F, int item) {
    const int w = F.wave, lane = F.lane, cg = item >> 2, kq = item & 3;
    f32x4 acc[10];
#pragma unroll
    for (int b = 0; b < 10; ++b) acc[b] = (f32x4){0.f, 0.f, 0.f, 0.f};
    const int kbase = 1024 * kq + 128 * w;
    const float* wp = F.in[I_WADA] + (size_t)kbase * NMOD + 256 * cg + 4 * lane;
#pragma unroll 1
    for (int kc = 0; kc < 2; ++kc) {
        float scv[10];
#pragma unroll
        for (int b = 0; b < 10; ++b) { const int k = kbase + 64 * kc + lane; const float c = b < 2 ? F.in[I_CP][b * D + k] : F.in[I_CS][(b - 2) * D + k]; scv[b] = c / (1.f + __expf(-c)); }
#pragma unroll
        for (int kk = 0; kk < 64; ++kk) {
            const f32x4 wv = *(const f32x4*)(wp + (size_t)(64 * kc + kk) * NMOD);
#pragma unroll
            for (int b = 0; b < 10; ++b) { const float sv = __builtin_bit_cast(float, __builtin_amdgcn_readlane(__builtin_bit_cast(int, scv[b]), kk)); acc[b] += wv * sv; }
        }
    }
    LAS float* red = (LAS float*)F.lds;
#pragma unroll
    for (int b = 0; b < 10; ++b) *(LAS f32x4*)(red + (w * 10 + b) * 256 + 4 * lane) = acc[b];
    __syncthreads();
    for (int o = F.tid; o < 2560; o += NTHR) { const int b = o >> 8, c = o & 255; float sacc = kq == 0 ? F.in[I_BADA][256 * cg + c] : 0.f;
#pragma unroll
        for (int ww = 0; ww < 8; ++ww) sacc += red[(ww * 10 + b) * 256 + c];
        atomicAdd(F.MOD + b * NMOD + 256 * cg + c, sacc); }
    __syncthreads();
}
__device__ __forceinline__ void p0_rope_item(Frame& F, int it) {
    const int pos = 256 * it + (F.tid >> 1), fh = F.tid & 1;
#pragma unroll 1
    for (int f = 16 * fh; f < 16 * fh + 16; ++f) {
        const float inv = (float)exp2(-(double)f * (13.287712379549449 / 32.0));
        const float ang = (float)pos * inv;
        const double a = (double)ang, r = a - 6.283185307179586 * rint(a * 0.15915494309189535);
        F.ROPEC[pos * 32 + f] = (float)cos(r); F.ROPES[pos * 32 + f] = (float)sin(r);
    }
}
__device__ __forceinline__ void p0_phase(Frame& F, int qw) {
    LAS float* scr = (LAS float*)(F.lds + F.wave * 16640);
    for (;;) {
        __syncthreads();
        if (F.tid == 0) F.MISC[0] = __hip_atomic_fetch_add(F.ctl + qw, 1u, RLX_AGENT);
        __syncthreads();
        int it = (int)F.MISC[0];
        if (it >= P0_ITEMS) break;
        if (it < I_MOD) { p0_mod_item(F, it); continue; } it -= I_MOD;
        if (it < I_ROPE) { p0_rope_item(F, it); continue; } it -= I_ROPE;
        const int w = F.wave;
        p0_transpose(F.in[I_WIN], D, N_IN, F.WIN, 1, scr, 64 * (it >> 3), 512 * (it & 7) + 64 * w, F.lane, D / 64, true);
    }
}
template <int KIND>
__device__ __forceinline__ void drain_weights(Frame& F) {
    LAS float* scr = (LAS float*)(F.lds + F.wave * 16640);
    for (;;) {
        __syncthreads();
        if (F.tid == 0) F.MISC[0] = __hip_atomic_fetch_add(F.ctl + (KIND == 0 ? CW_QGU : CW_QDN), 1u, RLX_AGENT);
        __syncthreads();
        int it = (int)F.MISC[0];
        if (it >= (KIND == 0 ? I_TWOUT + I_TWGU : I_TWDN)) break;
        const int w = F.wave;
        if (KIND == 0 && it < I_TWOUT) p0_transpose(F.in[I_WOUT], D, D, F.WOUT, 0, scr, 64 * (it >> 3), 512 * (it & 7) + 64 * w, F.lane, D / 64, true);
        else if (KIND == 0) { it -= I_TWOUT; p0_transpose(F.in[I_WGU], D, N_GU, F.WGU, 2, scr, 64 * (it >> 3), 512 * (it & 7) + 64 * w, F.lane, D / 64, true); }
        else { const int nb = it / 22, kb = it % 22, k0 = 512 * kb + 64 * w; if (k0 < DFF) p0_transpose(F.in[I_WDN], DFF, D, F.WDN, 0, scr, 64 * nb, k0, F.lane, DFF / 64, true); }
    }
}

template <bool SRCB>
__device__ __forceinline__ void norm_mod_rows(Frame& F, const float* xp, const float* xs, const bf16* xb, const float* g, int off_sh, int off_sc, bf16* Hout) {
    const int gw = F.bid * NWAVES + F.wave, NGW = F.G * NWAVES;
    for (int row = gw; row < MPAD; row += NGW) {
        unsigned char* hb = (unsigned char*)Hout + (size_t)(row >> 7) * (D / 64) * (size_t)pg8::HTB + 8 * (F.lane & 1);
        const int kt0 = F.lane >> 4, cc = (4 * F.lane) & 56, o_lo = pg8::lds_byte(row & 127, cc);
#define H_ST8(j, val) (*(GAS unsigned long long*)(hb + (size_t)(4 * (j) + kt0) * pg8::HTB + o_lo) = (val))
        if (row >= MREAL) {
#pragma unroll
            for (int j = 0; j < 16; ++j) H_ST8(j, 0ull);
            continue; }
        f32x4 v[16]; float s = 0.f;
        if (!SRCB) { const float* xrow = row < MP ? xp + (size_t)row * D : xs + (size_t)(row - MP) * D;
            const GAS f32x4* xr = (const GAS f32x4*)xrow + F.lane;
#pragma unroll
            for (int j = 0; j < 16; ++j) v[j] = xr[64 * j]; }
        else { const GAS u32x2* xr = (const GAS u32x2*)(xb + (size_t)row * D) + F.lane;
#pragma unroll
            for (int j = 0; j < 16; ++j) { const u32x2 w = xr[64 * j]; v[j] = (f32x4){bflo(w.x), bfhi(w.x), bflo(w.y), bfhi(w.y)}; } }
#pragma unroll
        for (int j = 0; j < 16; ++j) s += (v[j].x * v[j].x + v[j].y * v[j].y) + (v[j].z * v[j].z + v[j].w * v[j].w);
        const float r = 1.0f / sqrtf(wave_sum(s) * (1.f / D) + NORM_EPS);
        const float* mod = F.MOD + (size_t)row_batch(row) * NMOD;
#pragma unroll
        for (int j = 0; j < 16; ++j) { const int c = 256 * j + 4 * F.lane;
            const f32x4 gg = *(const f32x4*)(g + c), sh = *(const f32x4*)(mod + off_sh + c), sc = *(const f32x4*)(mod + off_sc + c);
            const f32x4 y = (v[j] * r) * gg * (sc + 1.0f) + sh;
            H_ST8(j, (unsigned long long)cvtpk(y.x, y.y) | ((unsigned long long)cvtpk(y.z, y.w) << 32)); }
    }
}

__device__ __forceinline__ float sigmoidf_(float x) { return __builtin_amdgcn_rcpf(1.f + __expf(-x)); }
struct EpiIn {
    static constexpr bool PERM = true;
    bf16* P; const float* ropec; const float* ropes; float* out;
    __device__ __forceinline__ void operator()(const f32x4 (&acc)[2][2][4][2], const pg8::Unit& u, int wr, int wc, int fr, int fq) const {
        const int pn = u.pn, pm = u.pm;
        const bool is_q = pn >= 48 && pn < 64, is_k = pn >= 64 && pn < 66, is_v = pn >= 66 && pn < 68;
        const bool is_gz = (pn >= 32 && pn < 48) || (pn >= 68 && pn < 84), is_zb = pn >= 84 && pn < 100;
        const int t = 4 * (wc & 1) + fq;
        if (is_gz) {
            const int ct = pn < 48 ? pn - 32 : 16 + (pn - 68);
#pragma unroll
            for (int ai = 0; ai < 2; ++ai)
#pragma unroll
                for (int m = 0; m < 4; ++m) { const int row = pm * 256 + ai * 128 + wr * 64 + m * 16 + fr;
                    const f32x4 g0 = acc[ai][0][m][0], g1 = acc[ai][0][m][1], z0 = acc[ai][1][m][0], z1 = acc[ai][1][m][1]; float a[8];
#pragma unroll
                    for (int x = 0; x < 4; ++x) { a[x] = g0[x] * sigmoidf_(g0[x]) * sigmoidf_(z0[x]); a[4 + x] = g1[x] * sigmoidf_(g1[x]) * sigmoidf_(z1[x]); }
                    u32x4 w; w.x = cvtpk(a[0], a[1]); w.y = cvtpk(a[2], a[3]); w.z = cvtpk(a[4], a[5]); w.w = cvtpk(a[6], a[7]);
                    *(u32x4*)(P + pj(row, C_GA + ct * 128 + wc * 32 + 8 * fq)) = w; }
            return; }
#pragma unroll
        for (int ai = 0; ai < 2; ++ai)
#pragma unroll
            for (int m = 0; m < 4; ++m) {
                const int row = pm * 256 + ai * 128 + wr * 64 + m * 16 + fr;
                bf16* rowp = P + pj(row, pn * 256 + wc * 32 + 8 * fq);
                long kbase = -1;
                if (is_k || is_v) {
                    if (row < MP) { const int tt = row & 8191; if (tt >= 8064) kbase = (is_k ? OUT_KP : OUT_VP) + ((long)((row >> 13) * 128 + (tt - 8064)) * 8) * 64; }
                    else if (row < MREAL) { const int r2 = row - MP; kbase = (is_k ? OUT_KS : OUT_VS) + ((long)((r2 >> 4) * 16 + (r2 & 15)) * 8) * 64; }
                }
                f32x4 cs, sn;
                if (is_q || is_k) { const int pos = row_pos(row); cs = *(const f32x4*)(ropec + pos * 32 + 4 * t); sn = *(const f32x4*)(ropes + pos * 32 + 4 * t); }
#pragma unroll
                for (int bj = 0; bj < 2; ++bj) {
                    f32x4 v0 = acc[ai][bj][m][0], v1 = acc[ai][bj][m][1];
                    if (is_q || is_k) { const f32x4 o1 = v0 * cs - v1 * sn, o2 = v1 * cs + v0 * sn; v0 = o1; v1 = o2;
                        if (is_q) { v0 = v0 * QSCALE; v1 = v1 * QSCALE; } }
                    if (is_zb) {
#pragma unroll
                        for (int x = 0; x < 4; ++x) { v0[x] = sigmoidf_(v0[x]); v1[x] = sigmoidf_(v1[x]); } }
                    if (kbase >= 0) {
                        const int g = 4 * (pn - (is_k ? 64 : 66)) + 2 * bj + (wc >> 1);
                        float* kp = out + kbase + g * 64;
                        if (is_k) { *(f32x4*)(kp + 4 * t) = v0; *(f32x4*)(kp + 32 + 4 * t) = v1; }
                        else { *(f32x4*)(kp + 8 * t) = v0; *(f32x4*)(kp + 8 * t + 4) = v1; }
                    }
                    u32x4 w; w.x = cvtpk(v0[0], v0[1]); w.y = cvtpk(v0[2], v0[3]); w.z = cvtpk(v1[0], v1[1]); w.w = cvtpk(v1[2], v1[3]);
                    *(u32x4*)(rowp + bj * 128) = w;
                }
            }
    }
};

constexpr int CL_PITCH = 520;
constexpr float GLA_QSCALE = 0.04419417382415922f;
__device__ __forceinline__ int crow(int reg, int h) { return (reg & 3) + 8 * (reg >> 2) + 4 * h; }
#define MFMA32(a, b, c) __builtin_amdgcn_mfma_f32_32x32x16_bf16((a), (b), (c), 0, 0, 0)
__device__ __forceinline__ bf16x8 pack8(const f32x16& x, int s) {
    u32x4 p; p.x = cvtpk(x[8 * s], x[8 * s + 1]); p.y = cvtpk(x[8 * s + 2], x[8 * s + 3]); p.z = cvtpk(x[8 * s + 4], x[8 * s + 5]); p.w = cvtpk(x[8 * s + 6], x[8 * s + 7]);
    return __builtin_bit_cast(bf16x8, p);
}
constexpr float LOG2E_ = 1.4426950408889634f;
__device__ __forceinline__ float logsig(float x) { return fminf(x, 0.f) - __logf(1.f + __expf(-fabsf(x))); }

__device__ __forceinline__ void gla_chunk_local(Frame& F, int cid, int hd) {
    const int tid = F.tid, lane = F.lane, wv = F.wave, h = lane >> 5;
    LAS bf16* QL = (LAS bf16*)F.lds; LAS bf16* KL = QL + 64 * CL_PITCH;
    LAS float* RA = (LAS float*)(F.lds + 133120); LAS float* RED = (LAS float*)(F.lds + 137216);
    int row0, ntok; if (cid < 256) { row0 = cid * 64; ntok = 64; } else { row0 = MP + 16 * (cid - 256); ntok = 16; }
    const int d = tid;
    float wg[16];
#pragma unroll
    for (int r = 0; r < 16; ++r) wg[r] = F.in[I_WGK][r * 2048 + hd * 512 + d];
    const float bias = F.in[I_BGK][hd * 512 + d];
    u32x4 rq[8], rk[8];
#pragma unroll
    for (int j = 0; j < 8; ++j) { const int id = tid + 512 * j, rr = id >> 6, c16 = id & 63; rq[j] = (u32x4){0u, 0u, 0u, 0u}; rk[j] = rq[j];
        if (rr < ntok) { rq[j] = *(const u32x4*)(F.PROJ + pj(row0 + rr, C_QA + hd * 512 + 8 * c16)); rk[j] = *(const u32x4*)(F.PROJ + pj(row0 + rr, C_KA + hd * 512 + 8 * c16)); } }
    if (tid < 128) { const int i = tid >> 1, half = tid & 1; u32x4 w = (u32x4){0u, 0u, 0u, 0u};
        if (i < ntok) w = *(const u32x4*)(F.PROJ + pj(row0 + i, C_RA + 8 * half));
        LAS float* r = RA + i * 16 + 8 * half;
        r[0] = bflo(w.x); r[1] = bfhi(w.x); r[2] = bflo(w.y); r[3] = bfhi(w.y); r[4] = bflo(w.z); r[5] = bfhi(w.z); r[6] = bflo(w.w); r[7] = bfhi(w.w); }
#pragma unroll
    for (int j = 0; j < 8; ++j) { const int id = tid + 512 * j, rr = id >> 6, c16 = id & 63; *(LAS u32x4*)(QL + rr * CL_PITCH + 8 * c16) = rq[j]; *(LAS u32x4*)(KL + rr * CL_PITCH + 8 * c16) = rk[j]; }
    __syncthreads();
    float B[64]; float bc = 0.f;
    unsigned ra_base = (unsigned)(size_t)RA; asm volatile("" : "+v"(ra_base));
    const f32x2 w01 = {wg[0], wg[1]}, w23 = {wg[2], wg[3]}, w45 = {wg[4], wg[5]}, w67 = {wg[6], wg[7]}, w89 = {wg[8], wg[9]}, wab = {wg[10], wg[11]}, wcd = {wg[12], wg[13]}, wef = {wg[14], wg[15]};
#pragma unroll
    for (int i = 0; i < 64; ++i) {
        const LAS f32x4* rp = (const LAS f32x4*)(size_t)(ra_base + (unsigned)(i * 64));
        const f32x4 r0 = rp[0], r1 = rp[1], r2 = rp[2], r3 = rp[3];
        f32x2 a2 = (f32x2){r0.x, r0.y} * w01; a2 += (f32x2){r0.z, r0.w} * w23; a2 += (f32x2){r1.x, r1.y} * w45; a2 += (f32x2){r1.z, r1.w} * w67;
        a2 += (f32x2){r2.x, r2.y} * w89; a2 += (f32x2){r2.z, r2.w} * wab; a2 += (f32x2){r3.x, r3.y} * wcd; a2 += (f32x2){r3.z, r3.w} * wef;
        const float gk = bias + (a2.x + a2.y);
        const float l2 = __builtin_amdgcn_logf(1.f + __builtin_amdgcn_exp2f(-fabsf(gk) * LOG2E_));
        float g = (fminf(gk, 0.f) - l2 * 0.6931471805599453f) * (1.f / 16.f); if (i >= ntok) g = 0.f;
        bc += g; B[i] = bc; }
    const float bmid = (ntok == 64) ? B[32] : B[8], blast = B[63];
    float* VEC = (float*)(F.ws + WS_VEC) + (size_t)(cid * 4 + hd) * 1024;
    VEC[d] = __expf(bmid); VEC[512 + d] = __expf(blast - bmid);
    unsigned kpk[32]; float kprev = 0.f;
#pragma unroll
    for (int i = 0; i < 64; ++i) {
        const float q = bf2f(QL[i * CL_PITCH + d]), k = bf2f(KL[i * CL_PITCH + d]);
        const float qt = q * GLA_QSCALE * __expf(B[i] - bmid), kt = k * __expf(bmid - B[i]);
        QL[i * CL_PITCH + d] = (bf16)(cvtpk(qt, 0.f) & 0xffffu);
        KL[i * CL_PITCH + d] = (bf16)(cvtpk(kt, 0.f) & 0xffffu);
        if (i & 1) kpk[i >> 1] = cvtpk(kprev, kt); else kprev = kt; }
    __syncthreads();
    unsigned char* fq = F.ws + WS_FRAG + (size_t)(cid * 4 + hd) * 131072; unsigned char* fk = fq + 65536;
    { const int dt = (d >> 5) & 1, dl = d & 31;
#pragma unroll
      for (int sp = 0; sp < 4; ++sp)
#pragma unroll
          for (int hh = 0; hh < 2; ++hh) { u32x4 o; o.x = kpk[8 * sp + 4 * hh]; o.y = kpk[8 * sp + 4 * hh + 1]; o.z = kpk[8 * sp + 4 * hh + 2]; o.w = kpk[8 * sp + 4 * hh + 3];
              *(u32x4*)(fk + ((wv * 2 + dt) * 4 + sp) * 1024 + (dl + 32 * hh) * 16) = o; } }
#pragma unroll
    for (int mt = 0; mt < 2; ++mt)
#pragma unroll
        for (int dt = 0; dt < 2; ++dt)
#pragma unroll
            for (int s = 0; s < 2; ++s) { const int i = 32 * mt + (lane & 31), d0 = 64 * wv + 32 * dt + 16 * s + 4 * h;
                const u32x2 a = *(const LAS u32x2*)(QL + i * CL_PITCH + d0), b = *(const LAS u32x2*)(QL + i * CL_PITCH + d0 + 8);
                u32x4 o; o.x = a.x; o.y = a.y; o.z = b.x; o.w = b.y;
                *(u32x4*)(fq + (((wv * 2 + mt) * 2 + dt) * 2 + s) * 1024 + lane * 16) = o; }
    const int tile = wv & 3, jt = tile >> 1, it = tile & 1, kh = wv >> 2;
    f32x16 acc;
#pragma unroll
    for (int r = 0; r < 16; ++r) acc[r] = 0.f;
#pragma unroll
    for (int ks = 0; ks < 16; ++ks) { const int dk = 256 * kh + 16 * ks + 8 * h;
        const bf16x8 a = *(const LAS bf16x8*)(KL + (32 * jt + (lane & 31)) * CL_PITCH + dk);
        const bf16x8 b = *(const LAS bf16x8*)(QL + (32 * it + (lane & 31)) * CL_PITCH + dk);
        acc = MFMA32(a, b, acc); }
    if (kh == 1) {
#pragma unroll
        for (int r = 0; r < 16; ++r) RED[(tile * 16 + r) * 64 + lane] = acc[r]; }
    __syncthreads();
    if (kh == 0) {
        const int i = 32 * it + (lane & 31);
#pragma unroll
        for (int r = 0; r < 16; ++r) { const float v = acc[r] + RED[(tile * 16 + r) * 64 + lane]; const int j = 32 * jt + crow(r, h); acc[r] = (j > i) ? 0.f : v; }
        unsigned char* am = F.ws + WS_AMAT + (size_t)(cid * 4 + hd) * 8192;
#pragma unroll
        for (int s = 0; s < 2; ++s) { const bf16x8 p = pack8(acc, s); *(bf16x8*)(am + (it + 2 * (2 * jt + s)) * 1024 + lane * 16) = p; }
    }
    __syncthreads();
}

constexpr int KS_PITCH = 72, VT_PITCH = 196;
constexpr float LOG2E = 1.4426950408889634f;
constexpr size_t WS_DUMMY = 1600 * MiB;
template <bool SAMPLE, bool DUMMY = false>
__device__ __forceinline__ void swa_unit(Frame& F, int b, int n, int g) {
    const int tid = F.tid, lane = F.lane, wv = F.wave, h = lane >> 5;
    LAS bf16* KS = (LAS bf16*)F.lds; LAS bf16* VT = KS + 192 * KS_PITCH;
    int nk, ntile;
    if (!SAMPLE) {
        nk = 64 * (n + 1 < 3 ? n + 1 : 3); ntile = nk >> 5;
        const int kr0 = b * SEQ + 64 * (n > 2 ? n - 2 : 0);
        for (int task = tid; task < nk * 8; task += NTHR) { const int key = task >> 3, c8 = task & 7;
            *(LAS u32x4*)(KS + key * KS_PITCH + 8 * c8) = *(const u32x4*)(F.PROJ + pj(kr0 + key, C_KB + g * 64 + 8 * c8)); }
        for (int task = tid; task < nk * 8; task += NTHR) { const int kp = task >> 4, dq = task & 15;
            const bf16* vp = F.PROJ + pj(kr0 + 2 * kp, C_VB + g * 64 + 4 * dq);
            const u32x2 a = *(const u32x2*)vp, c = *(const u32x2*)(vp + 256);
            LAS unsigned* o = (LAS unsigned*)(VT + (4 * dq) * VT_PITCH + 2 * kp);
            o[0] = (a.x & 0xffffu) | (c.x << 16); o[VT_PITCH / 2] = (a.x >> 16) | (c.x & 0xffff0000u);
            o[VT_PITCH] = (a.y & 0xffffu) | (c.y << 16); o[3 * (VT_PITCH / 2)] = (a.y >> 16) | (c.y & 0xffff0000u); }
    } else {
        nk = 144; ntile = 5;
        const float* ck = F.in[I_CK]; const float* cv = F.in[I_CV];
        for (int task = tid; task < 160 * 8; task += NTHR) { const int key = task >> 3, t = task & 7; u32x4 o = (u32x4){0u, 0u, 0u, 0u};
            if (key < 128) { const float* p = ck + ((size_t)(b * 128 + key) * 8 + g) * 64; const f32x4 x1 = *(const f32x4*)(p + 4 * t), x2 = *(const f32x4*)(p + 32 + 4 * t);
                o.x = cvtpk(x1.x, x1.y); o.y = cvtpk(x1.z, x1.w); o.z = cvtpk(x2.x, x2.y); o.w = cvtpk(x2.z, x2.w); }
            else if (key < 144) o = *(const u32x4*)(F.PROJ + pj(MP + 16 * b + (key - 128), C_KB + g * 64 + 8 * t));
            *(LAS u32x4*)(KS + key * KS_PITCH + 8 * t) = o; }
        for (int task = tid; task < 80 * 16; task += NTHR) { const int kp = task >> 4, dq = task & 15; unsigned w0 = 0u, w1 = 0u, w2 = 0u, w3 = 0u;
            if (kp < 64) { const float* p = cv + ((size_t)(b * 128 + 2 * kp) * 8 + g) * 64 + 4 * dq; const f32x4 a = *(const f32x4*)p, c = *(const f32x4*)(p + 512);
                w0 = cvtpk(a.x, c.x); w1 = cvtpk(a.y, c.y); w2 = cvtpk(a.z, c.z); w3 = cvtpk(a.w, c.w); }
            else if (kp < 72) { const bf16* vp = F.PROJ + pj(MP + 16 * b + 2 * (kp - 64), C_VB + g * 64 + 4 * dq);
                const u32x2 a = *(const u32x2*)vp, c = *(const u32x2*)(vp + 256);
                w0 = (a.x & 0xffffu) | (c.x << 16); w1 = (a.x >> 16) | (c.x & 0xffff0000u); w2 = (a.y & 0xffffu) | (c.y << 16); w3 = (a.y >> 16) | (c.y & 0xffff0000u); }
            LAS unsigned* o = (LAS unsigned*)(VT + (4 * dq) * VT_PITCH + 2 * kp);
            o[0] = w0; o[VT_PITCH / 2] = w1; o[VT_PITCH] = w2; o[3 * (VT_PITCH / 2)] = w3; }
    }
    __syncthreads();
    const int npass = SAMPLE ? 1 : 2;
    if (!SAMPLE || wv < 4) {
#pragma unroll 1
        for (int pass = 0; pass < npass; ++pass) {
            const int r = lane & 31;
            int head, row;
            if (!SAMPLE) { head = g * 8 + wv; row = b * SEQ + 64 * n + 32 * pass + r; }
            else { head = g * 8 + 2 * wv + (r >> 4); row = MP + 16 * b + (r & 15); }
            const float sink2 = F.in[I_SINK][head] * LOG2E;
            bf16* qptr = F.PROJ + pj(row, C_QB + head * 64);
            bf16x8 qf[4];
#pragma unroll
            for (int t = 0; t < 4; ++t) qf[t] = *(const bf16x8*)(qptr + 16 * t + 8 * h);
            f32x16 st[6];
#pragma unroll
            for (int kt = 0; kt < 6; ++kt) {
#pragma unroll
                for (int rr = 0; rr < 16; ++rr) st[kt][rr] = -INFINITY;
                if (kt < ntile) { f32x16 a;
#pragma unroll
                    for (int rr = 0; rr < 16; ++rr) a[rr] = 0.f;
#pragma unroll
                    for (int t = 0; t < 4; ++t) { const bf16x8 kf = *(const LAS bf16x8*)(KS + (32 * kt + r) * KS_PITCH + 16 * t + 8 * h); a = MFMA32(kf, qf[t], a); }
                    st[kt] = a; } }
            if (SAMPLE) {
#pragma unroll
                for (int rr = 0; rr < 16; ++rr) if (crow(rr, h) >= 16) st[4][rr] = -INFINITY; }
            float m = sink2;
#pragma unroll
            for (int kt = 0; kt < 6; ++kt)
#pragma unroll
                for (int rr = 0; rr < 16; ++rr) m = fmaxf(m, st[kt][rr]);
            m = fmaxf(m, __shfl_xor(m, 32));
            float sum = 0.f;
#pragma unroll
            for (int kt = 0; kt < 6; ++kt)
#pragma unroll
                for (int rr = 0; rr < 16; ++rr) { const float p = __builtin_amdgcn_exp2f(st[kt][rr] - m); st[kt][rr] = p; sum += p; }
            sum += __shfl_xor(sum, 32);
            const float inv = 1.f / (sum + __builtin_amdgcn_exp2f(sink2 - m));
            f32x16 o0, o1;
#pragma unroll
            for (int rr = 0; rr < 16; ++rr) { o0[rr] = 0.f; o1[rr] = 0.f; }
#pragma unroll
            for (int kt = 0; kt < 6; ++kt) if (kt < ntile) {
#pragma unroll
                for (int s = 0; s < 2; ++s) { const bf16x8 pb = pack8(st[kt], s);
                    const LAS bf16* v0 = VT + r * VT_PITCH + 32 * kt + 16 * s + 4 * h; const LAS bf16* v1 = v0 + 32 * VT_PITCH;
                    const u32x2 a0 = *(const LAS u32x2*)v0, a1 = *(const LAS u32x2*)(v0 + 8), c0 = *(const LAS u32x2*)v1, c1 = *(const LAS u32x2*)(v1 + 8);
                    u32x4 va; va.x = a0.x; va.y = a0.y; va.z = a1.x; va.w = a1.y; u32x4 vc; vc.x = c0.x; vc.y = c0.y; vc.z = c1.x; vc.w = c1.y;
                    o0 = MFMA32(__builtin_bit_cast(bf16x8, va), pb, o0); o1 = MFMA32(__builtin_bit_cast(bf16x8, vc), pb, o1); } }
#pragma unroll
            for (int rg = 0; rg < 4; ++rg) { u32x2 w0, w1;
                w0.x = cvtpk(o0[4 * rg] * inv, o0[4 * rg + 1] * inv); w0.y = cvtpk(o0[4 * rg + 2] * inv, o0[4 * rg + 3] * inv);
                w1.x = cvtpk(o1[4 * rg] * inv, o1[4 * rg + 1] * inv); w1.y = cvtpk(o1[4 * rg + 2] * inv, o1[4 * rg + 3] * inv);
                bf16* optr = DUMMY ? (bf16*)(F.ws + WS_DUMMY) + (size_t)(row & 1023) * 4096 + head * 64 : qptr;
                *(u32x2*)(optr + 8 * rg + 4 * h) = w0; *(u32x2*)(optr + 32 + 8 * rg + 4 * h) = w1; }
        }
    }
    __syncthreads();
}

constexpr int P3_CL = 264 * 4, P3_SWAP = 2048, P3_SWAS = 64, P3_UNITS = P3_CL + P3_SWAP + P3_SWAS;
__device__ __forceinline__ void p3_phase(Frame& F) {
    for (int u = F.bid; u < P3_CL; u += F.G) gla_chunk_local(F, u >> 2, u & 3);
#if PROBE_TWICE == 105
    for (int u = F.bid; u < P3_CL; u += F.G) gla_chunk_local(F, u >> 2, u & 3);
#endif
#if PROBE_TWICE == 103
    for (int v = (F.bid + F.G - (P3_CL % F.G)) % F.G; v < P3_SWAP; v += F.G) swa_unit<false, true>(F, v >> 10, (v >> 3) & 127, v & 7);
#endif
    const bool bal = F.G == 256;
    for (int v = (F.bid + F.G - (P3_CL % F.G)) % F.G, k = 0; v < P3_SWAP; v += F.G, ++k) { if (bal && F.bid < 32 && k >= 6) break; swa_unit<false>(F, v >> 10, (v >> 3) & 127, v & 7); }
    if (bal && F.bid >= 96 && F.bid < 160) { const int src = (F.bid - 96) >> 1, v = ((src + F.G - (P3_CL % F.G)) % F.G) + F.G * (6 + ((F.bid - 96) & 1)); swa_unit<false>(F, v >> 10, (v >> 3) & 127, v & 7); }
    for (int v = (F.bid + 2 * F.G - ((P3_CL + P3_SWAP) % F.G)) % F.G; v < P3_SWAS; v += F.G) swa_unit<true>(F, v >> 3, 0, v & 7);
}

__device__ __forceinline__ u32x2 tr_read8(unsigned addr) { u32x2 r; asm volatile("ds_read_b64_tr_b16 %0, %1\n\ts_waitcnt lgkmcnt(0)" : "=&v"(r) : "v"(addr) : "memory"); return r; }
struct ScanQ { bf16x8 qf[2][2][2], af; };
__device__ __forceinline__ void scan_load_q(ScanQ& P, const unsigned char* ws, int cid, int hd, int wv, int lane) {
    const unsigned char* fq = ws + WS_FRAG + (size_t)(cid * 4 + hd) * 131072;
#pragma unroll
    for (int mt = 0; mt < 2; ++mt)
#pragma unroll
        for (int dt = 0; dt < 2; ++dt)
#pragma unroll
            for (int s = 0; s < 2; ++s) P.qf[mt][dt][s] = *(const bf16x8*)(fq + (((wv * 2 + mt) * 2 + dt) * 2 + s) * 1024 + lane * 16);
    P.af = *(const bf16x8*)(ws + WS_AMAT + (size_t)(cid * 4 + hd) * 8192 + wv * 1024 + lane * 16);
}
__device__ __forceinline__ void scan_load_v(u32x4& vt, f32x4& vec, const unsigned char* ws, const bf16* PROJ, int cid, int hd, int row0, int ntok, int e0, int tid) {
    vt = (u32x4){0u, 0u, 0u, 0u}; vec = (f32x4){0.f, 0.f, 0.f, 0.f};
    if (tid < 256) { const int i = tid >> 2, c4 = tid & 3;
        if (i < ntok) vt = *(const u32x4*)(PROJ + pj(row0 + i, C_VA + hd * 1024 + e0 + 8 * c4));
        vec = *(const f32x4*)((const float*)(ws + WS_VEC) + (size_t)(cid * 4 + hd) * 1024 + 4 * tid); }
}
__device__ __forceinline__ void scan_store_v(LAS unsigned char* base, const u32x4& vt, const f32x4& vec, int tid) {
    if (tid < 256) { *(LAS u32x4*)((LAS bf16*)base + (tid >> 2) * 32 + 8 * (tid & 3)) = vt; *(LAS f32x4*)((LAS float*)(base + 4096) + 4 * tid) = vec; }
}
struct ScanK { bf16x8 kf[2][4]; };
__device__ __forceinline__ void scan_load_k(ScanK& P, const unsigned char* ws, int cid, int hd, int wv, int lane) {
    const unsigned char* fk = ws + WS_FRAG + (size_t)(cid * 4 + hd) * 131072 + 65536;
#pragma unroll
    for (int dt = 0; dt < 2; ++dt)
#pragma unroll
        for (int sp = 0; sp < 4; ++sp) P.kf[dt][sp] = *(const bf16x8*)(fk + ((wv * 2 + dt) * 4 + sp) * 1024 + lane * 16);
}
constexpr int SC_BUF = 73728, SC_VEC = 4096, SC_RED = 8192;
struct ScanTr { u32x2 n[8]; };
__device__ __forceinline__ void scan_tr_reads_p(u32x2& p0, u32x2& p1, unsigned aP) {
    asm volatile("ds_read_b64_tr_b16 %0, %2\n\tds_read_b64_tr_b16 %1, %2 offset:512\n\ts_waitcnt lgkmcnt(0)" : "=&v"(p0), "=&v"(p1) : "v"(aP) : "memory");
}
__device__ __forceinline__ void scan_tr_reads_n(ScanTr& T, unsigned aN) {
    asm volatile("ds_read_b64_tr_b16 %0, %8\n\tds_read_b64_tr_b16 %1, %8 offset:256\n\t"
                 "ds_read_b64_tr_b16 %2, %8 offset:1024\n\tds_read_b64_tr_b16 %3, %8 offset:1280\n\t"
                 "ds_read_b64_tr_b16 %4, %8 offset:2048\n\tds_read_b64_tr_b16 %5, %8 offset:2304\n\t"
                 "ds_read_b64_tr_b16 %6, %8 offset:3072\n\tds_read_b64_tr_b16 %7, %8 offset:3328\n\ts_waitcnt lgkmcnt(0)"
                 : "=&v"(T.n[0]), "=&v"(T.n[1]), "=&v"(T.n[2]), "=&v"(T.n[3]), "=&v"(T.n[4]), "=&v"(T.n[5]), "=&v"(T.n[6]), "=&v"(T.n[7])
                 : "v"(aN) : "memory");
}
template <bool DUMMY, int BUF>
__device__ __forceinline__ void scan_reduce(Frame& F, int hd, int row0, int ntok, int e0) {
    const int tid = F.tid; LAS float* RED = (LAS float*)(F.lds + BUF * SC_BUF + SC_RED);
    const int i = tid >> 3, e4 = 4 * (tid & 7); f32x4 sacc = *(const LAS f32x4*)(RED + i * 32 + e4);
#pragma unroll
    for (int w = 1; w < 8; ++w) sacc += *(const LAS f32x4*)(RED + w * 2048 + i * 32 + e4);
    if (i < ntok) { u32x2 o; o.x = cvtpk(sacc.x, sacc.y); o.y = cvtpk(sacc.z, sacc.w);
        bf16* op_ = DUMMY ? (bf16*)(F.ws + WS_DUMMY) + (size_t)((row0 + i) & 1023) * 4096 + hd * 1024 + e0 + e4 : F.PROJ + pj(row0 + i, C_VA + hd * 1024 + e0 + e4);
        *(u32x2*)op_ = o; }
}
template <bool SAMPLE, bool DUMMY, int BUF>
__device__ __forceinline__ void scan_step(Frame& F, f32x16& S0, f32x16& S1, ScanQ& cq, ScanK& ck, int cidn, int hd, int rowp, int rown, int ntok, int e0) {
    const int tid = F.tid, lane = F.lane, wv = F.wave, h = lane >> 5, el = lane & 31;
    LAS unsigned char* base = F.lds + BUF * SC_BUF;
    LAS bf16* VB = (LAS bf16*)base; LAS float* VECL = (LAS float*)(base + SC_VEC); LAS float* RED = (LAS float*)(base + SC_RED);
    __syncthreads();
    u32x4 nvt; f32x4 nvec;
    if (!SAMPLE) scan_load_v(nvt, nvec, F.ws, F.PROJ, cidn, hd, rown, ntok, e0, tid);
    if (!SAMPLE && rowp >= 0) scan_reduce<DUMMY, BUF ^ 1>(F, hd, rowp, ntok, e0);
    const int i16 = lane & 15; const unsigned tro = (unsigned)(size_t)VB + (unsigned)((i16 >> 2) * 64 + 32 * ((lane >> 4) & 1) + 8 * (i16 & 3));
    u32x2 tp0, tp1; scan_tr_reads_p(tp0, tp1, tro + (unsigned)((16 * (wv >> 1) + 4 * h) * 64));
#pragma unroll
    for (int rg = 0; rg < 4; ++rg) { const f32x4 e0v = *(const LAS f32x4*)(VECL + 64 * wv + 8 * rg + 4 * h), e1v = *(const LAS f32x4*)(VECL + 64 * wv + 32 + 8 * rg + 4 * h);
#pragma unroll
        for (int x = 0; x < 4; ++x) { S0[4 * rg + x] *= e0v[x]; S1[4 * rg + x] *= e1v[x]; } }
    bf16x8 vP; { u32x4 vv; vv.x = tp0.x; vv.y = tp0.y; vv.z = tp1.x; vv.w = tp1.y; vP = __builtin_bit_cast(bf16x8, vv); }
    LAS float* rw = RED + wv * 2048;
#pragma unroll
    for (int mt = 0; mt < 2; ++mt) {
        f32x16 op;
#pragma unroll
        for (int r = 0; r < 16; ++r) op[r] = 0.f;
        op = MFMA32(cq.qf[mt][0][0], pack8(S0, 0), op); op = MFMA32(cq.qf[mt][0][1], pack8(S0, 1), op); op = MFMA32(cq.qf[mt][1][0], pack8(S1, 0), op); op = MFMA32(cq.qf[mt][1][1], pack8(S1, 1), op);
        if ((wv & 1) == mt) op = MFMA32(cq.af, vP, op);
#pragma unroll
        for (int r = 0; r < 16; ++r) rw[(32 * mt + crow(r, h)) * 32 + el] = op[r];
    }
    asm volatile("" ::: "memory");
    if (!SAMPLE) scan_load_q(cq, F.ws, cidn, hd, wv, lane);
    ScanTr T; scan_tr_reads_n(T, tro + (unsigned)(8 * h * 64));
#pragma unroll
    for (int sp = 0; sp < 4; ++sp) { u32x4 vv; vv.x = T.n[2 * sp].x; vv.y = T.n[2 * sp].y; vv.z = T.n[2 * sp + 1].x; vv.w = T.n[2 * sp + 1].y;
        const bf16x8 vN = __builtin_bit_cast(bf16x8, vv);
        S0 = MFMA32(ck.kf[0][sp], vN, S0); S1 = MFMA32(ck.kf[1][sp], vN, S1); }
    asm volatile("" ::: "memory");
    if (!SAMPLE) scan_load_k(ck, F.ws, cidn, hd, wv, lane);
#pragma unroll
    for (int rg = 0; rg < 4; ++rg) { const f32x4 e0v = *(const LAS f32x4*)(VECL + 512 + 64 * wv + 8 * rg + 4 * h), e1v = *(const LAS f32x4*)(VECL + 512 + 64 * wv + 32 + 8 * rg + 4 * h);
#pragma unroll
        for (int x = 0; x < 4; ++x) { S0[4 * rg + x] *= e0v[x]; S1[4 * rg + x] *= e1v[x]; } }
    if (!SAMPLE) scan_store_v(F.lds + (BUF ^ 1) * SC_BUF, nvt, nvec, tid);
}
template <bool SAMPLE, bool DUMMY = false>
__device__ __forceinline__ void scan_item(Frame& F, int seq, int slice) {
    const int tid = F.tid, lane = F.lane, wv = F.wave, h = lane >> 5, el = lane & 31;
    const int hd = seq & 3, b = seq >> 2, e0 = slice * 32;
    const int nchunks = SAMPLE ? 1 : 128, cid0 = SAMPLE ? 256 + b : b * 128, ntok = SAMPLE ? 16 : 64, row00 = SAMPLE ? MP + 16 * b : b * SEQ;
    ScanQ qa; ScanK ka;
    scan_load_q(qa, F.ws, cid0, hd, wv, lane);
    scan_load_k(ka, F.ws, cid0, hd, wv, lane);
    { u32x4 vt; f32x4 vec; scan_load_v(vt, vec, F.ws, F.PROJ, cid0, hd, row00, ntok, e0, tid); scan_store_v(F.lds, vt, vec, tid); }
    f32x16 S0, S1;
#pragma unroll
    for (int r = 0; r < 16; ++r) { S0[r] = 0.f; S1[r] = 0.f; }
    if (SAMPLE) { const float* sp = F.in[I_SG] + ((size_t)(b * 4 + hd) * 512 + 64 * wv + 4 * h) * 1024 + e0 + el;
#pragma unroll
        for (int rg = 0; rg < 4; ++rg) {
#pragma unroll
            for (int x = 0; x < 4; ++x) { S0[4 * rg + x] = sp[(size_t)(8 * rg + x) * 1024]; S1[4 * rg + x] = sp[(size_t)(32 + 8 * rg + x) * 1024]; }
            asm volatile("" ::: "memory"); } }
    if (SAMPLE) { scan_step<true, DUMMY, 0>(F, S0, S1, qa, ka, cid0, hd, -1, row00, ntok, e0); __syncthreads(); scan_reduce<DUMMY, 0>(F, hd, row00, ntok, e0); __syncthreads(); }
    else {
#pragma unroll 1
        for (int c = 0; c < nchunks; c += 2) {
            const int c2 = c + 2 < nchunks ? c + 2 : c + 1;
            scan_step<false, DUMMY, 0>(F, S0, S1, qa, ka, cid0 + c + 1, hd, c > 0 ? row00 + 64 * (c - 1) : -1, row00 + 64 * (c + 1), ntok, e0);
            scan_step<false, DUMMY, 1>(F, S0, S1, qa, ka, cid0 + c2, hd, row00 + 64 * c, row00 + 64 * c2, ntok, e0);
        }
        __syncthreads();
        scan_reduce<DUMMY, 1>(F, hd, row00 + 64 * (nchunks - 1), ntok, e0);
        __syncthreads();
    }
    { int h2 = h; asm volatile("" : "+v"(h2));
      float* so = F.out + (SAMPLE ? OUT_SGS : OUT_SGP) + ((size_t)(b * 4 + hd) * 512) * 1024 + e0 + (lane & 31) + (size_t)(64 * wv + 4 * h2) * 1024;
#pragma unroll
      for (int r = 0; r < 16; ++r) { so[(size_t)((r & 3) + 8 * (r >> 2)) * 1024] = S0[r]; so[(size_t)(32 + (r & 3) + 8 * (r >> 2)) * 1024] = S1[r]; } }
}
__device__ __forceinline__ void p4_phase(Frame& F) {
#if PROBE_TWICE == 104
    for (int it = F.bid; it < 256; it += F.G) scan_item<false, true>(F, it >> 5, it & 31);
#endif
    for (int it = F.bid; it < 256; it += F.G) scan_item<false>(F, it & 7, (it >> 3) & 31);
    { int t_ = threadIdx.x; asm volatile("" : "+v"(t_)); F.tid = t_; F.lane = t_ & 63; F.wave = __builtin_amdgcn_readfirstlane(t_ >> 6); }
    for (int it = F.bid; it < 1024; it += F.G) scan_item<true>(F, (it & 7) + 8 * (it >> 8), (it >> 3) & 31);
}

__device__ __forceinline__ void unpack8(const u32x4 w, float (&f)[8]) { f[0] = bflo(w.x); f[1] = bfhi(w.x); f[2] = bflo(w.y); f[3] = bfhi(w.y); f[4] = bflo(w.z); f[5] = bfhi(w.z); f[6] = bflo(w.w); f[7] = bfhi(w.w); }
__device__ __forceinline__ void p5_merge(Frame& F) {
    const int gw = F.bid * NWAVES + F.wave, NGW = F.G * NWAVES, lane = F.lane;
    const float* gg = F.in[I_GGLA] + 16 * lane;
    for (int row = gw; row < MPAD; row += NGW) {
        if (row >= MREAL) {
#pragma unroll
            for (int j = 0; j < 8; ++j) *(u32x4*)((unsigned char*)F.H + pg8::img_off(row, 512 * j + 8 * lane, D / 64, false)) = (u32x4){0u, 0u, 0u, 0u};
            continue; }
#pragma unroll 2
        for (int hd = 0; hd < 4; ++hd) {
            const int c = hd * 1024 + 16 * lane;
            const u32x4 wo0 = *(const u32x4*)(F.PROJ + pj(row, C_VA + c)), wo1 = *(const u32x4*)(F.PROJ + pj(row, C_VA + c) + 8);
            const u32x4 wg0 = *(const u32x4*)(F.PROJ + pj(row, C_GA + c)), wg1 = *(const u32x4*)(F.PROJ + pj(row, C_GA + c) + 8);
            const u32x4 wb0 = *(const u32x4*)(F.PROJ + pj(row, C_ZB + c)), wb1 = *(const u32x4*)(F.PROJ + pj(row, C_ZB + c) + 8);
            const u32x4 wq0 = *(const u32x4*)(F.PROJ + pj(row, C_QB + c)), wq1 = *(const u32x4*)(F.PROJ + pj(row, C_QB + c) + 8);
            float o[16], ga[16], zb[16], ob[16];
#define UP16(dst, w0, w1) { float t[8]; unpack8(w0, t); _Pragma("unroll") for (int x = 0; x < 8; ++x) dst[x] = t[x]; unpack8(w1, t); _Pragma("unroll") for (int x = 0; x < 8; ++x) dst[8 + x] = t[x]; }
            UP16(o, wo0, wo1)
            float ss = 0.f;
#pragma unroll
            for (int x = 0; x < 16; ++x) ss += o[x] * o[x];
            const float r = 1.0f / sqrtf(wave_sum(ss) * (1.f / 1024.f) + NORM_EPS);
            UP16(ga, wg0, wg1) UP16(zb, wb0, wb1) UP16(ob, wq0, wq1)
#undef UP16
            float mg[16];
#pragma unroll
            for (int x = 0; x < 16; ++x) mg[x] = (o[x] * r * gg[x]) * ga[x] + zb[x] * ob[x];
            u32x4 w0, w1; w0.x = cvtpk(mg[0], mg[1]); w0.y = cvtpk(mg[2], mg[3]); w0.z = cvtpk(mg[4], mg[5]); w0.w = cvtpk(mg[6], mg[7]);
            w1.x = cvtpk(mg[8], mg[9]); w1.y = cvtpk(mg[10], mg[11]); w1.z = cvtpk(mg[12], mg[13]); w1.w = cvtpk(mg[14], mg[15]);
            *(u32x4*)((unsigned char*)F.H + pg8::img_off(row, c, D / 64, false)) = w0; *(u32x4*)((unsigned char*)F.H + pg8::img_off(row, c + 8, D / 64, false)) = w1;
        }
    }
}

template <int MODE> struct EpiRes {
    static constexpr bool PERM = true;
    const float* srcf; const bf16* srcb; float* outf; bf16* outb; const float* mod; int off_gt;
    __device__ __forceinline__ void operator()(const f32x4 (&acc)[2][2][4][2], const pg8::Unit& u, int wr, int wc, int fr, int fq) const {
        const int col0 = u.pn * 256 + wc * 32 + 8 * fq;
        const float* gt = mod + (size_t)(u.pm >> 5) * NMOD + off_gt + col0;
        f32x4 g[2][2];
#pragma unroll
        for (int bj = 0; bj < 2; ++bj)
#pragma unroll
            for (int n = 0; n < 2; ++n) g[bj][n] = *(const f32x4*)(gt + bj * 128 + n * 4);
#pragma unroll
        for (int ai = 0; ai < 2; ++ai) {
            const size_t rbase = (size_t)(u.pm * 256 + ai * 128 + wr * 64 + fr) * D + col0;
            if (MODE == 0) {
                f32x4 x[4][2][2];
#pragma unroll
                for (int m = 0; m < 4; ++m)
#pragma unroll
                    for (int bj = 0; bj < 2; ++bj)
#pragma unroll
                        for (int n = 0; n < 2; ++n) x[m][bj][n] = *(const f32x4*)(srcf + rbase + (size_t)(m * 16) * D + bj * 128 + n * 4);
#pragma unroll
                for (int m = 0; m < 4; ++m)
#pragma unroll
                    for (int bj = 0; bj < 2; ++bj) { const f32x4 a = x[m][bj][0] + g[bj][0] * acc[ai][bj][m][0], b = x[m][bj][1] + g[bj][1] * acc[ai][bj][m][1];
                        u32x4 w; w.x = cvtpk(a.x, a.y); w.y = cvtpk(a.z, a.w); w.z = cvtpk(b.x, b.y); w.w = cvtpk(b.z, b.w);
                        *(u32x4*)(outb + rbase + (size_t)(m * 16) * D + bj * 128) = w; }
            } else {
                u32x4 x[4][2];
#pragma unroll
                for (int m = 0; m < 4; ++m)
#pragma unroll
                    for (int bj = 0; bj < 2; ++bj) x[m][bj] = *(const u32x4*)(srcb + rbase + (size_t)(m * 16) * D + bj * 128);
#pragma unroll
                for (int m = 0; m < 4; ++m)
#pragma unroll
                    for (int bj = 0; bj < 2; ++bj) { const u32x4 w = x[m][bj];
                        const f32x4 xa = (f32x4){bflo(w.x), bfhi(w.x), bflo(w.y), bfhi(w.y)}, xb = (f32x4){bflo(w.z), bfhi(w.z), bflo(w.w), bfhi(w.w)};
                        const f32x4 a = xa + g[bj][0] * acc[ai][bj][m][0], b = xb + g[bj][1] * acc[ai][bj][m][1];
                        u32x4 o; o.x = cvtpk(a.x, a.y); o.y = cvtpk(a.z, a.w); o.z = cvtpk(b.x, b.y); o.w = cvtpk(b.z, b.w);
                        *(u32x4*)(outb + rbase + (size_t)(m * 16) * D + bj * 128) = o; }
            }
        }
    }
};
struct EpiPart {
    static constexpr bool PERM = true;
    float* PART;
    __device__ __forceinline__ void operator()(const f32x4 (&acc)[2][2][4][2], const pg8::Unit& u, int wr, int wc, int fr, int fq) const {
        float* base = PART + ((size_t)u.sp * MS + wr * 64 + fr) * D + u.pn * 256 + wc * 32 + 8 * fq;
#pragma unroll
        for (int m = 0; m < 4; ++m)
#pragma unroll
            for (int bj = 0; bj < 2; ++bj)
#pragma unroll
                for (int n = 0; n < 2; ++n) *(f32x4*)(base + (size_t)(m * 16) * D + bj * 128 + n * 4) = acc[0][bj][m][n];
    }
};
template <int MODE>
__device__ __forceinline__ void skinny_reduce(Frame& F, const float* PART, const float* srcf, bf16* xb, int off_gt) {
    for (int it = F.bid * NTHR + F.tid; it < MS * D / 4; it += F.G * NTHR) {
        const int r = it >> 10, c = (it & 1023) * 4, row = MP + r;
        f32x4 p[16];
#pragma unroll
        for (int k = 0; k < 16; ++k) p[k] = *(const f32x4*)(PART + ((size_t)k * MS + r) * D + c);
        f32x4 x;
        if (MODE == 0) x = *(const f32x4*)(srcf + (size_t)r * D + c);
        else { const u32x2 w = *(const u32x2*)(xb + (size_t)row * D + c); x = (f32x4){bflo(w.x), bfhi(w.x), bflo(w.y), bfhi(w.y)}; }
        const f32x4 g = *(const f32x4*)(F.MOD + (size_t)row_batch(row) * NMOD + off_gt + c);
        f32x4 s = ((p[0] + p[1]) + (p[2] + p[3])) + ((p[4] + p[5]) + (p[6] + p[7]));
        s += ((p[8] + p[9]) + (p[10] + p[11])) + ((p[12] + p[13]) + (p[14] + p[15]));
        x += g * s;
        u32x2 o; o.x = cvtpk(x.x, x.y); o.y = cvtpk(x.z, x.w); *(u32x2*)(xb + (size_t)row * D + c) = o;
    }
}
template <int K, int MODE, bool BIMG, bool AIMG>
__device__ __forceinline__ void skinny_res(Frame& F, const bf16* A, const bf16* Bt, const float* srcf, const bf16* srcb, float* dstf, bf16* dstb, int off_gt) {
    const int lane = F.lane, wv = F.wave, fr = lane & 15, fq = lane >> 4;
    for (int nb = F.bid; nb < D / 16; nb += F.G) {
        const bf16* ap = A + (size_t)(MP + 16 * wv + fr) * K + 8 * fq;
        const int nrow = 16 * nb + fr;
        int sl = nrow & 127; { const int m = sl & 31; sl = (sl & ~31) + 16 * ((m >> 2) & 1) + 4 * (m >> 3) + (m & 3); }
        const unsigned char* bimg = (const unsigned char*)Bt + (size_t)(nrow >> 7) * (K / 64) * (size_t)pg8::HTB;
        const int oc0 = pg8::lds_byte(sl, 8 * fq), oc1 = pg8::lds_byte(sl, 32 + 8 * fq);
        const bf16* bp = Bt + (size_t)nrow * K + 8 * fq;
        const int arow = MP + 16 * wv + fr;
        const unsigned char* aimg = (const unsigned char*)A + (size_t)(arow >> 7) * (K / 64) * (size_t)pg8::HTB;
        const int ac0 = pg8::lds_byte(arow & 127, 8 * fq), ac1 = pg8::lds_byte(arow & 127, 32 + 8 * fq);
#define SK_ALOAD(kk, u) (AIMG ? *(const bf16x8*)(aimg + (size_t)(((kk) >> 6) + ((u) >> 1)) * pg8::HTB + (((u) & 1) ? ac1 : ac0)) : *(const bf16x8*)(ap + (kk) + 32 * (u)))
#define SK_BLOAD(kk, u) (BIMG ? *(const bf16x8*)(bimg + (size_t)(((kk) >> 6) + ((u) >> 1)) * pg8::HTB + (((u) & 1) ? oc1 : oc0)) : *(const bf16x8*)(bp + (kk) + 32 * (u)))
        f32x4 acc0 = (f32x4){0.f, 0.f, 0.f, 0.f}, acc1 = acc0;
        bf16x8 a[8], b[8], a2[8], b2[8];
#pragma unroll
        for (int u = 0; u < 8; ++u) { a[u] = SK_ALOAD(0, u); b[u] = SK_BLOAD(0, u); }
#pragma unroll 1
        for (int k = 0; k < K; k += 512) {
            const int k1 = k + 256 < K ? k + 256 : k, k2 = k + 512 < K ? k + 512 : k1;
#pragma unroll
            for (int u = 0; u < 8; ++u) { a2[u] = SK_ALOAD(k1, u); b2[u] = SK_BLOAD(k1, u); }
#pragma unroll
            for (int u = 0; u < 8; u += 2) { acc0 = __builtin_amdgcn_mfma_f32_16x16x32_bf16(b[u], a[u], acc0, 0, 0, 0); acc1 = __builtin_amdgcn_mfma_f32_16x16x32_bf16(b[u + 1], a[u + 1], acc1, 0, 0, 0); }
#pragma unroll
            for (int u = 0; u < 8; ++u) { a[u] = SK_ALOAD(k2, u); b[u] = SK_BLOAD(k2, u); }
            if (k + 256 < K) {
#pragma unroll
                for (int u = 0; u < 8; u += 2) { acc0 = __builtin_amdgcn_mfma_f32_16x16x32_bf16(b2[u], a2[u], acc0, 0, 0, 0); acc1 = __builtin_amdgcn_mfma_f32_16x16x32_bf16(b2[u + 1], a2[u + 1], acc1, 0, 0, 0); } }
        }
        const int row = MP + 16 * wv + fr, col = 16 * nb + 4 * fq;
        const f32x4 g = *(const f32x4*)(F.MOD + (size_t)row_batch(row) * NMOD + off_gt + col), r = g * (acc0 + acc1);
        if (MODE == 0) { const f32x4 x = *(const f32x4*)(srcf + (size_t)(row - MP) * D + col) + r; u32x2 w; w.x = cvtpk(x.x, x.y); w.y = cvtpk(x.z, x.w); *(u32x2*)(dstb + (size_t)row * D + col) = w; }
        else { const u32x2 w = *(const u32x2*)(srcb + (size_t)row * D + col); const f32x4 x = (f32x4){bflo(w.x), bfhi(w.x), bflo(w.y), bfhi(w.y)} + r;
            u32x2 o; o.x = cvtpk(x.x, x.y); o.y = cvtpk(x.z, x.w); *(u32x2*)(dstb + (size_t)row * D + col) = o; }
    }
}

struct EpiGU {
    static constexpr bool PERM = true;
    bf16* ACT;
    __device__ __forceinline__ void operator()(const f32x4 (&acc)[2][2][4][2], const pg8::Unit& u, int wr, int wc, int fr, int fq) const {
#pragma unroll
        for (int ai = 0; ai < 2; ++ai)
#pragma unroll
            for (int m = 0; m < 4; ++m) {
                const int row = u.pm * 256 + ai * 128 + wr * 64 + m * 16 + fr;
                const f32x4 g0 = acc[ai][0][m][0], g1 = acc[ai][0][m][1], u0 = acc[ai][1][m][0], u1 = acc[ai][1][m][1];
                float a[8];
#pragma unroll
                for (int x = 0; x < 4; ++x) { a[x] = g0[x] * sigmoidf_(g0[x]) * u0[x]; a[4 + x] = g1[x] * sigmoidf_(g1[x]) * u1[x]; }
                u32x4 w; w.x = cvtpk(a[0], a[1]); w.y = cvtpk(a[2], a[3]); w.z = cvtpk(a[4], a[5]); w.w = cvtpk(a[6], a[7]);
                *(u32x4*)((unsigned char*)ACT + pg8::img_off(row, u.pn * 128 + wc * 32 + 8 * fq, DFF / 64, false)) = w;
            }
    }
};
__device__ __forceinline__ void p10_final(Frame& F, const bf16* X2B) {
    const int gw = F.bid * NWAVES + F.wave, NGW = F.G * NWAVES;
    for (int row = gw; row < MREAL; row += NGW) {
        const GAS u32x2* xr = (const GAS u32x2*)(X2B + (size_t)row * D) + F.lane;
        GAS f32x4* yr = (GAS f32x4*)(F.out + (size_t)row * D) + F.lane;
        f32x4 v[16]; float s = 0.f;
#pragma unroll
        for (int j = 0; j < 16; ++j) { const u32x2 w = xr[64 * j]; v[j] = (f32x4){bflo(w.x), bfhi(w.x), bflo(w.y), bfhi(w.y)}; s += (v[j].x * v[j].x + v[j].y * v[j].y) + (v[j].z * v[j].z + v[j].w * v[j].w); }
        const float r = 1.0f / sqrtf(wave_sum(s) * (1.f / D) + NORM_EPS);
#pragma unroll
        for (int j = 0; j < 16; ++j) { const f32x4 gg = *(const f32x4*)(F.in[I_GF] + 256 * j + 4 * F.lane); yr[64 * j] = (v[j] * r) * gg; }
    }
}

#if DBG_CHECK
__device__ __forceinline__ unsigned hash32(unsigned x) { x ^= x >> 16; x *= 0x7feb352du; x ^= x >> 15; x *= 0x846ca68bu; x ^= x >> 16; return x; }
__device__ __forceinline__ void dbg_report(Frame& F, int k, float e) { if (!(e == e) || e > 1e30f) e = 1e30f; atomicMax((unsigned*)F.DBG + k, __float_as_uint(e)); }
__device__ __forceinline__ float relerr(float got, float ref, float floor_) { return fabsf(got - ref) / (fabsf(ref) + floor_); }
__device__ __forceinline__ int win_fwd(int c) {
    if (c < 12288) return c;
    if (c < 12304) return 25600 + (c - 12288);
    if (c < 16912) { const bool isq = c < 16400; const int r = c - (isq ? 12304 : 16400), hh = r >> 6, d = r & 63;
        const int t = (d & 31) >> 2, e = (d & 3) + 4 * (d >> 5); return (isq ? 12288 : 16384) + 64 * hh + 8 * t + e; }
    return c - 16;
}
__device__ __forceinline__ int win_fwd_w(int c) {
    if (c >= 8192 && c < 12288) { const int i = c - 8192, ct = i >> 7; return (ct < 16 ? 8192 + 256 * ct : 17408 + 256 * (ct - 16)) + (i & 127); }
    if (c >= 17424 && c < 21520) { const int i = c - 17424, ct = i >> 7; return (ct < 16 ? 8192 + 256 * ct : 17408 + 256 * (ct - 16)) + 128 + (i & 127); }
    return win_fwd(c);
}
__device__ __forceinline__ int wgu_fwd(int c) { if (c < DFF) return 256 * (c >> 7) + (c & 127); const int c2 = c - DFF; return 256 * (c2 >> 7) + 128 + (c2 & 127); }
__device__ __forceinline__ float silu_ref(float x) { return x / (1.f + expf(-x)); }
__device__ __forceinline__ float cvec(const Frame& F, int b, int k) { return b < 2 ? F.in[I_CP][b * D + k] : F.in[I_CS][(b - 2) * D + k]; }
__device__ __forceinline__ float bfround(float x) { return bflo(cvtpk(x, 0.f)); }
__device__ __forceinline__ float dbg_h(const Frame& F, int row, int k) { return bf2f(*(const bf16*)((const unsigned char*)F.H + pg8::img_off(row, k & ~7, D / 64, false) + 2 * (k & 7))); }

__device__ __forceinline__ void dbg_check_p0p1(Frame& F) {
    const int gt = F.bid * NTHR + F.tid;
    if (gt < 512) {
        const unsigned h = hash32(gt * 7919u + 13u); const int b = gt % 10, col = (int)(h % NMOD);
        float s = 0.f; for (int k = 0; k < D; ++k) s += silu_ref(cvec(F, b, k)) * F.in[I_WADA][(size_t)k * NMOD + col];
        s += F.in[I_BADA][col];
        dbg_report(F, 0, relerr(F.MOD[b * NMOD + col], s, 0.05f));
    } else if (gt < 1024) {
        const unsigned h = hash32(gt * 31u + 5u); const int pos = (int)(h % 8192u), f = (int)((h >> 16) % 32u);
        const double inv = pow(10000.0, -(double)f / 32.0), a = (double)pos * inv;
        dbg_report(F, 1, fmaxf(fabsf(F.ROPEC[pos * 32 + f] - (float)cos(a)), fabsf(F.ROPES[pos * 32 + f] - (float)sin(a))) * 0.2f);
    } else if (gt < 1024 + 4096) {
        const int i = gt - 1024; const unsigned h = hash32(i * 2654435761u + 77u), h2 = hash32(h + 12345u);
        const int which = 0; float ref, got;
        if (which == 0) { const int k = (int)(h % D), c = (int)(h2 % N_IN); ref = bfround(F.in[I_WIN][(size_t)k * N_IN + c]); got = bf2f(*(const bf16*)((const unsigned char*)F.WIN + pg8::img_off(win_fwd_w(c), k & ~7, D / 64, true) + 2 * (k & 7))); }
        else if (which == 1) { const int k = (int)(h % D), c = (int)(h2 % D); ref = bfround(F.in[I_WOUT][(size_t)k * D + c]); got = bf2f(*(const bf16*)((const unsigned char*)F.WOUT + pg8::img_off(c, k & ~7, D / 64, true) + 2 * (k & 7))); }
        else if (which == 2) { const int k = (int)(h % D), c = (int)(h2 % N_GU); ref = bfround(F.in[I_WGU][(size_t)k * N_GU + c]); got = bf2f(*(const bf16*)((const unsigned char*)F.WGU + pg8::img_off(wgu_fwd(c), k & ~7, D / 64, true) + 2 * (k & 7))); }
        else { const int k = (int)(h % DFF), c = (int)(h2 % D); ref = bfround(F.in[I_WDN][(size_t)k * D + c]); got = bf2f(*(const bf16*)((const unsigned char*)F.WDN + pg8::img_off(c, k & ~7, DFF / 64, true) + 2 * (k & 7))); }
        dbg_report(F, 2, fabsf(got - ref) * 100.f);
        if (i < 240) { const int k = (int)(h % D); dbg_report(F, 2, fabsf(bf2f(*(const bf16*)((const unsigned char*)F.WIN + pg8::img_off(25616 + i, k & ~7, D / 64, true) + 2 * (k & 7)))) * 100.f); }
    } else if (gt < 1024 + 4096 + 96) {
        const int i = gt - 5120; const unsigned h = hash32(i * 977u + 3u);
        const int row = i < 64 ? (int)(h % MP) : (i < 88 ? MP + (int)(h % MS) : MREAL + (int)(h % 128u));
        if (row >= MREAL) { float m = 0.f; for (int c = 0; c < D; ++c) m = fmaxf(m, fabsf(dbg_h(F, row, c))); dbg_report(F, 3, m); }
        else { const float* x = x_row(F, row); float s = 0.f; for (int c = 0; c < D; ++c) s += x[c] * x[c];
            const float r = 1.f / sqrtf(s / D + NORM_EPS); const float* mod = F.MOD + row_batch(row) * NMOD; float e = 0.f;
            for (int c = 0; c < D; ++c) { const float y = x[c] * r * F.in[I_G1][c] * (1.f + mod[D + c]) + mod[c]; e = fmaxf(e, relerr(dbg_h(F, row, c), y, 0.2f)); }
            dbg_report(F, 3, e); }
    }
}
__device__ __forceinline__ float dbg_dot_h_win(Frame& F, int row, int c) { float s = 0.f; const float* w = F.in[I_WIN] + c; for (int k = 0; k < D; ++k) s += dbg_h(F, row, k) * w[(size_t)k * N_IN]; return s; }
__device__ __forceinline__ void dbg_check_p2(Frame& F) {
    const int gt = F.bid * NTHR + F.tid;
    if (gt >= 2048) return;
    const unsigned h = hash32(gt * 2246822519u + 99u), h2 = hash32(h ^ 0x9e3779b9u);
    int row = (gt & 7) == 7 ? MP + (int)(h % MS) : (int)(h % MP);
    int c;
    const int cls = gt % 5;
    if (cls == 0) c = (int)(h2 % N_IN); else if (cls == 1) c = O_QB + (int)(h2 % 4096u); else if (cls == 2) c = O_KB + (int)(h2 % 512u); else if (cls == 3) c = O_VB + (int)(h2 % 512u); else c = O_RA + (int)(h2 % 16u);
    if (gt >= 1024) {
        if (cls != 2 && cls != 3) return;
        if (gt & 8) { const int b = (h >> 3) & 1, tt = 8064 + (int)((h >> 8) % 128u); row = b * 8192 + tt; } else row = MP + (int)(h % MS);
    }
    const bool isq = c >= O_QB && c < O_KB, isk = c >= O_KB && c < O_VB, isv = c >= O_VB && c < O_VB + 512;
    float ref;
    if (isq || isk) { const int base = isq ? O_QB : O_KB, r = c - base, hh = r >> 6, d = r & 63, dl = d & 31;
        const float x1 = dbg_dot_h_win(F, row, base + 64 * hh + dl), x2 = dbg_dot_h_win(F, row, base + 64 * hh + dl + 32);
        const double inv = pow(10000.0, -(double)dl / 32.0), a = (double)row_pos(row) * inv; const float cs = (float)cos(a), sn = (float)sin(a);
        ref = d < 32 ? x1 * cs - x2 * sn : x2 * cs + x1 * sn; }
    else ref = dbg_dot_h_win(F, row, c);
    if (gt < 1024) {
        int pc = win_fwd(c);
        if ((c >= 8192 && c < 12288) || (c >= 17424 && c < 21520)) { const int i = c >= 17424 ? c - 17424 : c - 8192; const float gv = dbg_dot_h_win(F, row, 8192 + i), zv = dbg_dot_h_win(F, row, 17424 + i);
            ref = silu_ref(gv) / (1.f + expf(-zv)); pc = C_GA + i; }
        else if (c >= 21520) ref = 1.f / (1.f + expf(-ref));
        const float got = bf2f(F.PROJ[pj(row, pc)]); dbg_report(F, 4, relerr(got, isq ? ref * QSCALE : ref, 1.0f)); }
    else { const int r = c - (isk ? O_KB : O_VB), g = r >> 6, d = r & 63; long o;
        if (row < MP) o = (isk ? OUT_KP : OUT_VP) + ((long)(((row >> 13) * 128 + ((row & 8191) - 8064)) * 8 + g)) * 64 + d;
        else { const int r2 = row - MP; o = (isk ? OUT_KS : OUT_VS) + ((long)(((r2 >> 4) * 16 + (r2 & 15)) * 8 + g)) * 64 + d; }
        dbg_report(F, 5, relerr(F.out[o], ref, 1.0f)); }
}
__device__ __forceinline__ float logsig_ref(float x) { return x < 0.f ? x - log1pf(expf(x)) : -log1pf(expf(-x)); }
__device__ __forceinline__ float dbg_bcum(Frame& F, int row0, int ntok, int hd, int d, int upto) {
    float bc = 0.f; const float bias = F.in[I_BGK][hd * 512 + d];
    for (int t = 0; t <= upto && t < ntok; ++t) { float gk = bias; const bf16* ra = F.PROJ + pj(row0 + t, C_RA);
        for (int r = 0; r < 16; ++r) gk += bf2f(ra[r]) * F.in[I_WGK][r * 2048 + hd * 512 + d];
        bc += logsig_ref(gk) * (1.f / 16.f); }
    return bc;
}
__device__ __forceinline__ float dbg_qfrag(Frame& F, int cid, int hd, int i, int d) { const int w = d >> 6, dl = d & 63, dt = dl >> 5, r32 = dl & 31, s = r32 >> 4, r16 = r32 & 15, h = (r16 >> 2) & 1, jj = (r16 & 3) + 4 * (r16 >> 3);
    const int mt = i >> 5, ln = (i & 31) + 32 * h, fb = ((w * 2 + mt) * 2 + dt) * 2 + s; return bf2f(((const bf16*)(F.ws + WS_FRAG + (size_t)(cid * 4 + hd) * 131072))[fb * 512 + ln * 8 + jj]); }
__device__ __forceinline__ float dbg_kfrag(Frame& F, int cid, int hd, int j, int d) { const int w = d >> 6, dt = (d >> 5) & 1, dl = d & 31, sp = j >> 4, h = (j >> 3) & 1, jj = j & 7;
    const int ln = dl + 32 * h, fb = (w * 2 + dt) * 4 + sp; return bf2f(((const bf16*)(F.ws + WS_FRAG + (size_t)(cid * 4 + hd) * 131072 + 65536))[fb * 512 + ln * 8 + jj]); }
__device__ __forceinline__ float dbg_afrag(Frame& F, int cid, int hd, int i, int j) { const int it = i >> 5, jt = j >> 5, jl = j & 31, s = jl >> 4, r16 = jl & 15, h = (r16 >> 2) & 1, jj = (r16 & 3) + 4 * (r16 >> 3);
    const int blk = it + 2 * (2 * jt + s), ln = (i & 31) + 32 * h; return bf2f(((const bf16*)(F.ws + WS_AMAT + (size_t)(cid * 4 + hd) * 8192))[blk * 512 + ln * 8 + jj]); }
__device__ __forceinline__ void dbg_check_cl(Frame& F) {
    const int gt = F.bid * NTHR + F.tid;
    if (gt >= 2048) return;
    const unsigned hs = hash32(gt * 40503u + 17u), h2 = hash32(hs + 0x51ed27u);
    const int cid = (gt & 7) == 7 ? 256 + (int)(hs % 8u) : (int)(hs % 256u), hd = (int)((hs >> 8) & 3u);
    const int ntok = cid < 256 ? 64 : 16, row0 = cid < 256 ? cid * 64 : MP + 16 * (cid - 256), mid = ntok >> 1;
    const int i = (int)((hs >> 10) % (unsigned)ntok), j = (int)((h2) % (unsigned)ntok), d = (int)((h2 >> 8) % 512u);
    if (gt >= 256) {
        const float bi = dbg_bcum(F, row0, ntok, hd, d, i), bj = dbg_bcum(F, row0, ntok, hd, d, j), bm = dbg_bcum(F, row0, ntok, hd, d, mid), bl = dbg_bcum(F, row0, ntok, hd, d, 63);
        const float q = bf2f(F.PROJ[pj(row0 + i, C_QA + hd * 512 + d)]), k = bf2f(F.PROJ[pj(row0 + j, C_KA + hd * 512 + d)]);
        dbg_report(F, 6, relerr(dbg_qfrag(F, cid, hd, i, d), q * GLA_QSCALE * expf(bi - bm), 0.02f));
        dbg_report(F, 6, relerr(dbg_kfrag(F, cid, hd, j, d), k * expf(bm - bj), 0.3f));
        const float* VEC = (const float*)(F.ws + WS_VEC) + (size_t)(cid * 4 + hd) * 1024;
        dbg_report(F, 6, relerr(VEC[d], expf(bm), 0.01f)); dbg_report(F, 6, relerr(VEC[512 + d], expf(bl - bm), 0.01f));
        if (cid >= 256) { dbg_report(F, 6, fabsf(dbg_qfrag(F, cid, hd, 16 + (i % 48), d))); dbg_report(F, 6, fabsf(dbg_kfrag(F, cid, hd, 16 + (j % 48), d))); }
    } else {
        float s = 0.f;
        for (int dd = 0; dd < 512; ++dd) { float bi = 0.f, bj = 0.f, bm = 0.f, bc = 0.f; const float bias = F.in[I_BGK][hd * 512 + dd];
            for (int t = 0; t < ntok; ++t) { float gk = bias; const bf16* ra = F.PROJ + pj(row0 + t, C_RA);
                for (int r = 0; r < 16; ++r) gk += bf2f(ra[r]) * F.in[I_WGK][r * 2048 + hd * 512 + dd];
                bc += logsig_ref(gk) * (1.f / 16.f); if (t == i) bi = bc; if (t == j) bj = bc; if (t == mid) bm = bc; }
            const float q = bf2f(F.PROJ[pj(row0 + i, C_QA + hd * 512 + dd)]), k = bf2f(F.PROJ[pj(row0 + j, C_KA + hd * 512 + dd)]);
            s += bfround(q * GLA_QSCALE * expf(bi - bm)) * bfround(k * expf(bm - bj)); }
        if (j > i) s = 0.f;
        dbg_report(F, 6, relerr(dbg_afrag(F, cid, hd, i, j), s, 0.1f));
    }
}
__device__ __forceinline__ void dbg_check_swa(Frame& F) {
    LAS float* part = (LAS float*)F.lds;
    LAS float* qh = part + 512;
    LAS float* lg = qh + 64;
    LAS float* sm = lg + 192;
    const int tid = F.tid; const unsigned hs = hash32(F.bid * 7349u + 1234567u);
    const bool smp = (F.bid & 3) == 3;
    int row, b, tt;
    if (!smp) { b = hs & 1; tt = (F.bid & 7) == 0 ? (int)((hs >> 4) % 128u) : (int)((hs >> 4) % 8192u); row = b * SEQ + tt; } else { b = (hs >> 1) & 7; tt = (hs >> 4) & 15; row = MP + 16 * b + tt; }
    const int head = (int)((hs >> 20) & 63u), g = head >> 3;
    { const int d = tid >> 3, pt = tid & 7; float s = 0.f; const float* w = F.in[I_WIN] + O_QB + head * 64 + d;
      for (int k = 512 * pt; k < 512 * pt + 512; ++k) s += dbg_h(F, row, k) * w[(size_t)k * N_IN];
      part[d * 8 + pt] = s; }
    __syncthreads();
    float xq = 0.f; if (tid < 64) { for (int p = 0; p < 8; ++p) xq += part[tid * 8 + p]; }
    __syncthreads();
    if (tid < 64) part[tid] = xq;
    __syncthreads();
    if (tid < 64) { const int dl = tid & 31; const double inv = pow(10000.0, -(double)dl / 32.0), a = (double)row_pos(row) * inv; const float cs = (float)cos(a), sn = (float)sin(a);
        const float x1 = part[dl], x2 = part[dl + 32]; qh[tid] = (tid < 32 ? x1 * cs - x2 * sn : x2 * cs + x1 * sn) * QSCALE; }
    __syncthreads();
    int nk, kr0 = 0;
    if (!smp) { const int n = tt >> 6; nk = 64 * (n + 1 < 3 ? n + 1 : 3); kr0 = b * SEQ + 64 * (n > 2 ? n - 2 : 0); } else nk = 144;
    if (tid < nk) { float s = 0.f;
        for (int d = 0; d < 64; ++d) { float kv;
            if (smp && tid < 128) kv = bfround(F.in[I_CK][((size_t)(b * 128 + tid) * 8 + g) * 64 + d]);
            else { const int krow = smp ? MP + 16 * b + (tid - 128) : kr0 + tid; const int p = 8 * ((d & 31) >> 2) + (d & 3) + 4 * (d >> 5); kv = bf2f(F.PROJ[pj(krow, C_KB + g * 64 + p)]); }
            s += qh[d] * kv; }
        lg[tid] = s; }
    __syncthreads();
    if (tid == 0) { const float sk = F.in[I_SINK][head] * LOG2E; float m = sk; for (int k = 0; k < nk; ++k) m = fmaxf(m, lg[k]); float su = exp2f(sk - m); for (int k = 0; k < nk; ++k) su += exp2f(lg[k] - m); sm[0] = m; sm[1] = su; }
    __syncthreads();
    if (tid < 64) { float o = 0.f; const float m = sm[0];
        for (int k = 0; k < nk; ++k) { float vv;
            if (smp && k < 128) vv = bfround(F.in[I_CV][((size_t)(b * 128 + k) * 8 + g) * 64 + tid]);
            else { const int krow = smp ? MP + 16 * b + (k - 128) : kr0 + k; vv = bf2f(F.PROJ[pj(krow, C_VB + g * 64 + tid)]); }
            o += exp2f(lg[k] - m) * vv; }
        o /= sm[1];
        dbg_report(F, 7, relerr(bf2f(F.PROJ[pj(row, C_QB + head * 64 + tid)]), o, 0.3f)); }
    __syncthreads();
}
constexpr size_t WS_DBGV = 1596 * MiB;
__device__ __forceinline__ void dbg_check_scan(Frame& F) {
    LAS float* red = (LAS float*)F.lds;
    const int tid = F.tid; const unsigned hs = hash32(F.bid * 92821u + 777u);
    const bool smp = (F.bid & 1) == 1;
    const int b = smp ? (int)((hs >> 2) & 7u) : (int)((hs >> 2) & 1u), hd = (int)((hs >> 6) & 3u), e = (int)((hs >> 8) & 1023u);
    const int T = smp ? 16 : SEQ, row00 = smp ? MP + 16 * b : b * SEQ;
    float* vcol = (float*)(F.ws + WS_DBGV) + (size_t)F.bid * SEQ;
    for (int t = tid; t < T; t += NTHR) { float s = 0.f; const float* w = F.in[I_WIN] + C_VA + hd * 1024 + e;
        for (int k = 0; k < D; ++k) s += dbg_h(F, row00 + t, k) * w[(size_t)k * N_IN];
        vcol[t] = s; }
    __syncthreads();
    const int d = tid; float wg[16];
#pragma unroll
    for (int r = 0; r < 16; ++r) wg[r] = F.in[I_WGK][r * 2048 + hd * 512 + d];
    const float bias = F.in[I_BGK][hd * 512 + d];
    float S = smp ? F.in[I_SG][((size_t)(b * 4 + hd) * 512 + d) * 1024 + e] : 0.f;
    for (int t = 0; t < T; ++t) {
        const int row = row00 + t;
        const u32x4 ra0 = *(const u32x4*)(F.PROJ + pj(row, C_RA)), ra1 = *(const u32x4*)(F.PROJ + pj(row, C_RA) + 8);
        float gk = bias + bflo(ra0.x) * wg[0] + bfhi(ra0.x) * wg[1] + bflo(ra0.y) * wg[2] + bfhi(ra0.y) * wg[3] + bflo(ra0.z) * wg[4] + bfhi(ra0.z) * wg[5] + bflo(ra0.w) * wg[6] + bfhi(ra0.w) * wg[7]
                 + bflo(ra1.x) * wg[8] + bfhi(ra1.x) * wg[9] + bflo(ra1.y) * wg[10] + bfhi(ra1.y) * wg[11] + bflo(ra1.z) * wg[12] + bfhi(ra1.z) * wg[13] + bflo(ra1.w) * wg[14] + bfhi(ra1.w) * wg[15];
        const float a = expf(logsig_ref(gk) * (1.f / 16.f));
        S = a * S + bf2f(F.PROJ[pj(row, C_KA + hd * 512 + d)]) * vcol[t];
        const bool chk = smp || t < 2 || t == 31 || t == 63 || t == 64 || t == 65 || t == 127 || t == 128 || t == 1000 || t == 4095 || t == 8191;
        if (chk) { red[tid] = bf2f(F.PROJ[pj(row, C_QA + hd * 512 + d)]) * GLA_QSCALE * S; __syncthreads();
            if (tid == 0) { float o = 0.f; for (int x = 0; x < 512; ++x) o += red[x]; const float got = bf2f(F.PROJ[pj(row, C_VA + hd * 1024 + e)]); dbg_report(F, 8, relerr(got, o, 5.0f)); atomicAdd(F.DBG + 32, (got - o) * (got - o)); atomicAdd(F.DBG + 33, o * o); }
            __syncthreads(); }
    }
    { const float got = F.out[(smp ? OUT_SGS : OUT_SGP) + ((size_t)(b * 4 + hd) * 512 + d) * 1024 + e]; dbg_report(F, 8, relerr(got, S, 5.0f));
      const float se = wave_sum((got - S) * (got - S)), sr = wave_sum(S * S); if (F.lane == 0) { atomicAdd(F.DBG + 34, se); atomicAdd(F.DBG + 35, sr); } }
}

constexpr int DBG_NCHECK = 11;
__device__ __forceinline__ void dbg_final(Frame& F) {
    if (F.bid != 0 || F.tid != 0) return;
    const float tol[DBG_NCHECK] = {2e-3f, 1e-3f, 1e-3f, 1e-2f, 3e-2f, 3e-2f, 2e-2f, 3e-2f, 3e-2f, 1e-2f, 1e-2f};
    for (int k = 0; k < DBG_NCHECK; ++k) { float e = __uint_as_float(__hip_atomic_load((unsigned*)F.DBG + k, RLX_AGENT));
        if (k == 9) e = sqrtf(F.DBG[32] / F.DBG[33]); if (k == 10) e = sqrtf(F.DBG[34] / F.DBG[35]);
        if (!(e <= tol[k])) { const int m = e >= 1.f ? 9 : e >= 0.3f ? 8 : e >= 0.1f ? 7 : e >= 0.03f ? 6 : e >= 0.01f ? 5 : e >= 0.003f ? 4 : e >= 0.001f ? 3 : e >= 3e-4f ? 2 : 1;
            float x = (1.f + 0.1f * m) * 1e4f; for (int j = 0; j < k; ++j) x *= 10.f; F.out[0] = x; return; } }
}
#endif

#define PHASE_BEGIN() do { int t_ = threadIdx.x; asm volatile("" : "+v"(t_)); F.tid = t_; F.lane = t_ & 63; F.wave = __builtin_amdgcn_readfirstlane(t_ >> 6); } while (0)
__global__ void __launch_bounds__(NTHR, 2) mega_fwd(Args args) {
    extern __shared__ __attribute__((aligned(16))) unsigned char lds[];
    Frame F;
    F.lds = (LAS unsigned char*)lds;
    F.MISC = (volatile LAS unsigned*)(F.lds + MISC_OFF);
    F.tid = threadIdx.x; F.lane = F.tid & 63; F.wave = __builtin_amdgcn_readfirstlane(F.tid >> 6);
    F.G = gridDim.x; F.bid = blockIdx.x;
    unsigned char* ws = args.ws; F.ws = ws; F.out = args.out;
#pragma unroll
    for (int i = 0; i < 20; ++i) F.in[i] = args.in[i];
    F.ctl = (gu32*)(ws + WS_CTL);
    F.MOD = (float*)(ws + WS_MOD); F.ROPEC = (float*)(ws + WS_ROPE); F.ROPES = (float*)(ws + WS_ROPE + MiB); F.SC = (float*)(ws + WS_SC); F.DBG = (float*)(ws + WS_DBG);
    F.WIN = (bf16*)(ws + WS_WIN); F.WOUT = (bf16*)(ws + WS_WOUT); F.WGU = (bf16*)(ws + WS_WGU); F.WDN = (bf16*)(ws + WS_WDN); F.H = (bf16*)(ws + WS_H); F.PROJ = (bf16*)(ws + WS_PROJ);
    for (int u = F.tid; u < 64; u += NTHR) ((LAS unsigned*)(F.lds + MISC_OFF))[u] = 0u;
    __syncthreads();
    XcdBarrier bar = xcd_barrier_post((unsigned*)(F.ctl + CW_BAR), F.MISC + 8);
    const int gtid = F.bid * NTHR + F.tid;

#if DBG_CHECK
    if (gtid < 64) F.DBG[gtid] = 0.f;
    xcd_barrier(bar);
#endif
    PHASE_BEGIN();
    p0_phase(F, CW_Q0);
#if PROBE_TWICE == 100
    xcd_barrier(bar); p0_phase(F, CW_Q0 + 64);
#endif
    xcd_barrier(bar);
    PHASE_BEGIN();
    norm_mod_rows<false>(F, F.in[I_XP], F.in[I_XS], nullptr, F.in[I_G1], 0, D, F.H);
#if PROBE_TWICE == 101
    xcd_barrier(bar); norm_mod_rows<false>(F, F.in[I_XP], F.in[I_XS], nullptr, F.in[I_G1], 0, D, F.H);
#endif
    xcd_barrier(bar);
#if DBG_CHECK
    dbg_check_p0p1(F);
#endif
    PHASE_BEGIN();
    { pg8::Gemm g{F.H, F.WIN, MPAD, NP_IN, D}; pg8::StaticOrder S; S.init(MPAD, NP_IN, F.G, F.bid);
      EpiIn E{F.PROJ, F.ROPEC, F.ROPES, F.out};
#if PROBE_TWICE == 110
      S.force0 = 1; pg8::gemm_phase<EpiIn, true, true>(F.lds, g, S, E); S.force0 = 0; xcd_barrier(bar);
#endif
      pg8::gemm_phase<EpiIn, true, true>(F.lds, g, S, E);
      drain_weights<0>(F);
#if PROBE_TWICE == 102
      xcd_barrier(bar); pg8::gemm_phase<EpiIn, true, true>(F.lds, g, S, E);
#endif
    }
    xcd_barrier(bar);
#if DBG_CHECK
    dbg_check_p2(F);
    xcd_barrier(bar);
#endif
    PHASE_BEGIN();
    p3_phase(F);
    xcd_barrier(bar);
#if DBG_CHECK
    dbg_check_cl(F);
    dbg_check_swa(F);
    xcd_barrier(bar);
#endif
    PHASE_BEGIN();
    p4_phase(F);
    xcd_barrier(bar);
#if DBG_CHECK
    dbg_check_scan(F);
    xcd_barrier(bar);
#endif
    PHASE_BEGIN();
    p5_merge(F);
#if PROBE_TWICE == 105
    xcd_barrier(bar); p5_merge(F);
#endif
    xcd_barrier(bar);
    PHASE_BEGIN();
    bf16* const X1B = (bf16*)(F.ws + WS_FRAG);
    { pg8::Gemm g{F.H, F.WOUT, MP, D, D}; pg8::StaticOrder S; S.init(MP, D, F.G, F.bid);
      EpiRes<0> E{F.in[I_XP], nullptr, nullptr, X1B, F.MOD, 2 * D};
      pg8::gemm_phase<EpiRes<0>, true, true>(F.lds, g, S, E); }
    { pg8::Gemm g{F.H, F.WOUT, MPAD, D, D}; pg8::SplitOrder S{F.G, F.bid, MP / 256, D / 128};
      EpiPart E{(float*)F.PROJ};
      pg8::gemm_phase<EpiPart, true, true, pg8::SplitOrder, true>(F.lds, g, S, E); }
    xcd_barrier(bar);
    PHASE_BEGIN();
    skinny_reduce<0>(F, (const float*)F.PROJ, F.in[I_XS], X1B, 2 * D);
    xcd_barrier(bar);
    PHASE_BEGIN();
    norm_mod_rows<true>(F, nullptr, nullptr, X1B, F.in[I_G2], 3 * D, 4 * D, F.H);
#if PROBE_TWICE == 101
    xcd_barrier(bar); norm_mod_rows<true>(F, nullptr, nullptr, X1B, F.in[I_G2], 3 * D, 4 * D, F.H);
#endif
    xcd_barrier(bar);
    PHASE_BEGIN();
    { pg8::Gemm g{F.H, F.WGU, MPAD, N_GU, D}; pg8::StaticOrder S; S.init(MPAD, N_GU, F.G, F.bid);
      EpiGU E{F.PROJ};
      pg8::gemm_phase<EpiGU, true, true>(F.lds, g, S, E);
      drain_weights<1>(F); }
    xcd_barrier(bar);
    PHASE_BEGIN();
    { pg8::Gemm g{F.PROJ, F.WDN, MP, D, DFF}; pg8::StaticOrder S; S.init(MP, D, F.G, F.bid); S.fatk = 1;
      EpiRes<1> E{nullptr, X1B, nullptr, X1B, F.MOD, 5 * D};
      pg8::gemm_phase<EpiRes<1>, true, true>(F.lds, g, S, E); }
    { pg8::Gemm g{F.PROJ, F.WDN, MPAD, D, DFF}; pg8::SplitOrder S{F.G, F.bid, MP / 256, DFF / 128};
      EpiPart E{(float*)F.H};
      pg8::gemm_phase<EpiPart, true, true, pg8::SplitOrder, true>(F.lds, g, S, E); }
    xcd_barrier(bar);
    PHASE_BEGIN();
    skinny_reduce<1>(F, (const float*)F.H, nullptr, X1B, 5 * D);
    xcd_barrier(bar);
    PHASE_BEGIN();
    p10_final(F, X1B);
#if DBG_CHECK
    xcd_barrier(bar);
    dbg_final(F);
#endif
}

extern "C" void kernel_launch(void* const* d_in, const int* in_sizes, int n_in, void* d_out, int out_size, void* d_ws, size_t ws_size, hipStream_t stream) {
    static int grid = 0;
    if (grid == 0) {
        int dev = 0, cus = 0, per_cu = 0;
        if (n_in != 20 || out_size != (int)OUT_TOTAL || ws_size < WS_END + 32 * MiB) { fprintf(stderr, "kernel_launch: unexpected sizes n_in %d out %d ws %zu (need %zu); nothing launched\n", n_in, out_size, ws_size, (size_t)WS_END); grid = -1; return; }
        if (hipGetDevice(&dev) != hipSuccess || hipDeviceGetAttribute(&cus, hipDeviceAttributeMultiprocessorCount, dev) != hipSuccess) { fprintf(stderr, "kernel_launch: device query failed\n"); grid = -1; return; }
        if (hipFuncSetAttribute((const void*)mega_fwd, hipFuncAttributeMaxDynamicSharedMemorySize, LDS_BYTES) != hipSuccess) { fprintf(stderr, "kernel_launch: hipFuncSetAttribute failed\n"); grid = -1; return; }
        if (hipOccupancyMaxActiveBlocksPerMultiprocessor(&per_cu, (const void*)mega_fwd, NTHR, LDS_BYTES) != hipSuccess || per_cu < 1)
            fprintf(stderr, "kernel_launch: occupancy query reports %d blocks per CU\n", per_cu);
        (void)hipGetLastError();
        grid = cus;
    }
    if (grid < 0) return;
    if (hipMemsetAsync((char*)d_ws + WS_CTL, 0, CTL_ZERO_BYTES, stream) != hipSuccess) { fprintf(stderr, "kernel_launch: memset failed\n"); return; }
    Args a{};
    for (int i = 0; i < 20; ++i) a.in[i] = (const float*)d_in[i];
    a.out = (float*)d_out; a.ws = (unsigned char*)d_ws;
    hipLaunchKernelGGL(mega_fwd, dim3(grid), dim3(NTHR), LDS_BYTES, stream, a);
}
```

```cpp
#include <hip/hip_runtime.h>
#include <cstdio>

#ifndef DBG_CHECK
#define DBG_CHECK 0
#endif
#ifndef PROBE_TWICE
#define PROBE_TWICE 0
#endif
#ifndef ZERO_FILL
#define ZERO_FILL 0
#endif

#define LAS __attribute__((address_space(3)))
#define GAS __attribute__((address_space(1)))
typedef GAS unsigned gu32;
typedef unsigned short bf16;
typedef short bf16x8 __attribute__((ext_vector_type(8)));
typedef float f32x2 __attribute__((ext_vector_type(2)));
typedef float f32x4 __attribute__((ext_vector_type(4)));
typedef float f32x16 __attribute__((ext_vector_type(16)));
typedef unsigned u32x2 __attribute__((ext_vector_type(2)));
typedef unsigned u32x4 __attribute__((ext_vector_type(4)));
typedef __bf16 bf16x2_t __attribute__((ext_vector_type(2)));
#define RLX_AGENT __ATOMIC_RELAXED, __HIP_MEMORY_SCOPE_AGENT
#define LDS_WAIT() asm volatile("s_waitcnt lgkmcnt(0)" ::: "memory")
#define VM_WAIT() asm volatile("s_waitcnt vmcnt(0)" ::: "memory")

__device__ __forceinline__ unsigned cvtpk(float lo, float hi) { f32x2 v = {lo, hi}; bf16x2_t b = __builtin_convertvector(v, bf16x2_t); return __builtin_bit_cast(unsigned, b); }
__device__ __forceinline__ float bf2f(unsigned short b) { return __uint_as_float(((unsigned)b) << 16); }
__device__ __forceinline__ float bflo(unsigned w) { return __uint_as_float(w << 16); }
__device__ __forceinline__ float bfhi(unsigned w) { return __uint_as_float(w & 0xffff0000u); }
__device__ __forceinline__ float wave_sum(float v) {
#pragma unroll
    for (int o = 1; o < 64; o <<= 1) v += __shfl_xor(v, o);
    return v;
}

constexpr int NWAVES = 8, NTHR = 512;
constexpr int D = 4096, SEQ = 8192, MP = 16384, MS = 128, MREAL = 16512, MPAD = 16640;
constexpr int N_IN = 25616, NP_IN = 25856, DFF = 11008, N_GU = 22016, NMOD = 24576;
constexpr int C_QA = 0, C_KA = 2048, C_VA = 4096, C_GA = 8192, C_QB = 12288, C_KB = 16384, C_VB = 16896, C_ZA = 17408, C_ZB = 21504, C_RA = 25600;
constexpr int O_RA = 12288, O_QB = 12304, O_KB = 16400, O_VB = 16912;
constexpr float NORM_EPS = 1e-6f;
__host__ __device__ __forceinline__ size_t pj(int row, int col) { return ((size_t)((row >> 8) * 101 + (col >> 8)) << 16) + (size_t)(((row & 255) << 8) + (col & 255)); }
constexpr float QSCALE = 0.125f * 1.4426950408889634f;
constexpr long OUT_YP = 0, OUT_YS = 67108864L, OUT_SGP = 67633152L, OUT_KP = 71827456L, OUT_VP = 71958528L, OUT_SGS = 72089600L, OUT_KS = 88866816L, OUT_VS = 88932352L, OUT_TOTAL = 88997888L;

constexpr size_t MiB = 1u << 20;
constexpr size_t WS_CTL = 0, CTL_ZERO_BYTES = 2 * MiB;
constexpr size_t WS_MOD = 1 * MiB, WS_ROPE = 2 * MiB, WS_VEC = 4 * MiB, WS_AMAT = 9 * MiB, WS_SC = 18 * MiB, WS_DBG = 19 * MiB;
constexpr size_t WS_WIN = 20 * MiB, WS_WOUT = 222 * MiB, WS_WGU = 254 * MiB, WS_WDN = 426 * MiB, WS_H = 512 * MiB, WS_PROJ = 642 * MiB, WS_FRAG = 1463 * MiB, WS_END = 1595 * MiB;
static_assert(WS_WIN + (size_t)NP_IN * D * 2 <= WS_WOUT && WS_WGU + (size_t)N_GU * D * 2 <= WS_WDN && WS_WDN + (size_t)D * DFF * 2 <= WS_H, "ws map");
static_assert(WS_H + (size_t)MPAD * D * 2 <= WS_PROJ && WS_PROJ + (size_t)MPAD * NP_IN * 2 <= WS_FRAG && WS_FRAG + (size_t)264 * 4 * 131072 <= WS_END, "ws map");
constexpr int CW_Q0 = 64, CW_BAR = 4096;

constexpr int LDS_BYTES = 160 * 1024;
constexpr int MISC_OFF = LDS_BYTES - 256;

#define XB_TMO      128
#define XB_XCNT(j)  (256  + 64 * (j))
#define XB_XSUB(j)  (1280 + 64 * (j))
#define XB_XGEN(j)  (2304 + 64 * (j))
#define XB_TOP      3328
#define XB_TOPGEN   3392
#define XCD_BAR_WORDS 3456
#define XB_SPIN_CAP (1u << 24)
__device__ __forceinline__ unsigned xb_ld(unsigned* p)              { return __hip_atomic_load(p, __ATOMIC_RELAXED, __HIP_MEMORY_SCOPE_AGENT); }
__device__ __forceinline__ unsigned xb_add(unsigned* p, unsigned v) { return __hip_atomic_fetch_add(p, v, __ATOMIC_RELAXED, __HIP_MEMORY_SCOPE_AGENT); }
__device__ __forceinline__ unsigned xb_xcc_id() { return (unsigned)__builtin_amdgcn_s_getreg((3 << 11) | 20) & 0xFu; }
#define XB_SPIN(cond, bar) do { unsigned _sp = 0; while (cond) { __builtin_amdgcn_s_sleep(1); \
    if ((++_sp & 255u) == 0u) { if (xb_ld(&(bar)[XB_TMO])) break; if (_sp > XB_SPIN_CAP) { atomicAdd(&(bar)[XB_TMO], 1u); break; } } } } while (0)
struct XcdBarrier { unsigned* bar; unsigned x; volatile LAS unsigned* st; };
__device__ __forceinline__ XcdBarrier xcd_barrier_post(unsigned* bar, volatile LAS unsigned* st) {
    XcdBarrier b; b.bar = bar; b.x = xb_xcc_id(); b.st = st;
    if (threadIdx.x == 0) (void)xb_add(&bar[XB_XCNT(b.x)], 1u);
    return b;
}
__device__ __forceinline__ void xcd_barrier_complete(unsigned* bar, unsigned x, unsigned& nloc, unsigned& nx) {
    const unsigned G = gridDim.x * gridDim.y * gridDim.z;
    unsigned sum, cnt, mine, sp = 0u;
    for (;;) {
        sum = 0u; cnt = 0u; mine = 0u;
#pragma unroll
        for (unsigned j = 0; j < 16; ++j) { const unsigned c = xb_ld(&bar[XB_XCNT(j)]); sum += c; cnt += (c > 0u) ? 1u : 0u; mine = (j == x) ? c : mine; }
        if (sum == G) break;
        __builtin_amdgcn_s_sleep(1);
        if ((++sp & 255u) == 0u) { if (xb_ld(&bar[XB_TMO])) break; if (sp > XB_SPIN_CAP) { atomicAdd(&bar[XB_TMO], 1u); break; } }
    }
    nloc = mine > 0u ? mine : 1u; nx = cnt > 0u ? cnt : 1u;
}
__device__ __forceinline__ void xcd_barrier(const XcdBarrier& b) {
    asm volatile("s_waitcnt vmcnt(0)" ::: "memory");
    __syncthreads();
    if (threadIdx.x == 0) {
        unsigned* bar = b.bar;
        __builtin_amdgcn_s_waitcnt(0);
        unsigned nloc = b.st[0], nx = b.st[1];
        if (nloc == 0u) { xcd_barrier_complete(bar, b.x, nloc, nx); b.st[0] = nloc; b.st[1] = nx; }
        const unsigned old = xb_add(&bar[XB_XSUB(b.x)], 1u);
        const unsigned gen = old / nloc;
        if (old + 1u == (gen + 1u) * nloc) {
            __builtin_amdgcn_fence(__ATOMIC_RELEASE, "agent");
            asm volatile("s_waitcnt vmcnt(0)" ::: "memory");
            const unsigned og = xb_add(&bar[XB_TOP], 1u);
            const unsigned tg = og / nx;
            if (og + 1u == (tg + 1u) * nx) xb_add(&bar[XB_TOPGEN], 1u);
            else XB_SPIN(xb_ld(&bar[XB_TOPGEN]) == tg, bar);
            __builtin_amdgcn_fence(__ATOMIC_ACQUIRE, "agent");
            xb_add(&bar[XB_XGEN(b.x)], 1u);
            asm volatile("s_waitcnt vmcnt(0)" ::: "memory");
        } else {
            XB_SPIN(xb_ld(&bar[XB_XGEN(b.x)]) == gen, bar);
            __builtin_amdgcn_fence(__ATOMIC_ACQUIRE, "agent");
            asm volatile("s_waitcnt vmcnt(0)" ::: "memory");
        }
    }
    __syncthreads();
}

namespace pg8 {
constexpr int BM = 256, BK = 64, HALF = 128, HTB = HALF * BK * 2, STAGE_BYTES = 8 * HTB, NXCD = 8, WGM = 8;
__host__ __device__ __forceinline__ int lds_byte(int r, int c) { const int st = (r >> 4) * 2 + (c >> 5), rr = r & 15, cc = c & 31, ob = rr * 64 + cc * 2; return st * 1024 + (ob ^ (((ob >> 9) & 1) << 5)); }
__host__ __device__ __forceinline__ void stage_rc(int b, int& R, int& C) { const int st = b / 1024, sb = b % 1024, swz = sb ^ (((sb >> 9) & 1) << 5); R = (st >> 1) * 16 + swz / 64; C = (st & 1) * 32 + (swz % 64) / 2; }
__host__ __device__ __forceinline__ int perm32(int rho) { const int n = rho >> 4, i = rho & 15; return 8 * (i >> 2) + 4 * n + (i & 3); }
struct Unit { int pm, pn, k0, ntu, sp; };
struct Gemm { const bf16* A; const bf16* Bt; int M, N, K; };
struct StaticOrder {
    int nM, nN, nwg, G, c; int force0 = 0; int fatk = 0;
    __host__ __device__ void init(int M, int N, int G_, int c_) { nM = M / BM; nN = N / BM; nwg = nM * nN; G = G_; c = c_; }
    __host__ __device__ bool next(int i, Unit& u) const {
        const long L = (long)i * G + c; if (L >= nwg) return false;
        if (fatk && G == 256 && nM == 64 && nN == 16) { const int x = c & 7, l = c >> 3; u.pm = 8 * (2 * i + (x >> 2)) + (l & 7); u.pn = 4 * (x & 3) + (l >> 3); return true; }
        int wgid = (int)L; { const int q = nwg / NXCD, r = nwg % NXCD, xcd = wgid % NXCD, off = wgid / NXCD; wgid = (xcd < r ? xcd * (q + 1) : r * (q + 1) + (xcd - r) * q) + off; }
        const int nig = WGM * nN, gid = wgid / nig, fm = gid * WGM, gsz = (nM - fm) < WGM ? (nM - fm) : WGM;
        u.pm = fm + ((wgid % nig) % gsz); u.pn = (wgid % nig) / gsz; if (force0) { u.pm = 0; u.pn = 0; } return true;
    }
};
struct SplitOrder {
    int G, c, pm, pairs;
    __device__ bool next(int i, Unit& u) const {
        const int L = i * G + c; if (L >= 256) return false;
        const int s = 2 * (L & 7) + (L >> 7), base = pairs >> 4, rem = pairs & 15;
        u.pm = pm; u.pn = (L >> 3) & 15; u.sp = s; u.ntu = 2 * (base + (s < rem ? 1 : 0)); u.k0 = 2 * (s * base + (s < rem ? s : rem)); return true;
    }
};
template <class Epi, bool AIMG = false, bool BIMG = false, class Order = StaticOrder, bool SPLIT = false>
__device__ __forceinline__ void gemm_phase(LAS unsigned char* lds, const Gemm g, const Order& S, const Epi& E) {
    int tid_ = threadIdx.x; asm volatile("" : "+v"(tid_));
    const int tid = tid_, wid = __builtin_amdgcn_readfirstlane(tid >> 6), lane = tid & 63, wr = wid >> 2, wc = wid & 3, fr = lane & 15, fq = lane >> 4;
    const int K = g.K, nt = K / BK;
    unsigned voffA[2], voffB[2];
#pragma unroll
    for (int i = 0; i < 2; ++i) { int R, C; stage_rc(tid * 16 + i * 8192, R, C); const int Rb = Epi::PERM ? ((R & ~31) + perm32(R & 31)) : R;
        voffA[i] = AIMG ? (unsigned)(tid * 16 + i * 8192) : (unsigned)(R * K + C) * 2u; voffB[i] = BIMG ? (unsigned)(tid * 16 + i * 8192) : (unsigned)(Rb * K + C) * 2u; }
    const size_t kstepA = AIMG ? (size_t)HTB : (size_t)(BK * 2), kstepB = BIMG ? (size_t)HTB : (size_t)(BK * 2);
    const size_t hstepA = AIMG ? (size_t)nt * HTB : (size_t)HALF * K * 2, hstepB = BIMG ? (size_t)nt * HTB : (size_t)HALF * K * 2;
    const size_t tstepA = 2 * hstepA, tstepB = 2 * hstepB;
    const unsigned ldsw = (unsigned)wid * 1024u;
    const int aoff = lds_byte(wr * 64 + fr, fq * 8), boff = lds_byte(wc * 32 + fr, fq * 8);
#define PG8_SA(b, h) (((b) * 2 + (h)) * HTB)
#define PG8_SB(b, h) ((4 + (b) * 2 + (h)) * HTB)
#define PG8_STAGE(bufoff, gbase, voff) do { _Pragma("unroll") for (int _i = 0; _i < 2; ++_i) \
        __builtin_amdgcn_global_load_lds((const unsigned*)((const char*)(gbase) + (voff)[_i]), (LAS unsigned*)(lds + (bufoff) + ldsw + _i * 8192), 16, 0, 0); } while (0)
#define PG8_LDA(dst, b, h) do { _Pragma("unroll") for (int m = 0; m < 4; ++m) _Pragma("unroll") for (int k = 0; k < 2; ++k) dst[m][k] = *(const LAS bf16x8*)(lds + PG8_SA(b, h) + aoff + m * 2048 + k * 1024); } while (0)
#define PG8_LDB(dst, b, h) do { _Pragma("unroll") for (int n = 0; n < 2; ++n) _Pragma("unroll") for (int k = 0; k < 2; ++k) dst[n][k] = *(const LAS bf16x8*)(lds + PG8_SB(b, h) + boff + n * 2048 + k * 1024); } while (0)
#define PG8_MMA(ai, bj, At, Bt) do { __builtin_amdgcn_s_setprio(1); _Pragma("unroll") for (int m = 0; m < 4; ++m) _Pragma("unroll") for (int n = 0; n < 2; ++n) _Pragma("unroll") for (int k = 0; k < 2; ++k) \
        acc[ai][bj][m][n] = __builtin_amdgcn_mfma_f32_16x16x32_bf16(Bt[n][k], At[m][k], acc[ai][bj][m][n], 0, 0, 0); __builtin_amdgcn_s_setprio(0); } while (0)
#define PG8_WAIT_V(n) asm volatile("s_waitcnt vmcnt(" #n ")" ::: "memory")
#define PG8_WAIT_L(n) asm volatile("s_waitcnt lgkmcnt(" #n ")" ::: "memory")
#define PG8_BAR __builtin_amdgcn_s_barrier()
#define PG8_SCHED __builtin_amdgcn_sched_barrier(0)
    Unit cur, nxt; int ui = 0;
    if (!S.next(0, cur)) return;
    f32x4 acc[2][2][4][2];
#pragma unroll
    for (int a = 0; a < 2; ++a)
#pragma unroll
        for (int b = 0; b < 2; ++b)
#pragma unroll
            for (int m = 0; m < 4; ++m)
#pragma unroll
                for (int n = 0; n < 2; ++n) acc[a][b][m][n] = (f32x4){0.f, 0.f, 0.f, 0.f};
    bf16x8 At[4][2], B0[2][2], B1[2][2];
    const char* cA = (const char*)g.A + (size_t)cur.pm * tstepA + (SPLIT ? (size_t)cur.k0 * kstepA : (size_t)0); const char* cB = (const char*)g.Bt + (size_t)cur.pn * tstepB + (SPLIT ? (size_t)cur.k0 * kstepB : (size_t)0);
    PG8_STAGE(PG8_SB(0, 0), cB, voffB); PG8_STAGE(PG8_SB(0, 1), cB + hstepB, voffB); PG8_STAGE(PG8_SA(0, 0), cA, voffA); PG8_STAGE(PG8_SA(0, 1), cA + hstepA, voffA);
    if (wr == 1) PG8_BAR;
    PG8_WAIT_V(2); PG8_BAR;
    PG8_STAGE(PG8_SB(1, 0), cB + kstepB, voffB); PG8_STAGE(PG8_SA(1, 0), cA + kstepA, voffA); PG8_STAGE(PG8_SB(1, 1), cB + hstepB + kstepB, voffB);
    PG8_WAIT_V(6); PG8_BAR;
    for (;;) {
        const bool has_next = S.next(ui + 1, nxt);
        const char* nA = has_next ? (const char*)g.A + (size_t)nxt.pm * tstepA + (SPLIT ? (size_t)nxt.k0 * kstepA : (size_t)0) : cA;
        const char* nB = has_next ? (const char*)g.Bt + (size_t)nxt.pn * tstepB + (SPLIT ? (size_t)nxt.k0 * kstepB : (size_t)0) : cB;
        const int ntu = SPLIT ? cur.ntu : nt;
        for (int t = 0; t < ntu; t += 2) {
            const bool last = (t == ntu - 2);
            const char* a1 = cA + (size_t)(t + 1) * kstepA;
            const char* a2 = last ? nA : cA + (size_t)(t + 2) * kstepA; const char* b2 = last ? nB : cB + (size_t)(t + 2) * kstepB;
            const char* a3 = a2 + kstepA; const char* b3 = b2 + kstepB;
            PG8_LDB(B0, 0, 0); PG8_LDB(B1, 0, 1); PG8_SCHED; PG8_LDA(At, 0, 0); PG8_STAGE(PG8_SA(1, 1), a1 + hstepA, voffA);
            PG8_WAIT_V(8); PG8_WAIT_L(0); PG8_BAR; PG8_MMA(0, 0, At, B0); PG8_MMA(0, 1, At, B1); PG8_BAR; PG8_SCHED;
            PG8_LDA(At, 0, 1); PG8_STAGE(PG8_SB(0, 0), b2, voffB); PG8_STAGE(PG8_SB(0, 1), b2 + hstepB, voffB); PG8_STAGE(PG8_SA(0, 0), a2, voffA);
            PG8_WAIT_V(8); PG8_WAIT_L(0); PG8_BAR; PG8_MMA(1, 0, At, B0); PG8_MMA(1, 1, At, B1); PG8_BAR; PG8_SCHED;
            PG8_LDB(B0, 1, 0); PG8_LDB(B1, 1, 1); PG8_SCHED; PG8_LDA(At, 1, 0); PG8_STAGE(PG8_SA(0, 1), a2 + hstepA, voffA);
            PG8_WAIT_V(8); PG8_WAIT_L(0); PG8_BAR; PG8_MMA(0, 0, At, B0); PG8_MMA(0, 1, At, B1); PG8_BAR; PG8_SCHED;
            PG8_LDA(At, 1, 1); PG8_STAGE(PG8_SB(1, 0), b3, voffB); PG8_STAGE(PG8_SB(1, 1), b3 + hstepB, voffB); PG8_STAGE(PG8_SA(1, 0), a3, voffA);
            PG8_WAIT_V(8); PG8_WAIT_L(0); PG8_BAR; PG8_MMA(1, 0, At, B0); PG8_MMA(1, 1, At, B1); PG8_BAR; PG8_SCHED;
        }
        if (wr == 0) PG8_BAR;
        E(acc, cur, wr, wc, fr, fq);
        if (!has_next) break;
#pragma unroll
        for (int a = 0; a < 2; ++a)
#pragma unroll
            for (int b = 0; b < 2; ++b)
#pragma unroll
                for (int m = 0; m < 4; ++m)
#pragma unroll
                    for (int n = 0; n < 2; ++n) acc[a][b][m][n] = (f32x4){0.f, 0.f, 0.f, 0.f};
        cur = nxt; cA = nA; cB = nB; ++ui;
        if (wr == 1) PG8_BAR;
    }
    PG8_WAIT_V(0);
    PG8_BAR;
#undef PG8_SA
#undef PG8_SB
#undef PG8_STAGE
#undef PG8_LDA
#undef PG8_LDB
#undef PG8_MMA
#undef PG8_WAIT_V
#undef PG8_WAIT_L
#undef PG8_BAR
#undef PG8_SCHED
}
__device__ __forceinline__ size_t img_off(int row, int k, int nt, bool permb) {
    int r = row & 127; if (permb) { const int m = r & 31; r = (r & ~31) + 16 * ((m >> 2) & 1) + 4 * (m >> 3) + (m & 3); }
    return ((size_t)(row >> 7) * nt + (k >> 6)) * (size_t)HTB + (size_t)lds_byte(r, k & 63);
}
}

struct Args { const float* in[20]; float* out; unsigned char* ws; };
enum { I_XP = 0, I_XS, I_SG, I_CK, I_CV, I_CP, I_CS, I_WADA, I_BADA, I_G1, I_WIN, I_WGK, I_BGK, I_GGLA, I_SINK, I_WOUT, I_G2, I_WGU, I_WDN, I_GF };

struct Frame {
    LAS unsigned char* lds;
    volatile LAS unsigned* MISC;
    gu32* ctl;
    int tid, lane, wave, G, bid;
    const float* in[20];
    float* out; unsigned char* ws;
    float* MOD; float* ROPEC; float* ROPES; float* SC; float* DBG;
    bf16 *WIN, *WOUT, *WGU, *WDN, *H, *PROJ;
};

__device__ __forceinline__ int row_batch(int row) { return row < MP ? (row >> 13) : 2 + ((row - MP) >> 4); }
__device__ __forceinline__ int row_pos(int row) { return row < MP ? (row & 8191) : 2048 + (row & 15); }
__device__ __forceinline__ const float* x_row(const Frame& F, int row) { return row < MP ? F.in[I_XP] + (size_t)row * D : F.in[I_XS] + (size_t)(row - MP) * D; }

__device__ __forceinline__ int win_src_col(int n) {
    if (n < 8192) return n;
    if (n < 12288 || (n >= 17408 && n < 21504)) {
        const int ct = n < 12288 ? (n - 8192) >> 8 : 16 + ((n - 17408) >> 8), j = n & 255; return j < 128 ? 8192 + 128 * ct + j : 17424 + 128 * ct + (j - 128); }
    if (n < 16896) { const bool isq = n < 16384; const int r = n - (isq ? 12288 : 16384), hh = r >> 6, p = r & 63, t = p >> 3, e = p & 7;
        const int d = (e < 4) ? (4 * t + e) : (32 + 4 * t + (e - 4)); return (isq ? O_QB : O_KB) + 64 * hh + d; }
    if (n < 25600) return n + 16;
    if (n < 25616) return O_RA + (n - 25600);
    return -1;
}
__device__ __forceinline__ int wgu_src_col(int n) { const int pn = n >> 8, j = n & 255; return j < 128 ? 128 * pn + j : DFF + 128 * pn + (j - 128); }

__device__ __forceinline__ void p0_transpose(const float* W, int K, int N, bf16* WT, int mode, LAS float* scr, int n0, int k0, int lane, int imgnt = 0, bool permb = false) {
    const int cg = lane & 15, kr = lane >> 4;
    const int n = n0 + 4 * cg; const int src = mode == 1 ? win_src_col(n) : (mode == 2 ? wgu_src_col(n) : n);
    const float* wp = W + (size_t)(k0 + kr) * N + (src < 0 ? 0 : src);
    f32x4 v[16];
#pragma unroll
    for (int j = 0; j < 16; ++j) v[j] = src >= 0 ? *(const f32x4*)(wp + (size_t)(4 * j) * N) : (f32x4){0.f, 0.f, 0.f, 0.f};
#pragma unroll
    for (int j = 0; j < 16; ++j) { LAS float* d = scr + (4 * j + kr) * 65 + 4 * cg; d[0] = v[j].x; d[1] = v[j].y; d[2] = v[j].z; d[3] = v[j].w; }
    LDS_WAIT(); asm volatile("" ::: "memory");
    const int c = lane & 7;
#pragma unroll
    for (int j = 0; j < 8; ++j) { const int nn = (lane >> 3) + 8 * j; const LAS float* q = scr + (8 * c) * 65 + nn;
        u32x4 o; o.x = cvtpk(q[0], q[65]); o.y = cvtpk(q[2 * 65], q[3 * 65]); o.z = cvtpk(q[4 * 65], q[5 * 65]); o.w = cvtpk(q[6 * 65], q[7 * 65]);
        if (imgnt) *(u32x4*)((unsigned char*)WT + pg8::img_off(n0 + nn, k0 + 8 * c, imgnt, permb)) = o;
        else *(u32x4*)(WT + (size_t)(n0 + nn) * K + k0 + 8 * c) = o; }
    LDS_WAIT(); asm volatile("" ::: "memory");
}

constexpr int I_MOD = 384, I_TWIN = (NP_IN / 64) * 8, I_TWOUT = (D / 64) * 8, I_TWGU = (N_GU / 64) * 8, I_TWDN = (D / 64) * 22, I_ROPE = 32;
constexpr int P0_ITEMS = I_MOD + I_ROPE + I_TWIN;
constexpr int CW_QGU = 192, CW_QDN = 320;

__device__ __forceinline__ void p0_mod_item(Frame& F, int item) {
    const int w = F.wave, lane = F.lane, cg = item >> 2, kq = item & 3;
    f32x4 acc[10];
#pragma unroll
    for (int b = 0; b < 10; ++b) acc[b] = (f32x4){0.f, 0.f, 0.f, 0.f};
    const int kbase = 1024 * kq + 128 * w;
    const float* wp = F.in[I_WADA] + (size_t)kbase * NMOD + 256 * cg + 4 * lane;
#pragma unroll 1
    for (int kc = 0; kc < 2; ++kc) {
        float scv[10];
#pragma unroll
        for (int b = 0; b < 10; ++b) { const int k = kbase + 64 * kc + lane; const float c = b < 2 ? F.in[I_CP][b * D + k] : F.in[I_CS][(b - 2) * D + k]; scv[b] = c / (1.f + __expf(-c)); }
#pragma unroll
        for (int kk = 0; kk < 64; ++kk) {
            const f32x4 wv = *(const f32x4*)(wp + (size_t)(64 * kc + kk) * NMOD);
#pragma unroll
            for (int b = 0; b < 10; ++b) { const float sv = __builtin_bit_cast(float, __builtin_amdgcn_readlane(__builtin_bit_cast(int, scv[b]), kk)); acc[b] += wv * sv; }
        }
    }
    LAS float* red = (LAS float*)F.lds;
#pragma unroll
    for (int b = 0; b < 10; ++b) *(LAS f32x4*)(red + (w * 10 + b) * 256 + 4 * lane) = acc[b];
    __syncthreads();
    for (int o = F.tid; o < 2560; o += NTHR) { const int b = o >> 8, c = o & 255; float sacc = kq == 0 ? F.in[I_BADA][256 * cg + c] : 0.f;
#pragma unroll
        for (int ww = 0; ww < 8; ++ww) sacc += red[(ww * 10 + b) * 256 + c];
        atomicAdd(F.MOD + b * NMOD + 256 * cg + c, sacc); }
    __syncthreads();
}
__device__ __forceinline__ void p0_rope_item(Frame& F, int it) {
    const int pos = 256 * it + (F.tid >> 1), fh = F.tid & 1;
#pragma unroll 1
    for (int f = 16 * fh; f < 16 * fh + 16; ++f) {
        const float inv = (float)exp2(-(double)f * (13.287712379549449 / 32.0));
        const float ang = (float)pos * inv;
        const double a = (double)ang, r = a - 6.283185307179586 * rint(a * 0.15915494309189535);
        F.ROPEC[pos * 32 + f] = (float)cos(r); F.ROPES[pos * 32 + f] = (float)sin(r);
    }
}
__device__ __forceinline__ void p0_phase(Frame& F, int qw) {
    LAS float* scr = (LAS float*)(F.lds + F.wave * 16640);
    for (;;) {
        __syncthreads();
        if (F.tid == 0) F.MISC[0] = __hip_atomic_fetch_add(F.ctl + qw, 1u, RLX_AGENT);
        __syncthreads();
        int it = (int)F.MISC[0];
        if (it >= P0_ITEMS) break;
        if (it < I_MOD) { p0_mod_item(F, it); continue; } it -= I_MOD;
        if (it < I_ROPE) { p0_rope_item(F, it); continue; } it -= I_ROPE;
        const int w = F.wave;
        p0_transpose(F.in[I_WIN], D, N_IN, F.WIN, 1, scr, 64 * (it >> 3), 512 * (it & 7) + 64 * w, F.lane, D / 64, true);
    }
}
template <int KIND>
__device__ __forceinline__ void drain_weights(Frame& F) {
    LAS float* scr = (LAS float*)(F.lds + F.wave * 16640);
    for (;;) {
        __syncthreads();
        if (F.tid == 0) F.MISC[0] = __hip_atomic_fetch_add(F.ctl + (KIND == 0 ? CW_QGU : CW_QDN), 1u, RLX_AGENT);
        __syncthreads();
        int it = (int)F.MISC[0];
        if (it >= (KIND == 0 ? I_TWOUT + I_TWGU : I_TWDN)) break;
        const int w = F.wave;
        if (KIND == 0 && it < I_TWOUT) p0_transpose(F.in[I_WOUT], D, D, F.WOUT, 0, scr, 64 * (it >> 3), 512 * (it & 7) + 64 * w, F.lane, D / 64, true);
        else if (KIND == 0) { it -= I_TWOUT; p0_transpose(F.in[I_WGU], D, N_GU, F.WGU, 2, scr, 64 * (it >> 3), 512 * (it & 7) + 64 * w, F.lane, D / 64, true); }
        else { const int nb = it / 22, kb = it % 22, k0 = 512 * kb + 64 * w; if (k0 < DFF) p0_transpose(F.in[I_WDN], DFF, D, F.WDN, 0, scr, 64 * nb, k0, F.lane, DFF / 64, true); }
    }
}

template <bool SRCB> struct NormRaw { f32x4 v[16]; };
template <> struct NormRaw<true> { u32x2 v[16]; };
template <bool SRCB>
__device__ __forceinline__ void norm_load(const Frame& F, int row, const float* xp, const float* xs, const bf16* xb, NormRaw<SRCB>& R) {
    if constexpr (!SRCB) { const float* xrow = row < MP ? xp + (size_t)row * D : xs + (size_t)(row - MP) * D;
        const GAS f32x4* xr = (const GAS f32x4*)xrow + F.lane;
#pragma unroll
        for (int j = 0; j < 16; ++j) R.v[j] = xr[64 * j]; }
    else { const GAS u32x2* xr = (const GAS u32x2*)(xb + (size_t)row * D) + F.lane;
#pragma unroll
        for (int j = 0; j < 16; ++j) R.v[j] = xr[64 * j]; }
}
template <bool SRCB>
__device__ __forceinline__ void norm_proc(const Frame& F, int row, const NormRaw<SRCB>& R, const float* g, int off_sh, int off_sc, bf16* Hout) {
    unsigned char* hb = (unsigned char*)Hout + (size_t)(row >> 7) * (D / 64) * (size_t)pg8::HTB + 8 * (F.lane & 1);
    const int kt0 = F.lane >> 4, cc = (4 * F.lane) & 56, o_lo = pg8::lds_byte(row & 127, cc);
#define H_ST8(j, val) (*(GAS unsigned long long*)(hb + (size_t)(4 * (j) + kt0) * pg8::HTB + o_lo) = (val))
    if (row >= MREAL) {
#pragma unroll
        for (int j = 0; j < 16; ++j) H_ST8(j, 0ull);
        return; }
    f32x4 v[16]; float s = 0.f;
#pragma unroll
    for (int j = 0; j < 16; ++j) {
        if constexpr (!SRCB) v[j] = R.v[j]; else { const u32x2 w = R.v[j]; v[j] = (f32x4){bflo(w.x), bfhi(w.x), bflo(w.y), bfhi(w.y)}; }
        s += (v[j].x * v[j].x + v[j].y * v[j].y) + (v[j].z * v[j].z + v[j].w * v[j].w); }
    const float r = 1.0f / sqrtf(wave_sum(s) * (1.f / D) + NORM_EPS);
    const float* mod = F.MOD + (size_t)row_batch(row) * NMOD;
#pragma unroll
    for (int j = 0; j < 16; ++j) { const int c = 256 * j + 4 * F.lane;
        const f32x4 gg = *(const f32x4*)(g + c), sh = *(const f32x4*)(mod + off_sh + c), sc = *(const f32x4*)(mod + off_sc + c);
        const f32x4 y = (v[j] * r) * gg * (sc + 1.0f) + sh;
        H_ST8(j, (unsigned long long)cvtpk(y.x, y.y) | ((unsigned long long)cvtpk(y.z, y.w) << 32)); }
#undef H_ST8
}
template <bool SRCB>
__device__ __forceinline__ void norm_mod_rows(Frame& F, const float* xp, const float* xs, const bf16* xb, const float* g, int off_sh, int off_sc, bf16* Hout) {
    const int gw = F.bid * NWAVES + F.wave, NGW = F.G * NWAVES;
    int row = gw; if (row >= MPAD) return;
    NormRaw<SRCB> A, B;
    if (row < MREAL) norm_load<SRCB>(F, row, xp, xs, xb, A);
    for (;;) {
        if (row + NGW < MREAL) norm_load<SRCB>(F, row + NGW, xp, xs, xb, B);
        norm_proc<SRCB>(F, row, A, g, off_sh, off_sc, Hout);
        row += NGW; if (row >= MPAD) break;
        if (row + NGW < MREAL) norm_load<SRCB>(F, row + NGW, xp, xs, xb, A);
        norm_proc<SRCB>(F, row, B, g, off_sh, off_sc, Hout);
        row += NGW; if (row >= MPAD) break;
    }
}

__device__ __forceinline__ float sigmoidf_(float x) { return __builtin_amdgcn_rcpf(1.f + __expf(-x)); }
struct EpiIn {
    static constexpr bool PERM = true;
    bf16* P; const float* ropec; const float* ropes; float* out;
    __device__ __forceinline__ void operator()(const f32x4 (&acc)[2][2][4][2], const pg8::Unit& u, int wr, int wc, int fr, int fq) const {
        const int pn = u.pn, pm = u.pm;
        const bool is_q = pn >= 48 && pn < 64, is_k = pn >= 64 && pn < 66, is_v = pn >= 66 && pn < 68;
        const bool is_gz = (pn >= 32 && pn < 48) || (pn >= 68 && pn < 84), is_zb = pn >= 84 && pn < 100;
        const int t = 4 * (wc & 1) + fq;
        if (is_gz) {
            const int ct = pn < 48 ? pn - 32 : 16 + (pn - 68);
#pragma unroll
            for (int ai = 0; ai < 2; ++ai)
#pragma unroll
                for (int m = 0; m < 4; ++m) { const int row = pm * 256 + ai * 128 + wr * 64 + m * 16 + fr;
                    const f32x4 g0 = acc[ai][0][m][0], g1 = acc[ai][0][m][1], z0 = acc[ai][1][m][0], z1 = acc[ai][1][m][1]; float a[8];
#pragma unroll
                    for (int x = 0; x < 4; ++x) { a[x] = g0[x] * sigmoidf_(g0[x]) * sigmoidf_(z0[x]); a[4 + x] = g1[x] * sigmoidf_(g1[x]) * sigmoidf_(z1[x]); }
                    u32x4 w; w.x = cvtpk(a[0], a[1]); w.y = cvtpk(a[2], a[3]); w.z = cvtpk(a[4], a[5]); w.w = cvtpk(a[6], a[7]);
                    *(u32x4*)(P + pj(row, C_GA + ct * 128 + wc * 32 + 8 * fq)) = w; }
            return; }
#pragma unroll
        for (int ai = 0; ai < 2; ++ai)
#pragma unroll
            for (int m = 0; m < 4; ++m) {
                const int row = pm * 256 + ai * 128 + wr * 64 + m * 16 + fr;
                bf16* rowp = P + pj(row, pn * 256 + wc * 32 + 8 * fq);
                long kbase = -1;
                if (is_k || is_v) {
                    if (row < MP) { const int tt = row & 8191; if (tt >= 8064) kbase = (is_k ? OUT_KP : OUT_VP) + ((long)((row >> 13) * 128 + (tt - 8064)) * 8) * 64; }
                    else if (row < MREAL) { const int r2 = row - MP; kbase = (is_k ? OUT_KS : OUT_VS) + ((long)((r2 >> 4) * 16 + (r2 & 15)) * 8) * 64; }
                }
                f32x4 cs, sn;
                if (is_q || is_k) { const int pos = row_pos(row); cs = *(const f32x4*)(ropec + pos * 32 + 4 * t); sn = *(const f32x4*)(ropes + pos * 32 + 4 * t); }
#pragma unroll
                for (int bj = 0; bj < 2; ++bj) {
                    f32x4 v0 = acc[ai][bj][m][0], v1 = acc[ai][bj][m][1];
                    if (is_q || is_k) { const f32x4 o1 = v0 * cs - v1 * sn, o2 = v1 * cs + v0 * sn; v0 = o1; v1 = o2;
                        if (is_q) { v0 = v0 * QSCALE; v1 = v1 * QSCALE; } }
                    if (is_zb) {
#pragma unroll
                        for (int x = 0; x < 4; ++x) { v0[x] = sigmoidf_(v0[x]); v1[x] = sigmoidf_(v1[x]); } }
                    if (kbase >= 0) {
                        const int g = 4 * (pn - (is_k ? 64 : 66)) + 2 * bj + (wc >> 1);
                        float* kp = out + kbase + g * 64;
                        if (is_k) { *(f32x4*)(kp + 4 * t) = v0; *(f32x4*)(kp + 32 + 4 * t) = v1; }
                        else { *(f32x4*)(kp + 8 * t) = v0; *(f32x4*)(kp + 8 * t + 4) = v1; }
                    }
                    u32x4 w; w.x = cvtpk(v0[0], v0[1]); w.y = cvtpk(v0[2], v0[3]); w.z = cvtpk(v1[0], v1[1]); w.w = cvtpk(v1[2], v1[3]);
                    *(u32x4*)(rowp + bj * 128) = w;
                }
            }
    }
};

constexpr int CL_PITCH = 520;
constexpr float GLA_QSCALE = 0.04419417382415922f;
__device__ __forceinline__ int crow(int reg, int h) { return (reg & 3) + 8 * (reg >> 2) + 4 * h; }
#define MFMA32(a, b, c) __builtin_amdgcn_mfma_f32_32x32x16_bf16((a), (b), (c), 0, 0, 0)
__device__ __forceinline__ bf16x8 pack8(const f32x16& x, int s) {
    u32x4 p; p.x = cvtpk(x[8 * s], x[8 * s + 1]); p.y = cvtpk(x[8 * s + 2], x[8 * s + 3]); p.z = cvtpk(x[8 * s + 4], x[8 * s + 5]); p.w = cvtpk(x[8 * s + 6], x[8 * s + 7]);
    return __builtin_bit_cast(bf16x8, p);
}
constexpr float LOG2E_ = 1.4426950408889634f;
__device__ __forceinline__ float logsig(float x) { return fminf(x, 0.f) - __logf(1.f + __expf(-fabsf(x))); }

__device__ __forceinline__ void gla_chunk_local(Frame& F, int cid, int hd) {
    const int tid = F.tid, lane = F.lane, wv = F.wave, h = lane >> 5;
    LAS bf16* QL = (LAS bf16*)F.lds; LAS bf16* KL = QL + 64 * CL_PITCH;
    LAS float* RA = (LAS float*)(F.lds + 133120); LAS float* RED = (LAS float*)(F.lds + 137216);
    int row0, ntok; if (cid < 256) { row0 = cid * 64; ntok = 64; } else { row0 = MP + 16 * (cid - 256); ntok = 16; }
    const int d = tid;
    float wg[16];
#pragma unroll
    for (int r = 0; r < 16; ++r) wg[r] = F.in[I_WGK][r * 2048 + hd * 512 + d];
    const float bias = F.in[I_BGK][hd * 512 + d];
    u32x4 rq[8], rk[8];
#pragma unroll
    for (int j = 0; j < 8; ++j) { const int id = tid + 512 * j, rr = id >> 6, c16 = id & 63; rq[j] = (u32x4){0u, 0u, 0u, 0u}; rk[j] = rq[j];
        if (rr < ntok) { rq[j] = *(const u32x4*)(F.PROJ + pj(row0 + rr, C_QA + hd * 512 + 8 * c16)); rk[j] = *(const u32x4*)(F.PROJ + pj(row0 + rr, C_KA + hd * 512 + 8 * c16)); } }
    if (tid < 128) { const int i = tid >> 1, half = tid & 1; u32x4 w = (u32x4){0u, 0u, 0u, 0u};
        if (i < ntok) w = *(const u32x4*)(F.PROJ + pj(row0 + i, C_RA + 8 * half));
        LAS float* r = RA + i * 16 + 8 * half;
        r[0] = bflo(w.x); r[1] = bfhi(w.x); r[2] = bflo(w.y); r[3] = bfhi(w.y); r[4] = bflo(w.z); r[5] = bfhi(w.z); r[6] = bflo(w.w); r[7] = bfhi(w.w); }
#pragma unroll
    for (int j = 0; j < 8; ++j) { const int id = tid + 512 * j, rr = id >> 6, c16 = id & 63; *(LAS u32x4*)(QL + rr * CL_PITCH + 8 * c16) = rq[j]; *(LAS u32x4*)(KL + rr * CL_PITCH + 8 * c16) = rk[j]; }
    __syncthreads();
    float B[64]; float bc = 0.f;
    unsigned ra_base = (unsigned)(size_t)RA; asm volatile("" : "+v"(ra_base));
    const f32x2 w01 = {wg[0], wg[1]}, w23 = {wg[2], wg[3]}, w45 = {wg[4], wg[5]}, w67 = {wg[6], wg[7]}, w89 = {wg[8], wg[9]}, wab = {wg[10], wg[11]}, wcd = {wg[12], wg[13]}, wef = {wg[14], wg[15]};
#pragma unroll
    for (int i = 0; i < 64; ++i) {
        const LAS f32x4* rp = (const LAS f32x4*)(size_t)(ra_base + (unsigned)(i * 64));
        const f32x4 r0 = rp[0], r1 = rp[1], r2 = rp[2], r3 = rp[3];
        f32x2 a2 = (f32x2){r0.x, r0.y} * w01; a2 += (f32x2){r0.z, r0.w} * w23; a2 += (f32x2){r1.x, r1.y} * w45; a2 += (f32x2){r1.z, r1.w} * w67;
        a2 += (f32x2){r2.x, r2.y} * w89; a2 += (f32x2){r2.z, r2.w} * wab; a2 += (f32x2){r3.x, r3.y} * wcd; a2 += (f32x2){r3.z, r3.w} * wef;
        const float gk = bias + (a2.x + a2.y);
        const float l2 = __builtin_amdgcn_logf(1.f + __builtin_amdgcn_exp2f(-fabsf(gk) * LOG2E_));
        float g = (fminf(gk, 0.f) - l2 * 0.6931471805599453f) * (1.f / 16.f); if (i >= ntok) g = 0.f;
        bc += g; B[i] = bc; }
    const float bmid = (ntok == 64) ? B[32] : B[8], blast = B[63];
    float* VEC = (float*)(F.ws + WS_VEC) + (size_t)(cid * 4 + hd) * 1024;
    VEC[d] = __expf(bmid); VEC[512 + d] = __expf(blast - bmid);
    unsigned kpk[32]; float kprev = 0.f;
#pragma unroll
    for (int i = 0; i < 64; ++i) {
        const float q = bf2f(QL[i * CL_PITCH + d]), k = bf2f(KL[i * CL_PITCH + d]);
        const float qt = q * GLA_QSCALE * __expf(B[i] - bmid), kt = k * __expf(bmid - B[i]);
        QL[i * CL_PITCH + d] = (bf16)(cvtpk(qt, 0.f) & 0xffffu);
        KL[i * CL_PITCH + d] = (bf16)(cvtpk(kt, 0.f) & 0xffffu);
        if (i & 1) kpk[i >> 1] = cvtpk(kprev, kt); else kprev = kt; }
    __syncthreads();
    unsigned char* fq = F.ws + WS_FRAG + (size_t)(cid * 4 + hd) * 131072; unsigned char* fk = fq + 65536;
    { const int dt = (d >> 5) & 1, dl = d & 31;
#pragma unroll
      for (int sp = 0; sp < 4; ++sp)
#pragma unroll
          for (int hh = 0; hh < 2; ++hh) { u32x4 o; o.x = kpk[8 * sp + 4 * hh]; o.y = kpk[8 * sp + 4 * hh + 1]; o.z = kpk[8 * sp + 4 * hh + 2]; o.w = kpk[8 * sp + 4 * hh + 3];
              *(u32x4*)(fk + ((wv * 2 + dt) * 4 + sp) * 1024 + (dl + 32 * hh) * 16) = o; } }
#pragma unroll
    for (int mt = 0; mt < 2; ++mt)
#pragma unroll
        for (int dt = 0; dt < 2; ++dt)
#pragma unroll
            for (int s = 0; s < 2; ++s) { const int i = 32 * mt + (lane & 31), d0 = 64 * wv + 32 * dt + 16 * s + 4 * h;
                const u32x2 a = *(const LAS u32x2*)(QL + i * CL_PITCH + d0), b = *(const LAS u32x2*)(QL + i * CL_PITCH + d0 + 8);
                u32x4 o; o.x = a.x; o.y = a.y; o.z = b.x; o.w = b.y;
                *(u32x4*)(fq + (((wv * 2 + mt) * 2 + dt) * 2 + s) * 1024 + lane * 16) = o; }
    const int tile = wv & 3, jt = tile >> 1, it = tile & 1, kh = wv >> 2;
    f32x16 acc;
#pragma unroll
    for (int r = 0; r < 16; ++r) acc[r] = 0.f;
#pragma unroll
    for (int ks = 0; ks < 16; ++ks) { const int dk = 256 * kh + 16 * ks + 8 * h;
        const bf16x8 a = *(const LAS bf16x8*)(KL + (32 * jt + (lane & 31)) * CL_PITCH + dk);
        const bf16x8 b = *(const LAS bf16x8*)(QL + (32 * it + (lane & 31)) * CL_PITCH + dk);
        acc = MFMA32(a, b, acc); }
    if (kh == 1) {
#pragma unroll
        for (int r = 0; r < 16; ++r) RED[(tile * 16 + r) * 64 + lane] = acc[r]; }
    __syncthreads();
    if (kh == 0) {
        const int i = 32 * it + (lane & 31);
#pragma unroll
        for (int r = 0; r < 16; ++r) { const float v = acc[r] + RED[(tile * 16 + r) * 64 + lane]; const int j = 32 * jt + crow(r, h); acc[r] = (j > i) ? 0.f : v; }
        unsigned char* am = F.ws + WS_AMAT + (size_t)(cid * 4 + hd) * 8192;
#pragma unroll
        for (int s = 0; s < 2; ++s) { const bf16x8 p = pack8(acc, s); *(bf16x8*)(am + (it + 2 * (2 * jt + s)) * 1024 + lane * 16) = p; }
    }
    __syncthreads();
}

constexpr int KS_PITCH = 72, VT_PITCH = 196;
constexpr float LOG2E = 1.4426950408889634f;
constexpr size_t WS_DUMMY = 1600 * MiB;
template <bool SAMPLE, bool DUMMY = false>
__device__ __forceinline__ void swa_unit(Frame& F, int b, int n, int g) {
    const int tid = F.tid, lane = F.lane, wv = F.wave, h = lane >> 5;
    LAS bf16* KS = (LAS bf16*)F.lds; LAS bf16* VT = KS + 192 * KS_PITCH;
    int nk, ntile;
    if (!SAMPLE) {
        nk = 64 * (n + 1 < 3 ? n + 1 : 3); ntile = nk >> 5;
        const int kr0 = b * SEQ + 64 * (n > 2 ? n - 2 : 0);
        for (int task = tid; task < nk * 8; task += NTHR) { const int key = task >> 3, c8 = task & 7;
            *(LAS u32x4*)(KS + key * KS_PITCH + 8 * c8) = *(const u32x4*)(F.PROJ + pj(kr0 + key, C_KB + g * 64 + 8 * c8)); }
        for (int task = tid; task < nk * 8; task += NTHR) { const int kp = task >> 4, dq = task & 15;
            const bf16* vp = F.PROJ + pj(kr0 + 2 * kp, C_VB + g * 64 + 4 * dq);
            const u32x2 a = *(const u32x2*)vp, c = *(const u32x2*)(vp + 256);
            LAS unsigned* o = (LAS unsigned*)(VT + (4 * dq) * VT_PITCH + 2 * kp);
            o[0] = (a.x & 0xffffu) | (c.x << 16); o[VT_PITCH / 2] = (a.x >> 16) | (c.x & 0xffff0000u);
            o[VT_PITCH] = (a.y & 0xffffu) | (c.y << 16); o[3 * (VT_PITCH / 2)] = (a.y >> 16) | (c.y & 0xffff0000u); }
    } else {
        nk = 144; ntile = 5;
        const float* ck = F.in[I_CK]; const float* cv = F.in[I_CV];
        for (int task = tid; task < 160 * 8; task += NTHR) { const int key = task >> 3, t = task & 7; u32x4 o = (u32x4){0u, 0u, 0u, 0u};
            if (key < 128) { const float* p = ck + ((size_t)(b * 128 + key) * 8 + g) * 64; const f32x4 x1 = *(const f32x4*)(p + 4 * t), x2 = *(const f32x4*)(p + 32 + 4 * t);
                o.x = cvtpk(x1.x, x1.y); o.y = cvtpk(x1.z, x1.w); o.z = cvtpk(x2.x, x2.y); o.w = cvtpk(x2.z, x2.w); }
            else if (key < 144) o = *(const u32x4*)(F.PROJ + pj(MP + 16 * b + (key - 128), C_KB + g * 64 + 8 * t));
            *(LAS u32x4*)(KS + key * KS_PITCH + 8 * t) = o; }
        for (int task = tid; task < 80 * 16; task += NTHR) { const int kp = task >> 4, dq = task & 15; unsigned w0 = 0u, w1 = 0u, w2 = 0u, w3 = 0u;
            if (kp < 64) { const float* p = cv + ((size_t)(b * 128 + 2 * kp) * 8 + g) * 64 + 4 * dq; const f32x4 a = *(const f32x4*)p, c = *(const f32x4*)(p + 512);
                w0 = cvtpk(a.x, c.x); w1 = cvtpk(a.y, c.y); w2 = cvtpk(a.z, c.z); w3 = cvtpk(a.w, c.w); }
            else if (kp < 72) { const bf16* vp = F.PROJ + pj(MP + 16 * b + 2 * (kp - 64), C_VB + g * 64 + 4 * dq);
                const u32x2 a = *(const u32x2*)vp, c = *(const u32x2*)(vp + 256);
                w0 = (a.x & 0xffffu) | (c.x << 16); w1 = (a.x >> 16) | (c.x & 0xffff0000u); w2 = (a.y & 0xffffu) | (c.y << 16); w3 = (a.y >> 16) | (c.y & 0xffff0000u); }
            LAS unsigned* o = (LAS unsigned*)(VT + (4 * dq) * VT_PITCH + 2 * kp);
            o[0] = w0; o[VT_PITCH / 2] = w1; o[VT_PITCH] = w2; o[3 * (VT_PITCH / 2)] = w3; }
    }
    __syncthreads();
    const int npass = SAMPLE ? 1 : 2;
    if (!SAMPLE || wv < 4) {
#pragma unroll 1
        for (int pass = 0; pass < npass; ++pass) {
            const int r = lane & 31;
            int head, row;
            if (!SAMPLE) { head = g * 8 + wv; row = b * SEQ + 64 * n + 32 * pass + r; }
            else { head = g * 8 + 2 * wv + (r >> 4); row = MP + 16 * b + (r & 15); }
            const float sink2 = F.in[I_SINK][head] * LOG2E;
            bf16* qptr = F.PROJ + pj(row, C_QB + head * 64);
            bf16x8 qf[4];
#pragma unroll
            for (int t = 0; t < 4; ++t) qf[t] = *(const bf16x8*)(qptr + 16 * t + 8 * h);
            f32x16 st[6];
#pragma unroll
            for (int kt = 0; kt < 6; ++kt) {
#pragma unroll
                for (int rr = 0; rr < 16; ++rr) st[kt][rr] = -INFINITY;
                if (kt < ntile) { f32x16 a;
#pragma unroll
                    for (int rr = 0; rr < 16; ++rr) a[rr] = 0.f;
#pragma unroll
                    for (int t = 0; t < 4; ++t) { const bf16x8 kf = *(const LAS bf16x8*)(KS + (32 * kt + r) * KS_PITCH + 16 * t + 8 * h); a = MFMA32(kf, qf[t], a); }
                    st[kt] = a; } }
            if (SAMPLE) {
#pragma unroll
                for (int rr = 0; rr < 16; ++rr) if (crow(rr, h) >= 16) st[4][rr] = -INFINITY; }
            float m = sink2;
#pragma unroll
            for (int kt = 0; kt < 6; ++kt)
#pragma unroll
                for (int rr = 0; rr < 16; ++rr) m = fmaxf(m, st[kt][rr]);
            m = fmaxf(m, __shfl_xor(m, 32));
            float sum = 0.f;
#pragma unroll
            for (int kt = 0; kt < 6; ++kt)
#pragma unroll
                for (int rr = 0; rr < 16; ++rr) { const float p = __builtin_amdgcn_exp2f(st[kt][rr] - m); st[kt][rr] = p; sum += p; }
            sum += __shfl_xor(sum, 32);
            const float inv = 1.f / (sum + __builtin_amdgcn_exp2f(sink2 - m));
            f32x16 o0, o1;
#pragma unroll
            for (int rr = 0; rr < 16; ++rr) { o0[rr] = 0.f; o1[rr] = 0.f; }
#pragma unroll
            for (int kt = 0; kt < 6; ++kt) if (kt < ntile) {
#pragma unroll
                for (int s = 0; s < 2; ++s) { const bf16x8 pb = pack8(st[kt], s);
                    const LAS bf16* v0 = VT + r * VT_PITCH + 32 * kt + 16 * s + 4 * h; const LAS bf16* v1 = v0 + 32 * VT_PITCH;
                    const u32x2 a0 = *(const LAS u32x2*)v0, a1 = *(const LAS u32x2*)(v0 + 8), c0 = *(const LAS u32x2*)v1, c1 = *(const LAS u32x2*)(v1 + 8);
                    u32x4 va; va.x = a0.x; va.y = a0.y; va.z = a1.x; va.w = a1.y; u32x4 vc; vc.x = c0.x; vc.y = c0.y; vc.z = c1.x; vc.w = c1.y;
                    o0 = MFMA32(__builtin_bit_cast(bf16x8, va), pb, o0); o1 = MFMA32(__builtin_bit_cast(bf16x8, vc), pb, o1); } }
#pragma unroll
            for (int rg = 0; rg < 4; ++rg) { u32x2 w0, w1;
                w0.x = cvtpk(o0[4 * rg] * inv, o0[4 * rg + 1] * inv); w0.y = cvtpk(o0[4 * rg + 2] * inv, o0[4 * rg + 3] * inv);
                w1.x = cvtpk(o1[4 * rg] * inv, o1[4 * rg + 1] * inv); w1.y = cvtpk(o1[4 * rg + 2] * inv, o1[4 * rg + 3] * inv);
                bf16* optr = DUMMY ? (bf16*)(F.ws + WS_DUMMY) + (size_t)(row & 1023) * 4096 + head * 64 : qptr;
                *(u32x2*)(optr + 8 * rg + 4 * h) = w0; *(u32x2*)(optr + 32 + 8 * rg + 4 * h) = w1; }
        }
    }
    __syncthreads();
}

constexpr int P3_CL = 264 * 4, P3_SWAP = 2048, P3_SWAS = 64, P3_UNITS = P3_CL + P3_SWAP + P3_SWAS;
__device__ __forceinline__ void p3_phase(Frame& F) {
    for (int u = F.bid; u < P3_CL; u += F.G) gla_chunk_local(F, u >> 2, u & 3);
#if PROBE_TWICE == 105
    for (int u = F.bid; u < P3_CL; u += F.G) gla_chunk_local(F, u >> 2, u & 3);
#endif
#if PROBE_TWICE == 103
    for (int v = (F.bid + F.G - (P3_CL % F.G)) % F.G; v < P3_SWAP; v += F.G) swa_unit<false, true>(F, v >> 10, (v >> 3) & 127, v & 7);
#endif
    const bool bal = F.G == 256;
    for (int v = (F.bid + F.G - (P3_CL % F.G)) % F.G, k = 0; v < P3_SWAP; v += F.G, ++k) { if (bal && F.bid < 32 && k >= 6) break; swa_unit<false>(F, v >> 10, (v >> 3) & 127, v & 7); }
    if (bal && F.bid >= 96 && F.bid < 160) { const int src = (F.bid - 96) >> 1, v = ((src + F.G - (P3_CL % F.G)) % F.G) + F.G * (6 + ((F.bid - 96) & 1)); swa_unit<false>(F, v >> 10, (v >> 3) & 127, v & 7); }
    for (int v = (F.bid + 2 * F.G - ((P3_CL + P3_SWAP) % F.G)) % F.G; v < P3_SWAS; v += F.G) swa_unit<true>(F, v >> 3, 0, v & 7);
}

__device__ __forceinline__ u32x2 tr_read8(unsigned addr) { u32x2 r; asm volatile("ds_read_b64_tr_b16 %0, %1\n\ts_waitcnt lgkmcnt(0)" : "=&v"(r) : "v"(addr) : "memory"); return r; }
struct ScanQ { bf16x8 qf[2][2][2], af; };
__device__ __forceinline__ void scan_load_q(ScanQ& P, const unsigned char* ws, int cid, int hd, int wv, int lane) {
    const unsigned char* fq = ws + WS_FRAG + (size_t)(cid * 4 + hd) * 131072;
#pragma unroll
    for (int mt = 0; mt < 2; ++mt)
#pragma unroll
        for (int dt = 0; dt < 2; ++dt)
#pragma unroll
            for (int s = 0; s < 2; ++s) P.qf[mt][dt][s] = *(const bf16x8*)(fq + (((wv * 2 + mt) * 2 + dt) * 2 + s) * 1024 + lane * 16);
    P.af = *(const bf16x8*)(ws + WS_AMAT + (size_t)(cid * 4 + hd) * 8192 + wv * 1024 + lane * 16);
}
__device__ __forceinline__ void scan_load_v(u32x4& vt, f32x4& vec, const unsigned char* ws, const bf16* PROJ, int cid, int hd, int row0, int ntok, int e0, int tid) {
    vt = (u32x4){0u, 0u, 0u, 0u}; vec = (f32x4){0.f, 0.f, 0.f, 0.f};
    if (tid < 256) { const int i = tid >> 2, c4 = tid & 3;
        if (i < ntok) vt = *(const u32x4*)(PROJ + pj(row0 + i, C_VA + hd * 1024 + e0 + 8 * c4));
        vec = *(const f32x4*)((const float*)(ws + WS_VEC) + (size_t)(cid * 4 + hd) * 1024 + 4 * tid); }
}
__device__ __forceinline__ void scan_store_v(LAS unsigned char* base, const u32x4& vt, const f32x4& vec, int tid) {
    if (tid < 256) { *(LAS u32x4*)((LAS bf16*)base + (tid >> 2) * 32 + 8 * (tid & 3)) = vt; *(LAS f32x4*)((LAS float*)(base + 4096) + 4 * tid) = vec; }
}
struct ScanK { bf16x8 kf[2][4]; };
__device__ __forceinline__ void scan_load_k(ScanK& P, const unsigned char* ws, int cid, int hd, int wv, int lane) {
    const unsigned char* fk = ws + WS_FRAG + (size_t)(cid * 4 + hd) * 131072 + 65536;
#pragma unroll
    for (int dt = 0; dt < 2; ++dt)
#pragma unroll
        for (int sp = 0; sp < 4; ++sp) P.kf[dt][sp] = *(const bf16x8*)(fk + ((wv * 2 + dt) * 4 + sp) * 1024 + lane * 16);
}
constexpr int SC_BUF = 73728, SC_VEC = 4096, SC_RED = 8192;
struct ScanTr { u32x2 n[8]; };
__device__ __forceinline__ void scan_tr_reads_p(u32x2& p0, u32x2& p1, unsigned aP) {
    asm volatile("ds_read_b64_tr_b16 %0, %2\n\tds_read_b64_tr_b16 %1, %2 offset:512\n\ts_waitcnt lgkmcnt(0)" : "=&v"(p0), "=&v"(p1) : "v"(aP) : "memory");
}
__device__ __forceinline__ void scan_tr_reads_n(ScanTr& T, unsigned aN) {
    asm volatile("ds_read_b64_tr_b16 %0, %8\n\tds_read_b64_tr_b16 %1, %8 offset:256\n\t"
                 "ds_read_b64_tr_b16 %2, %8 offset:1024\n\tds_read_b64_tr_b16 %3, %8 offset:1280\n\t"
                 "ds_read_b64_tr_b16 %4, %8 offset:2048\n\tds_read_b64_tr_b16 %5, %8 offset:2304\n\t"
                 "ds_read_b64_tr_b16 %6, %8 offset:3072\n\tds_read_b64_tr_b16 %7, %8 offset:3328\n\ts_waitcnt lgkmcnt(0)"
                 : "=&v"(T.n[0]), "=&v"(T.n[1]), "=&v"(T.n[2]), "=&v"(T.n[3]), "=&v"(T.n[4]), "=&v"(T.n[5]), "=&v"(T.n[6]), "=&v"(T.n[7])
                 : "v"(aN) : "memory");
}
template <bool DUMMY, int BUF>
__device__ __forceinline__ void scan_reduce(Frame& F, int hd, int row0, int ntok, int e0) {
    const int tid = F.tid; LAS float* RED = (LAS float*)(F.lds + BUF * SC_BUF + SC_RED);
    const int i = tid >> 3, e4 = 4 * (tid & 7); f32x4 sacc = *(const LAS f32x4*)(RED + i * 32 + e4);
#pragma unroll
    for (int w = 1; w < 8; ++w) sacc += *(const LAS f32x4*)(RED + w * 2048 + i * 32 + e4);
    if (i < ntok) { u32x2 o; o.x = cvtpk(sacc.x, sacc.y); o.y = cvtpk(sacc.z, sacc.w);
        bf16* op_ = DUMMY ? (bf16*)(F.ws + WS_DUMMY) + (size_t)((row0 + i) & 1023) * 4096 + hd * 1024 + e0 + e4 : F.PROJ + pj(row0 + i, C_VA + hd * 1024 + e0 + e4);
        *(u32x2*)op_ = o; }
}
template <bool SAMPLE, bool DUMMY, int BUF>
__device__ __forceinline__ void scan_step(Frame& F, f32x16& S0, f32x16& S1, ScanQ& cq, ScanK& ck, int cidn, int hd, int rowp, int rown, int ntok, int e0) {
    const int tid = F.tid, lane = F.lane, wv = F.wave, h = lane >> 5, el = lane & 31;
    LAS unsigned char* base = F.lds + BUF * SC_BUF;
    LAS bf16* VB = (LAS bf16*)base; LAS float* VECL = (LAS float*)(base + SC_VEC); LAS float* RED = (LAS float*)(base + SC_RED);
    __syncthreads();
    u32x4 nvt; f32x4 nvec;
    if (!SAMPLE) scan_load_v(nvt, nvec, F.ws, F.PROJ, cidn, hd, rown, ntok, e0, tid);
    if (!SAMPLE && rowp >= 0) scan_reduce<DUMMY, BUF ^ 1>(F, hd, rowp, ntok, e0);
    const int i16 = lane & 15; const unsigned tro = (unsigned)(size_t)VB + (unsigned)((i16 >> 2) * 64 + 32 * ((lane >> 4) & 1) + 8 * (i16 & 3));
    u32x2 tp0, tp1; scan_tr_reads_p(tp0, tp1, tro + (unsigned)((16 * (wv >> 1) + 4 * h) * 64));
#pragma unroll
    for (int rg = 0; rg < 4; ++rg) { const f32x4 e0v = *(const LAS f32x4*)(VECL + 64 * wv + 8 * rg + 4 * h), e1v = *(const LAS f32x4*)(VECL + 64 * wv + 32 + 8 * rg + 4 * h);
#pragma unroll
        for (int x = 0; x < 4; ++x) { S0[4 * rg + x] *= e0v[x]; S1[4 * rg + x] *= e1v[x]; } }
    bf16x8 vP; { u32x4 vv; vv.x = tp0.x; vv.y = tp0.y; vv.z = tp1.x; vv.w = tp1.y; vP = __builtin_bit_cast(bf16x8, vv); }
    LAS float* rw = RED + wv * 2048;
#pragma unroll
    for (int mt = 0; mt < 2; ++mt) {
        f32x16 op;
#pragma unroll
        for (int r = 0; r < 16; ++r) op[r] = 0.f;
        op = MFMA32(cq.qf[mt][0][0], pack8(S0, 0), op); op = MFMA32(cq.qf[mt][0][1], pack8(S0, 1), op); op = MFMA32(cq.qf[mt][1][0], pack8(S1, 0), op); op = MFMA32(cq.qf[mt][1][1], pack8(S1, 1), op);
        if ((wv & 1) == mt) op = MFMA32(cq.af, vP, op);
#pragma unroll
        for (int r = 0; r < 16; ++r) rw[(32 * mt + crow(r, h)) * 32 + el] = op[r];
    }
    asm volatile("" ::: "memory");
    if (!SAMPLE) scan_load_q(cq, F.ws, cidn, hd, wv, lane);
    ScanTr T; scan_tr_reads_n(T, tro + (unsigned)(8 * h * 64));
#pragma unroll
    for (int sp = 0; sp < 4; ++sp) { u32x4 vv; vv.x = T.n[2 * sp].x; vv.y = T.n[2 * sp].y; vv.z = T.n[2 * sp + 1].x; vv.w = T.n[2 * sp + 1].y;
        const bf16x8 vN = __builtin_bit_cast(bf16x8, vv);
        S0 = MFMA32(ck.kf[0][sp], vN, S0); S1 = MFMA32(ck.kf[1][sp], vN, S1); }
    asm volatile("" ::: "memory");
    if (!SAMPLE) scan_load_k(ck, F.ws, cidn, hd, wv, lane);
#pragma unroll
    for (int rg = 0; rg < 4; ++rg) { const f32x4 e0v = *(const LAS f32x4*)(VECL + 512 + 64 * wv + 8 * rg + 4 * h), e1v = *(const LAS f32x4*)(VECL + 512 + 64 * wv + 32 + 8 * rg + 4 * h);
#pragma unroll
        for (int x = 0; x < 4; ++x) { S0[4 * rg + x] *= e0v[x]; S1[4 * rg + x] *= e1v[x]; } }
    if (!SAMPLE) scan_store_v(F.lds + (BUF ^ 1) * SC_BUF, nvt, nvec, tid);
}
template <bool SAMPLE, bool DUMMY = false>
__device__ __forceinline__ void scan_item(Frame& F, int seq, int slice) {
    const int tid = F.tid, lane = F.lane, wv = F.wave, h = lane >> 5, el = lane & 31;
    const int hd = seq & 3, b = seq >> 2, e0 = slice * 32;
    const int nchunks = SAMPLE ? 1 : 128, cid0 = SAMPLE ? 256 + b : b * 128, ntok = SAMPLE ? 16 : 64, row00 = SAMPLE ? MP + 16 * b : b * SEQ;
    ScanQ qa; ScanK ka;
    scan_load_q(qa, F.ws, cid0, hd, wv, lane);
    scan_load_k(ka, F.ws, cid0, hd, wv, lane);
    { u32x4 vt; f32x4 vec; scan_load_v(vt, vec, F.ws, F.PROJ, cid0, hd, row00, ntok, e0, tid); scan_store_v(F.lds, vt, vec, tid); }
    f32x16 S0, S1;
#pragma unroll
    for (int r = 0; r < 16; ++r) { S0[r] = 0.f; S1[r] = 0.f; }
    if (SAMPLE) { const float* sp = F.in[I_SG] + ((size_t)(b * 4 + hd) * 512 + 64 * wv + 4 * h) * 1024 + e0 + el;
#pragma unroll
        for (int rg = 0; rg < 4; ++rg) {
#pragma unroll
            for (int x = 0; x < 4; ++x) { S0[4 * rg + x] = sp[(size_t)(8 * rg + x) * 1024]; S1[4 * rg + x] = sp[(size_t)(32 + 8 * rg + x) * 1024]; }
            asm volatile("" ::: "memory"); } }
    if (SAMPLE) { scan_step<true, DUMMY, 0>(F, S0, S1, qa, ka, cid0, hd, -1, row00, ntok, e0); __syncthreads(); scan_reduce<DUMMY, 0>(F, hd, row00, ntok, e0); __syncthreads(); }
    else {
#pragma unroll 1
        for (int c = 0; c < nchunks; c += 2) {
            const int c2 = c + 2 < nchunks ? c + 2 : c + 1;
            scan_step<false, DUMMY, 0>(F, S0, S1, qa, ka, cid0 + c + 1, hd, c > 0 ? row00 + 64 * (c - 1) : -1, row00 + 64 * (c + 1), ntok, e0);
            scan_step<false, DUMMY, 1>(F, S0, S1, qa, ka, cid0 + c2, hd, row00 + 64 * c, row00 + 64 * c2, ntok, e0);
        }
        __syncthreads();
        scan_reduce<DUMMY, 1>(F, hd, row00 + 64 * (nchunks - 1), ntok, e0);
        __syncthreads();
    }
    { int h2 = h; asm volatile("" : "+v"(h2));
      float* so = F.out + (SAMPLE ? OUT_SGS : OUT_SGP) + ((size_t)(b * 4 + hd) * 512) * 1024 + e0 + (lane & 31) + (size_t)(64 * wv + 4 * h2) * 1024;
#pragma unroll
      for (int r = 0; r < 16; ++r) { so[(size_t)((r & 3) + 8 * (r >> 2)) * 1024] = S0[r]; so[(size_t)(32 + (r & 3) + 8 * (r >> 2)) * 1024] = S1[r]; } }
}
__device__ __forceinline__ void p4_phase(Frame& F) {
#if PROBE_TWICE == 104
    for (int it = F.bid; it < 256; it += F.G) scan_item<false, true>(F, it >> 5, it & 31);
#endif
    for (int it = F.bid; it < 256; it += F.G) scan_item<false>(F, it & 7, (it >> 3) & 31);
    { int t_ = threadIdx.x; asm volatile("" : "+v"(t_)); F.tid = t_; F.lane = t_ & 63; F.wave = __builtin_amdgcn_readfirstlane(t_ >> 6); }
    for (int it = F.bid; it < 1024; it += F.G) scan_item<true>(F, (it & 7) + 8 * (it >> 8), (it >> 3) & 31);
}

__device__ __forceinline__ void unpack8(const u32x4 w, float (&f)[8]) { f[0] = bflo(w.x); f[1] = bfhi(w.x); f[2] = bflo(w.y); f[3] = bfhi(w.y); f[4] = bflo(w.z); f[5] = bfhi(w.z); f[6] = bflo(w.w); f[7] = bfhi(w.w); }
__device__ __forceinline__ void p5_merge(Frame& F) {
    const int gw = F.bid * NWAVES + F.wave, NGW = F.G * NWAVES, lane = F.lane;
    const float* gg = F.in[I_GGLA] + 16 * lane;
    for (int row = gw; row < MPAD; row += NGW) {
        if (row >= MREAL) {
#pragma unroll
            for (int j = 0; j < 8; ++j) *(u32x4*)((unsigned char*)F.H + pg8::img_off(row, 512 * j + 8 * lane, D / 64, false)) = (u32x4){0u, 0u, 0u, 0u};
            continue; }
#pragma unroll 2
        for (int hd = 0; hd < 4; ++hd) {
            const int c = hd * 1024 + 16 * lane;
            const u32x4 wo0 = *(const u32x4*)(F.PROJ + pj(row, C_VA + c)), wo1 = *(const u32x4*)(F.PROJ + pj(row, C_VA + c) + 8);
            const u32x4 wg0 = *(const u32x4*)(F.PROJ + pj(row, C_GA + c)), wg1 = *(const u32x4*)(F.PROJ + pj(row, C_GA + c) + 8);
            const u32x4 wb0 = *(const u32x4*)(F.PROJ + pj(row, C_ZB + c)), wb1 = *(const u32x4*)(F.PROJ + pj(row, C_ZB + c) + 8);
            const u32x4 wq0 = *(const u32x4*)(F.PROJ + pj(row, C_QB + c)), wq1 = *(const u32x4*)(F.PROJ + pj(row, C_QB + c) + 8);
            float o[16], ga[16], zb[16], ob[16];
#define UP16(dst, w0, w1) { float t[8]; unpack8(w0, t); _Pragma("unroll") for (int x = 0; x < 8; ++x) dst[x] = t[x]; unpack8(w1, t); _Pragma("unroll") for (int x = 0; x < 8; ++x) dst[8 + x] = t[x]; }
            UP16(o, wo0, wo1)
            float ss = 0.f;
#pragma unroll
            for (int x = 0; x < 16; ++x) ss += o[x] * o[x];
            const float r = 1.0f / sqrtf(wave_sum(ss) * (1.f / 1024.f) + NORM_EPS);
            UP16(ga, wg0, wg1) UP16(zb, wb0, wb1) UP16(ob, wq0, wq1)
#undef UP16
            float mg[16];
#pragma unroll
            for (int x = 0; x < 16; ++x) mg[x] = (o[x] * r * gg[x]) * ga[x] + zb[x] * ob[x];
            u32x4 w0, w1; w0.x = cvtpk(mg[0], mg[1]); w0.y = cvtpk(mg[2], mg[3]); w0.z = cvtpk(mg[4], mg[5]); w0.w = cvtpk(mg[6], mg[7]);
            w1.x = cvtpk(mg[8], mg[9]); w1.y = cvtpk(mg[10], mg[11]); w1.z = cvtpk(mg[12], mg[13]); w1.w = cvtpk(mg[14], mg[15]);
            *(u32x4*)((unsigned char*)F.H + pg8::img_off(row, c, D / 64, false)) = w0; *(u32x4*)((unsigned char*)F.H + pg8::img_off(row, c + 8, D / 64, false)) = w1;
        }
    }
}

template <int MODE> struct EpiRes {
    static constexpr bool PERM = true;
    const float* srcf; const bf16* srcb; float* outf; bf16* outb; const float* mod; int off_gt;
    __device__ __forceinline__ void operator()(const f32x4 (&acc)[2][2][4][2], const pg8::Unit& u, int wr, int wc, int fr, int fq) const {
        const int col0 = u.pn * 256 + wc * 32 + 8 * fq;
        const float* gt = mod + (size_t)(u.pm >> 5) * NMOD + off_gt + col0;
        f32x4 g[2][2];
#pragma unroll
        for (int bj = 0; bj < 2; ++bj)
#pragma unroll
            for (int n = 0; n < 2; ++n) g[bj][n] = *(const f32x4*)(gt + bj * 128 + n * 4);
#pragma unroll
        for (int ai = 0; ai < 2; ++ai) {
            const size_t rbase = (size_t)(u.pm * 256 + ai * 128 + wr * 64 + fr) * D + col0;
            if (MODE == 0) {
                f32x4 x[4][2][2];
#pragma unroll
                for (int m = 0; m < 4; ++m)
#pragma unroll
                    for (int bj = 0; bj < 2; ++bj)
#pragma unroll
                        for (int n = 0; n < 2; ++n) x[m][bj][n] = *(const f32x4*)(srcf + rbase + (size_t)(m * 16) * D + bj * 128 + n * 4);
#pragma unroll
                for (int m = 0; m < 4; ++m)
#pragma unroll
                    for (int bj = 0; bj < 2; ++bj) { const f32x4 a = x[m][bj][0] + g[bj][0] * acc[ai][bj][m][0], b = x[m][bj][1] + g[bj][1] * acc[ai][bj][m][1];
                        u32x4 w; w.x = cvtpk(a.x, a.y); w.y = cvtpk(a.z, a.w); w.z = cvtpk(b.x, b.y); w.w = cvtpk(b.z, b.w);
                        *(u32x4*)(outb + rbase + (size_t)(m * 16) * D + bj * 128) = w; }
            } else {
                u32x4 x[4][2];
#pragma unroll
                for (int m = 0; m < 4; ++m)
#pragma unroll
                    for (int bj = 0; bj < 2; ++bj) x[m][bj] = *(const u32x4*)(srcb + rbase + (size_t)(m * 16) * D + bj * 128);
#pragma unroll
                for (int m = 0; m < 4; ++m)
#pragma unroll
                    for (int bj = 0; bj < 2; ++bj) { const u32x4 w = x[m][bj];
                        const f32x4 xa = (f32x4){bflo(w.x), bfhi(w.x), bflo(w.y), bfhi(w.y)}, xb = (f32x4){bflo(w.z), bfhi(w.z), bflo(w.w), bfhi(w.w)};
                        const f32x4 a = xa + g[bj][0] * acc[ai][bj][m][0], b = xb + g[bj][1] * acc[ai][bj][m][1];
                        u32x4 o; o.x = cvtpk(a.x, a.y); o.y = cvtpk(a.z, a.w); o.z = cvtpk(b.x, b.y); o.w = cvtpk(b.z, b.w);
                        *(u32x4*)(outb + rbase + (size_t)(m * 16) * D + bj * 128) = o; }
            }
        }
    }
};
struct EpiPart {
    static constexpr bool PERM = true;
    float* PART;
    __device__ __forceinline__ void operator()(const f32x4 (&acc)[2][2][4][2], const pg8::Unit& u, int wr, int wc, int fr, int fq) const {
        float* base = PART + ((size_t)u.sp * MS + wr * 64 + fr) * D + u.pn * 256 + wc * 32 + 8 * fq;
#pragma unroll
        for (int m = 0; m < 4; ++m)
#pragma unroll
            for (int bj = 0; bj < 2; ++bj)
#pragma unroll
                for (int n = 0; n < 2; ++n) *(f32x4*)(base + (size_t)(m * 16) * D + bj * 128 + n * 4) = acc[0][bj][m][n];
    }
};
template <int MODE>
__device__ __forceinline__ void skinny_reduce(Frame& F, const float* PART, const float* srcf, bf16* xb, int off_gt) {
    for (int it = F.bid * NTHR + F.tid; it < MS * D / 4; it += F.G * NTHR) {
        const int r = it >> 10, c = (it & 1023) * 4, row = MP + r;
        f32x4 p[16];
#pragma unroll
        for (int k = 0; k < 16; ++k) p[k] = *(const f32x4*)(PART + ((size_t)k * MS + r) * D + c);
        f32x4 x;
        if (MODE == 0) x = *(const f32x4*)(srcf + (size_t)r * D + c);
        else { const u32x2 w = *(const u32x2*)(xb + (size_t)row * D + c); x = (f32x4){bflo(w.x), bfhi(w.x), bflo(w.y), bfhi(w.y)}; }
        const f32x4 g = *(const f32x4*)(F.MOD + (size_t)row_batch(row) * NMOD + off_gt + c);
        f32x4 s = ((p[0] + p[1]) + (p[2] + p[3])) + ((p[4] + p[5]) + (p[6] + p[7]));
        s += ((p[8] + p[9]) + (p[10] + p[11])) + ((p[12] + p[13]) + (p[14] + p[15]));
        x += g * s;
        u32x2 o; o.x = cvtpk(x.x, x.y); o.y = cvtpk(x.z, x.w); *(u32x2*)(xb + (size_t)row * D + c) = o;
    }
}
template <int K, int MODE, bool BIMG, bool AIMG>
__device__ __forceinline__ void skinny_res(Frame& F, const bf16* A, const bf16* Bt, const float* srcf, const bf16* srcb, float* dstf, bf16* dstb, int off_gt) {
    const int lane = F.lane, wv = F.wave, fr = lane & 15, fq = lane >> 4;
    for (int nb = F.bid; nb < D / 16; nb += F.G) {
        const bf16* ap = A + (size_t)(MP + 16 * wv + fr) * K + 8 * fq;
        const int nrow = 16 * nb + fr;
        int sl = nrow & 127; { const int m = sl & 31; sl = (sl & ~31) + 16 * ((m >> 2) & 1) + 4 * (m >> 3) + (m & 3); }
        const unsigned char* bimg = (const unsigned char*)Bt + (size_t)(nrow >> 7) * (K / 64) * (size_t)pg8::HTB;
        const int oc0 = pg8::lds_byte(sl, 8 * fq), oc1 = pg8::lds_byte(sl, 32 + 8 * fq);
        const bf16* bp = Bt + (size_t)nrow * K + 8 * fq;
        const int arow = MP + 16 * wv + fr;
        const unsigned char* aimg = (const unsigned char*)A + (size_t)(arow >> 7) * (K / 64) * (size_t)pg8::HTB;
        const int ac0 = pg8::lds_byte(arow & 127, 8 * fq), ac1 = pg8::lds_byte(arow & 127, 32 + 8 * fq);
#define SK_ALOAD(kk, u) (AIMG ? *(const bf16x8*)(aimg + (size_t)(((kk) >> 6) + ((u) >> 1)) * pg8::HTB + (((u) & 1) ? ac1 : ac0)) : *(const bf16x8*)(ap + (kk) + 32 * (u)))
#define SK_BLOAD(kk, u) (BIMG ? *(const bf16x8*)(bimg + (size_t)(((kk) >> 6) + ((u) >> 1)) * pg8::HTB + (((u) & 1) ? oc1 : oc0)) : *(const bf16x8*)(bp + (kk) + 32 * (u)))
        f32x4 acc0 = (f32x4){0.f, 0.f, 0.f, 0.f}, acc1 = acc0;
        bf16x8 a[8], b[8], a2[8], b2[8];
#pragma unroll
        for (int u = 0; u < 8; ++u) { a[u] = SK_ALOAD(0, u); b[u] = SK_BLOAD(0, u); }
#pragma unroll 1
        for (int k = 0; k < K; k += 512) {
            const int k1 = k + 256 < K ? k + 256 : k, k2 = k + 512 < K ? k + 512 : k1;
#pragma unroll
            for (int u = 0; u < 8; ++u) { a2[u] = SK_ALOAD(k1, u); b2[u] = SK_BLOAD(k1, u); }
#pragma unroll
            for (int u = 0; u < 8; u += 2) { acc0 = __builtin_amdgcn_mfma_f32_16x16x32_bf16(b[u], a[u], acc0, 0, 0, 0); acc1 = __builtin_amdgcn_mfma_f32_16x16x32_bf16(b[u + 1], a[u + 1], acc1, 0, 0, 0); }
#pragma unroll
            for (int u = 0; u < 8; ++u) { a[u] = SK_ALOAD(k2, u); b[u] = SK_BLOAD(k2, u); }
            if (k + 256 < K) {
#pragma unroll
                for (int u = 0; u < 8; u += 2) { acc0 = __builtin_amdgcn_mfma_f32_16x16x32_bf16(b2[u], a2[u], acc0, 0, 0, 0); acc1 = __builtin_amdgcn_mfma_f32_16x16x32_bf16(b2[u + 1], a2[u + 1], acc1, 0, 0, 0); } }
        }
        const int row = MP + 16 * wv + fr, col = 16 * nb + 4 * fq;
        const f32x4 g = *(const f32x4*)(F.MOD + (size_t)row_batch(row) * NMOD + off_gt + col), r = g * (acc0 + acc1);
        if (MODE == 0) { const f32x4 x = *(const f32x4*)(srcf + (size_t)(row - MP) * D + col) + r; u32x2 w; w.x = cvtpk(x.x, x.y); w.y = cvtpk(x.z, x.w); *(u32x2*)(dstb + (size_t)row * D + col) = w; }
        else { const u32x2 w = *(const u32x2*)(srcb + (size_t)row * D + col); const f32x4 x = (f32x4){bflo(w.x), bfhi(w.x), bflo(w.y), bfhi(w.y)} + r;
            u32x2 o; o.x = cvtpk(x.x, x.y); o.y = cvtpk(x.z, x.w); *(u32x2*)(dstb + (size_t)row * D + col) = o; }
    }
}

struct EpiGU {
    static constexpr bool PERM = true;
    bf16* ACT;
    __device__ __forceinline__ void operator()(const f32x4 (&acc)[2][2][4][2], const pg8::Unit& u, int wr, int wc, int fr, int fq) const {
#pragma unroll
        for (int ai = 0; ai < 2; ++ai)
#pragma unroll
            for (int m = 0; m < 4; ++m) {
                const int row = u.pm * 256 + ai * 128 + wr * 64 + m * 16 + fr;
                const f32x4 g0 = acc[ai][0][m][0], g1 = acc[ai][0][m][1], u0 = acc[ai][1][m][0], u1 = acc[ai][1][m][1];
                float a[8];
#pragma unroll
                for (int x = 0; x < 4; ++x) { a[x] = g0[x] * sigmoidf_(g0[x]) * u0[x]; a[4 + x] = g1[x] * sigmoidf_(g1[x]) * u1[x]; }
                u32x4 w; w.x = cvtpk(a[0], a[1]); w.y = cvtpk(a[2], a[3]); w.z = cvtpk(a[4], a[5]); w.w = cvtpk(a[6], a[7]);
                *(u32x4*)((unsigned char*)ACT + pg8::img_off(row, u.pn * 128 + wc * 32 + 8 * fq, DFF / 64, false)) = w;
            }
    }
};
__device__ __forceinline__ void p10_proc(const Frame& F, int row, const NormRaw<true>& R) {
    GAS f32x4* yr = (GAS f32x4*)(F.out + (size_t)row * D) + F.lane;
    f32x4 v[16]; float s = 0.f;
#pragma unroll
    for (int j = 0; j < 16; ++j) { const u32x2 w = R.v[j]; v[j] = (f32x4){bflo(w.x), bfhi(w.x), bflo(w.y), bfhi(w.y)}; s += (v[j].x * v[j].x + v[j].y * v[j].y) + (v[j].z * v[j].z + v[j].w * v[j].w); }
    const float r = 1.0f / sqrtf(wave_sum(s) * (1.f / D) + NORM_EPS);
#pragma unroll
    for (int j = 0; j < 16; ++j) { const f32x4 gg = *(const f32x4*)(F.in[I_GF] + 256 * j + 4 * F.lane); yr[64 * j] = (v[j] * r) * gg; }
}
__device__ __forceinline__ void p10_final(Frame& F, const bf16* X2B) {
    const int gw = F.bid * NWAVES + F.wave, NGW = F.G * NWAVES;
    int row = gw; if (row >= MREAL) return;
    NormRaw<true> A, B;
    norm_load<true>(F, row, nullptr, nullptr, X2B, A);
    for (;;) {
        if (row + NGW < MREAL) norm_load<true>(F, row + NGW, nullptr, nullptr, X2B, B);
        p10_proc(F, row, A);
        row += NGW; if (row >= MREAL) break;
        if (row + NGW < MREAL) norm_load<true>(F, row + NGW, nullptr, nullptr, X2B, A);
        p10_proc(F, row, B);
        row += NGW; if (row >= MREAL) break;
    }
}

#if DBG_CHECK
__device__ __forceinline__ unsigned hash32(unsigned x) { x ^= x >> 16; x *= 0x7feb352du; x ^= x >> 15; x *= 0x846ca68bu; x ^= x >> 16; return x; }
__device__ __forceinline__ void dbg_report(Frame& F, int k, float e) { if (!(e == e) || e > 1e30f) e = 1e30f; atomicMax((unsigned*)F.DBG + k, __float_as_uint(e)); }
__device__ __forceinline__ float relerr(float got, float ref, float floor_) { return fabsf(got - ref) / (fabsf(ref) + floor_); }
__device__ __forceinline__ int win_fwd(int c) {
    if (c < 12288) return c;
    if (c < 12304) return 25600 + (c - 12288);
    if (c < 16912) { const bool isq = c < 16400; const int r = c - (isq ? 12304 : 16400), hh = r >> 6, d = r & 63;
        const int t = (d & 31) >> 2, e = (d & 3) + 4 * (d >> 5); return (isq ? 12288 : 16384) + 64 * hh + 8 * t + e; }
    return c - 16;
}
__device__ __forceinline__ int win_fwd_w(int c) {
    if (c >= 8192 && c < 12288) { const int i = c - 8192, ct = i >> 7; return (ct < 16 ? 8192 + 256 * ct : 17408 + 256 * (ct - 16)) + (i & 127); }
    if (c >= 17424 && c < 21520) { const int i = c - 17424, ct = i >> 7; return (ct < 16 ? 8192 + 256 * ct : 17408 + 256 * (ct - 16)) + 128 + (i & 127); }
    return win_fwd(c);
}
__device__ __forceinline__ int wgu_fwd(int c) { if (c < DFF) return 256 * (c >> 7) + (c & 127); const int c2 = c - DFF; return 256 * (c2 >> 7) + 128 + (c2 & 127); }
__device__ __forceinline__ float silu_ref(float x) { return x / (1.f + expf(-x)); }
__device__ __forceinline__ float cvec(const Frame& F, int b, int k) { return b < 2 ? F.in[I_CP][b * D + k] : F.in[I_CS][(b - 2) * D + k]; }
__device__ __forceinline__ float bfround(float x) { return bflo(cvtpk(x, 0.f)); }
__device__ __forceinline__ float dbg_h(const Frame& F, int row, int k) { return bf2f(*(const bf16*)((const unsigned char*)F.H + pg8::img_off(row, k & ~7, D / 64, false) + 2 * (k & 7))); }

__device__ __forceinline__ void dbg_check_p0p1(Frame& F) {
    const int gt = F.bid * NTHR + F.tid;
    if (gt < 512) {
        const unsigned h = hash32(gt * 7919u + 13u); const int b = gt % 10, col = (int)(h % NMOD);
        float s = 0.f; for (int k = 0; k < D; ++k) s += silu_ref(cvec(F, b, k)) * F.in[I_WADA][(size_t)k * NMOD + col];
        s += F.in[I_BADA][col];
        dbg_report(F, 0, relerr(F.MOD[b * NMOD + col], s, 0.05f));
    } else if (gt < 1024) {
        const unsigned h = hash32(gt * 31u + 5u); const int pos = (int)(h % 8192u), f = (int)((h >> 16) % 32u);
        const double inv = pow(10000.0, -(double)f / 32.0), a = (double)pos * inv;
        dbg_report(F, 1, fmaxf(fabsf(F.ROPEC[pos * 32 + f] - (float)cos(a)), fabsf(F.ROPES[pos * 32 + f] - (float)sin(a))) * 0.2f);
    } else if (gt < 1024 + 4096) {
        const int i = gt - 1024; const unsigned h = hash32(i * 2654435761u + 77u), h2 = hash32(h + 12345u);
        const int which = 0; float ref, got;
        if (which == 0) { const int k = (int)(h % D), c = (int)(h2 % N_IN); ref = bfround(F.in[I_WIN][(size_t)k * N_IN + c]); got = bf2f(*(const bf16*)((const unsigned char*)F.WIN + pg8::img_off(win_fwd_w(c), k & ~7, D / 64, true) + 2 * (k & 7))); }
        else if (which == 1) { const int k = (int)(h % D), c = (int)(h2 % D); ref = bfround(F.in[I_WOUT][(size_t)k * D + c]); got = bf2f(*(const bf16*)((const unsigned char*)F.WOUT + pg8::img_off(c, k & ~7, D / 64, true) + 2 * (k & 7))); }
        else if (which == 2) { const int k = (int)(h % D), c = (int)(h2 % N_GU); ref = bfround(F.in[I_WGU][(size_t)k * N_GU + c]); got = bf2f(*(const bf16*)((const unsigned char*)F.WGU + pg8::img_off(wgu_fwd(c), k & ~7, D / 64, true) + 2 * (k & 7))); }
        else { const int k = (int)(h % DFF), c = (int)(h2 % D); ref = bfround(F.in[I_WDN][(size_t)k * D + c]); got = bf2f(*(const bf16*)((const unsigned char*)F.WDN + pg8::img_off(c, k & ~7, DFF / 64, true) + 2 * (k & 7))); }
        dbg_report(F, 2, fabsf(got - ref) * 100.f);
        if (i < 240) { const int k = (int)(h % D); dbg_report(F, 2, fabsf(bf2f(*(const bf16*)((const unsigned char*)F.WIN + pg8::img_off(25616 + i, k & ~7, D / 64, true) + 2 * (k & 7)))) * 100.f); }
    } else if (gt < 1024 + 4096 + 96) {
        const int i = gt - 5120; const unsigned h = hash32(i * 977u + 3u);
        const int row = i < 64 ? (int)(h % MP) : (i < 88 ? MP + (int)(h % MS) : MREAL + (int)(h % 128u));
        if (row >= MREAL) { float m = 0.f; for (int c = 0; c < D; ++c) m = fmaxf(m, fabsf(dbg_h(F, row, c))); dbg_report(F, 3, m); }
        else { const float* x = x_row(F, row); float s = 0.f; for (int c = 0; c < D; ++c) s += x[c] * x[c];
            const float r = 1.f / sqrtf(s / D + NORM_EPS); const float* mod = F.MOD + row_batch(row) * NMOD; float e = 0.f;
            for (int c = 0; c < D; ++c) { const float y = x[c] * r * F.in[I_G1][c] * (1.f + mod[D + c]) + mod[c]; e = fmaxf(e, relerr(dbg_h(F, row, c), y, 0.2f)); }
            dbg_report(F, 3, e); }
    }
}
__device__ __forceinline__ float dbg_dot_h_win(Frame& F, int row, int c) { float s = 0.f; const float* w = F.in[I_WIN] + c; for (int k = 0; k < D; ++k) s += dbg_h(F, row, k) * w[(size_t)k * N_IN]; return s; }
__device__ __forceinline__ void dbg_check_p2(Frame& F) {
    const int gt = F.bid * NTHR + F.tid;
    if (gt >= 2048) return;
    const unsigned h = hash32(gt * 2246822519u + 99u), h2 = hash32(h ^ 0x9e3779b9u);
    int row = (gt & 7) == 7 ? MP + (int)(h % MS) : (int)(h % MP);
    int c;
    const int cls = gt % 5;
    if (cls == 0) c = (int)(h2 % N_IN); else if (cls == 1) c = O_QB + (int)(h2 % 4096u); else if (cls == 2) c = O_KB + (int)(h2 % 512u); else if (cls == 3) c = O_VB + (int)(h2 % 512u); else c = O_RA + (int)(h2 % 16u);
    if (gt >= 1024) {
        if (cls != 2 && cls != 3) return;
        if (gt & 8) { const int b = (h >> 3) & 1, tt = 8064 + (int)((h >> 8) % 128u); row = b * 8192 + tt; } else row = MP + (int)(h % MS);
    }
    const bool isq = c >= O_QB && c < O_KB, isk = c >= O_KB && c < O_VB, isv = c >= O_VB && c < O_VB + 512;
    float ref;
    if (isq || isk) { const int base = isq ? O_QB : O_KB, r = c - base, hh = r >> 6, d = r & 63, dl = d & 31;
        const float x1 = dbg_dot_h_win(F, row, base + 64 * hh + dl), x2 = dbg_dot_h_win(F, row, base + 64 * hh + dl + 32);
        const double inv = pow(10000.0, -(double)dl / 32.0), a = (double)row_pos(row) * inv; const float cs = (float)cos(a), sn = (float)sin(a);
        ref = d < 32 ? x1 * cs - x2 * sn : x2 * cs + x1 * sn; }
    else ref = dbg_dot_h_win(F, row, c);
    if (gt < 1024) {
        int pc = win_fwd(c);
        if ((c >= 8192 && c < 12288) || (c >= 17424 && c < 21520)) { const int i = c >= 17424 ? c - 17424 : c - 8192; const float gv = dbg_dot_h_win(F, row, 8192 + i), zv = dbg_dot_h_win(F, row, 17424 + i);
            ref = silu_ref(gv) / (1.f + expf(-zv)); pc = C_GA + i; }
        else if (c >= 21520) ref = 1.f / (1.f + expf(-ref));
        const float got = bf2f(F.PROJ[pj(row, pc)]); dbg_report(F, 4, relerr(got, isq ? ref * QSCALE : ref, 1.0f)); }
    else { const int r = c - (isk ? O_KB : O_VB), g = r >> 6, d = r & 63; long o;
        if (row < MP) o = (isk ? OUT_KP : OUT_VP) + ((long)(((row >> 13) * 128 + ((row & 8191) - 8064)) * 8 + g)) * 64 + d;
        else { const int r2 = row - MP; o = (isk ? OUT_KS : OUT_VS) + ((long)(((r2 >> 4) * 16 + (r2 & 15)) * 8 + g)) * 64 + d; }
        dbg_report(F, 5, relerr(F.out[o], ref, 1.0f)); }
}
__device__ __forceinline__ float logsig_ref(float x) { return x < 0.f ? x - log1pf(expf(x)) : -log1pf(expf(-x)); }
__device__ __forceinline__ float dbg_bcum(Frame& F, int row0, int ntok, int hd, int d, int upto) {
    float bc = 0.f; const float bias = F.in[I_BGK][hd * 512 + d];
    for (int t = 0; t <= upto && t < ntok; ++t) { float gk = bias; const bf16* ra = F.PROJ + pj(row0 + t, C_RA);
        for (int r = 0; r < 16; ++r) gk += bf2f(ra[r]) * F.in[I_WGK][r * 2048 + hd * 512 + d];
        bc += logsig_ref(gk) * (1.f / 16.f); }
    return bc;
}
__device__ __forceinline__ float dbg_qfrag(Frame& F, int cid, int hd, int i, int d) { const int w = d >> 6, dl = d & 63, dt = dl >> 5, r32 = dl & 31, s = r32 >> 4, r16 = r32 & 15, h = (r16 >> 2) & 1, jj = (r16 & 3) + 4 * (r16 >> 3);
    const int mt = i >> 5, ln = (i & 31) + 32 * h, fb = ((w * 2 + mt) * 2 + dt) * 2 + s; return bf2f(((const bf16*)(F.ws + WS_FRAG + (size_t)(cid * 4 + hd) * 131072))[fb * 512 + ln * 8 + jj]); }
__device__ __forceinline__ float dbg_kfrag(Frame& F, int cid, int hd, int j, int d) { const int w = d >> 6, dt = (d >> 5) & 1, dl = d & 31, sp = j >> 4, h = (j >> 3) & 1, jj = j & 7;
    const int ln = dl + 32 * h, fb = (w * 2 + dt) * 4 + sp; return bf2f(((const bf16*)(F.ws + WS_FRAG + (size_t)(cid * 4 + hd) * 131072 + 65536))[fb * 512 + ln * 8 + jj]); }
__device__ __forceinline__ float dbg_afrag(Frame& F, int cid, int hd, int i, int j) { const int it = i >> 5, jt = j >> 5, jl = j & 31, s = jl >> 4, r16 = jl & 15, h = (r16 >> 2) & 1, jj = (r16 & 3) + 4 * (r16 >> 3);
    const int blk = it + 2 * (2 * jt + s), ln = (i & 31) + 32 * h; return bf2f(((const bf16*)(F.ws + WS_AMAT + (size_t)(cid * 4 + hd) * 8192))[blk * 512 + ln * 8 + jj]); }
__device__ __forceinline__ void dbg_check_cl(Frame& F) {
    const int gt = F.bid * NTHR + F.tid;
    if (gt >= 2048) return;
    const unsigned hs = hash32(gt * 40503u + 17u), h2 = hash32(hs + 0x51ed27u);
    const int cid = (gt & 7) == 7 ? 256 + (int)(hs % 8u) : (int)(hs % 256u), hd = (int)((hs >> 8) & 3u);
    const int ntok = cid < 256 ? 64 : 16, row0 = cid < 256 ? cid * 64 : MP + 16 * (cid - 256), mid = ntok >> 1;
    const int i = (int)((hs >> 10) % (unsigned)ntok), j = (int)((h2) % (unsigned)ntok), d = (int)((h2 >> 8) % 512u);
    if (gt >= 256) {
        const float bi = dbg_bcum(F, row0, ntok, hd, d, i), bj = dbg_bcum(F, row0, ntok, hd, d, j), bm = dbg_bcum(F, row0, ntok, hd, d, mid), bl = dbg_bcum(F, row0, ntok, hd, d, 63);
        const float q = bf2f(F.PROJ[pj(row0 + i, C_QA + hd * 512 + d)]), k = bf2f(F.PROJ[pj(row0 + j, C_KA + hd * 512 + d)]);
        dbg_report(F, 6, relerr(dbg_qfrag(F, cid, hd, i, d), q * GLA_QSCALE * expf(bi - bm), 0.02f));
        dbg_report(F, 6, relerr(dbg_kfrag(F, cid, hd, j, d), k * expf(bm - bj), 0.3f));
        const float* VEC = (const float*)(F.ws + WS_VEC) + (size_t)(cid * 4 + hd) * 1024;
        dbg_report(F, 6, relerr(VEC[d], expf(bm), 0.01f)); dbg_report(F, 6, relerr(VEC[512 + d], expf(bl - bm), 0.01f));
        if (cid >= 256) { dbg_report(F, 6, fabsf(dbg_qfrag(F, cid, hd, 16 + (i % 48), d))); dbg_report(F, 6, fabsf(dbg_kfrag(F, cid, hd, 16 + (j % 48), d))); }
    } else {
        float s = 0.f;
        for (int dd = 0; dd < 512; ++dd) { float bi = 0.f, bj = 0.f, bm = 0.f, bc = 0.f; const float bias = F.in[I_BGK][hd * 512 + dd];
            for (int t = 0; t < ntok; ++t) { float gk = bias; const bf16* ra = F.PROJ + pj(row0 + t, C_RA);
                for (int r = 0; r < 16; ++r) gk += bf2f(ra[r]) * F.in[I_WGK][r * 2048 + hd * 512 + dd];
                bc += logsig_ref(gk) * (1.f / 16.f); if (t == i) bi = bc; if (t == j) bj = bc; if (t == mid) bm = bc; }
            const float q = bf2f(F.PROJ[pj(row0 + i, C_QA + hd * 512 + dd)]), k = bf2f(F.PROJ[pj(row0 + j, C_KA + hd * 512 + dd)]);
            s += bfround(q * GLA_QSCALE * expf(bi - bm)) * bfround(k * expf(bm - bj)); }
        if (j > i) s = 0.f;
        dbg_report(F, 6, relerr(dbg_afrag(F, cid, hd, i, j), s, 0.1f));
    }
}
__device__ __forceinline__ void dbg_check_swa(Frame& F) {
    LAS float* part = (LAS float*)F.lds;
    LAS float* qh = part + 512;
    LAS float* lg = qh + 64;
    LAS float* sm = lg + 192;
    const int tid = F.tid; const unsigned hs = hash32(F.bid * 7349u + 1234567u);
    const bool smp = (F.bid & 3) == 3;
    int row, b, tt;
    if (!smp) { b = hs & 1; tt = (F.bid & 7) == 0 ? (int)((hs >> 4) % 128u) : (int)((hs >> 4) % 8192u); row = b * SEQ + tt; } else { b = (hs >> 1) & 7; tt = (hs >> 4) & 15; row = MP + 16 * b + tt; }
    const int head = (int)((hs >> 20) & 63u), g = head >> 3;
    { const int d = tid >> 3, pt = tid & 7; float s = 0.f; const float* w = F.in[I_WIN] + O_QB + head * 64 + d;
      for (int k = 512 * pt; k < 512 * pt + 512; ++k) s += dbg_h(F, row, k) * w[(size_t)k * N_IN];
      part[d * 8 + pt] = s; }
    __syncthreads();
    float xq = 0.f; if (tid < 64) { for (int p = 0; p < 8; ++p) xq += part[tid * 8 + p]; }
    __syncthreads();
    if (tid < 64) part[tid] = xq;
    __syncthreads();
    if (tid < 64) { const int dl = tid & 31; const double inv = pow(10000.0, -(double)dl / 32.0), a = (double)row_pos(row) * inv; const float cs = (float)cos(a), sn = (float)sin(a);
        const float x1 = part[dl], x2 = part[dl + 32]; qh[tid] = (tid < 32 ? x1 * cs - x2 * sn : x2 * cs + x1 * sn) * QSCALE; }
    __syncthreads();
    int nk, kr0 = 0;
    if (!smp) { const int n = tt >> 6; nk = 64 * (n + 1 < 3 ? n + 1 : 3); kr0 = b * SEQ + 64 * (n > 2 ? n - 2 : 0); } else nk = 144;
    if (tid < nk) { float s = 0.f;
        for (int d = 0; d < 64; ++d) { float kv;
            if (smp && tid < 128) kv = bfround(F.in[I_CK][((size_t)(b * 128 + tid) * 8 + g) * 64 + d]);
            else { const int krow = smp ? MP + 16 * b + (tid - 128) : kr0 + tid; const int p = 8 * ((d & 31) >> 2) + (d & 3) + 4 * (d >> 5); kv = bf2f(F.PROJ[pj(krow, C_KB + g * 64 + p)]); }
            s += qh[d] * kv; }
        lg[tid] = s; }
    __syncthreads();
    if (tid == 0) { const float sk = F.in[I_SINK][head] * LOG2E; float m = sk; for (int k = 0; k < nk; ++k) m = fmaxf(m, lg[k]); float su = exp2f(sk - m); for (int k = 0; k < nk; ++k) su += exp2f(lg[k] - m); sm[0] = m; sm[1] = su; }
    __syncthreads();
    if (tid < 64) { float o = 0.f; const float m = sm[0];
        for (int k = 0; k < nk; ++k) { float vv;
            if (smp && k < 128) vv = bfround(F.in[I_CV][((size_t)(b * 128 + k) * 8 + g) * 64 + tid]);
            else { const int krow = smp ? MP + 16 * b + (k - 128) : kr0 + k; vv = bf2f(F.PROJ[pj(krow, C_VB + g * 64 + tid)]); }
            o += exp2f(lg[k] - m) * vv; }
        o /= sm[1];
        dbg_report(F, 7, relerr(bf2f(F.PROJ[pj(row, C_QB + head * 64 + tid)]), o, 0.3f)); }
    __syncthreads();
}
constexpr size_t WS_DBGV = 1596 * MiB;
__device__ __forceinline__ void dbg_check_scan(Frame& F) {
    LAS float* red = (LAS float*)F.lds;
    const int tid = F.tid; const unsigned hs = hash32(F.bid * 92821u + 777u);
    const bool smp = (F.bid & 1) == 1;
    const int b = smp ? (int)((hs >> 2) & 7u) : (int)((hs >> 2) & 1u), hd = (int)((hs >> 6) & 3u), e = (int)((hs >> 8) & 1023u);
    const int T = smp ? 16 : SEQ, row00 = smp ? MP + 16 * b : b * SEQ;
    float* vcol = (float*)(F.ws + WS_DBGV) + (size_t)F.bid * SEQ;
    for (int t = tid; t < T; t += NTHR) { float s = 0.f; const float* w = F.in[I_WIN] + C_VA + hd * 1024 + e;
        for (int k = 0; k < D; ++k) s += dbg_h(F, row00 + t, k) * w[(size_t)k * N_IN];
        vcol[t] = s; }
    __syncthreads();
    const int d = tid; float wg[16];
#pragma unroll
    for (int r = 0; r < 16; ++r) wg[r] = F.in[I_WGK][r * 2048 + hd * 512 + d];
    const float bias = F.in[I_BGK][hd * 512 + d];
    float S = smp ? F.in[I_SG][((size_t)(b * 4 + hd) * 512 + d) * 1024 + e] : 0.f;
    for (int t = 0; t < T; ++t) {
        const int row = row00 + t;
        const u32x4 ra0 = *(const u32x4*)(F.PROJ + pj(row, C_RA)), ra1 = *(const u32x4*)(F.PROJ + pj(row, C_RA) + 8);
        float gk = bias + bflo(ra0.x) * wg[0] + bfhi(ra0.x) * wg[1] + bflo(ra0.y) * wg[2] + bfhi(ra0.y) * wg[3] + bflo(ra0.z) * wg[4] + bfhi(ra0.z) * wg[5] + bflo(ra0.w) * wg[6] + bfhi(ra0.w) * wg[7]
                 + bflo(ra1.x) * wg[8] + bfhi(ra1.x) * wg[9] + bflo(ra1.y) * wg[10] + bfhi(ra1.y) * wg[11] + bflo(ra1.z) * wg[12] + bfhi(ra1.z) * wg[13] + bflo(ra1.w) * wg[14] + bfhi(ra1.w) * wg[15];
        const float a = expf(logsig_ref(gk) * (1.f / 16.f));
        S = a * S + bf2f(F.PROJ[pj(row, C_KA + hd * 512 + d)]) * vcol[t];
        const bool chk = smp || t < 2 || t == 31 || t == 63 || t == 64 || t == 65 || t == 127 || t == 128 || t == 1000 || t == 4095 || t == 8191;
        if (chk) { red[tid] = bf2f(F.PROJ[pj(row, C_QA + hd * 512 + d)]) * GLA_QSCALE * S; __syncthreads();
            if (tid == 0) { float o = 0.f; for (int x = 0; x < 512; ++x) o += red[x]; const float got = bf2f(F.PROJ[pj(row, C_VA + hd * 1024 + e)]); dbg_report(F, 8, relerr(got, o, 5.0f)); atomicAdd(F.DBG + 32, (got - o) * (got - o)); atomicAdd(F.DBG + 33, o * o); }
            __syncthreads(); }
    }
    { const float got = F.out[(smp ? OUT_SGS : OUT_SGP) + ((size_t)(b * 4 + hd) * 512 + d) * 1024 + e]; dbg_report(F, 8, relerr(got, S, 5.0f));
      const float se = wave_sum((got - S) * (got - S)), sr = wave_sum(S * S); if (F.lane == 0) { atomicAdd(F.DBG + 34, se); atomicAdd(F.DBG + 35, sr); } }
}

constexpr int DBG_NCHECK = 11;
__device__ __forceinline__ void dbg_final(Frame& F) {
    if (F.bid != 0 || F.tid != 0) return;
    const float tol[DBG_NCHECK] = {2e-3f, 1e-3f, 1e-3f, 1e-2f, 3e-2f, 3e-2f, 2e-2f, 3e-2f, 3e-2f, 1e-2f, 1e-2f};
    for (int k = 0; k < DBG_NCHECK; ++k) { float e = __uint_as_float(__hip_atomic_load((unsigned*)F.DBG + k, RLX_AGENT));
        if (k == 9) e = sqrtf(F.DBG[32] / F.DBG[33]); if (k == 10) e = sqrtf(F.DBG[34] / F.DBG[35]);
        if (!(e <= tol[k])) { const int m = e >= 1.f ? 9 : e >= 0.3f ? 8 : e >= 0.1f ? 7 : e >= 0.03f ? 6 : e >= 0.01f ? 5 : e >= 0.003f ? 4 : e >= 0.001f ? 3 : e >= 3e-4f ? 2 : 1;
            float x = (1.f + 0.1f * m) * 1e4f; for (int j = 0; j < k; ++j) x *= 10.f; F.out[0] = x; return; } }
}
#endif

#define PHASE_BEGIN() do { int t_ = threadIdx.x; asm volatile("" : "+v"(t_)); F.tid = t_; F.lane = t_ & 63; F.wave = __builtin_amdgcn_readfirstlane(t_ >> 6); } while (0)
__global__ void __launch_bounds__(NTHR, 2) mega_fwd(Args args) {
    extern __shared__ __attribute__((aligned(16))) unsigned char lds[];
    Frame F;
    F.lds = (LAS unsigned char*)lds;
    F.MISC = (volatile LAS unsigned*)(F.lds + MISC_OFF);
    F.tid = threadIdx.x; F.lane = F.tid & 63; F.wave = __builtin_amdgcn_readfirstlane(F.tid >> 6);
    F.G = gridDim.x; F.bid = blockIdx.x;
    unsigned char* ws = args.ws; F.ws = ws; F.out = args.out;
#pragma unroll
    for (int i = 0; i < 20; ++i) F.in[i] = args.in[i];
    F.ctl = (gu32*)(ws + WS_CTL);
    F.MOD = (float*)(ws + WS_MOD); F.ROPEC = (float*)(ws + WS_ROPE); F.ROPES = (float*)(ws + WS_ROPE + MiB); F.SC = (float*)(ws + WS_SC); F.DBG = (float*)(ws + WS_DBG);
    F.WIN = (bf16*)(ws + WS_WIN); F.WOUT = (bf16*)(ws + WS_WOUT); F.WGU = (bf16*)(ws + WS_WGU); F.WDN = (bf16*)(ws + WS_WDN); F.H = (bf16*)(ws + WS_H); F.PROJ = (bf16*)(ws + WS_PROJ);
    for (int u = F.tid; u < 64; u += NTHR) ((LAS unsigned*)(F.lds + MISC_OFF))[u] = 0u;
    __syncthreads();
    XcdBarrier bar = xcd_barrier_post((unsigned*)(F.ctl + CW_BAR), F.MISC + 8);
    const int gtid = F.bid * NTHR + F.tid;

#if DBG_CHECK
    if (gtid < 64) F.DBG[gtid] = 0.f;
    xcd_barrier(bar);
#endif
    PHASE_BEGIN();
    p0_phase(F, CW_Q0);
#if PROBE_TWICE == 100
    xcd_barrier(bar); p0_phase(F, CW_Q0 + 64);
#endif
    xcd_barrier(bar);
    PHASE_BEGIN();
    norm_mod_rows<false>(F, F.in[I_XP], F.in[I_XS], nullptr, F.in[I_G1], 0, D, F.H);
#if PROBE_TWICE == 101
    xcd_barrier(bar); norm_mod_rows<false>(F, F.in[I_XP], F.in[I_XS], nullptr, F.in[I_G1], 0, D, F.H);
#endif
    xcd_barrier(bar);
#if DBG_CHECK
    dbg_check_p0p1(F);
#endif
    PHASE_BEGIN();
    { pg8::Gemm g{F.H, F.WIN, MPAD, NP_IN, D}; pg8::StaticOrder S; S.init(MPAD, NP_IN, F.G, F.bid);
      EpiIn E{F.PROJ, F.ROPEC, F.ROPES, F.out};
#if PROBE_TWICE == 110
      S.force0 = 1; pg8::gemm_phase<EpiIn, true, true>(F.lds, g, S, E); S.force0 = 0; xcd_barrier(bar);
#endif
      pg8::gemm_phase<EpiIn, true, true>(F.lds, g, S, E);
      drain_weights<0>(F);
#if PROBE_TWICE == 102
      xcd_barrier(bar); pg8::gemm_phase<EpiIn, true, true>(F.lds, g, S, E);
#endif
    }
    xcd_barrier(bar);
#if DBG_CHECK
    dbg_check_p2(F);
    xcd_barrier(bar);
#endif
    PHASE_BEGIN();
    p3_phase(F);
    xcd_barrier(bar);
#if DBG_CHECK
    dbg_check_cl(F);
    dbg_check_swa(F);
    xcd_barrier(bar);
#endif
    PHASE_BEGIN();
    p4_phase(F);
    xcd_barrier(bar);
#if DBG_CHECK
    dbg_check_scan(F);
    xcd_barrier(bar);
#endif
    PHASE_BEGIN();
    p5_merge(F);
#if PROBE_TWICE == 105
    xcd_barrier(bar); p5_merge(F);
#endif
    xcd_barrier(bar);
    PHASE_BEGIN();
    bf16* const X1B = (bf16*)(F.ws + WS_FRAG);
    { pg8::Gemm g{F.H, F.WOUT, MP, D, D}; pg8::StaticOrder S; S.init(MP, D, F.G, F.bid);
      EpiRes<0> E{F.in[I_XP], nullptr, nullptr, X1B, F.MOD, 2 * D};
      pg8::gemm_phase<EpiRes<0>, true, true>(F.lds, g, S, E); }
    { pg8::Gemm g{F.H, F.WOUT, MPAD, D, D}; pg8::SplitOrder S{F.G, F.bid, MP / 256, D / 128};
      EpiPart E{(float*)F.PROJ};
      pg8::gemm_phase<EpiPart, true, true, pg8::SplitOrder, true>(F.lds, g, S, E); }
    xcd_barrier(bar);
    PHASE_BEGIN();
    skinny_reduce<0>(F, (const float*)F.PROJ, F.in[I_XS], X1B, 2 * D);
    xcd_barrier(bar);
    PHASE_BEGIN();
    norm_mod_rows<true>(F, nullptr, nullptr, X1B, F.in[I_G2], 3 * D, 4 * D, F.H);
#if PROBE_TWICE == 101
    xcd_barrier(bar); norm_mod_rows<true>(F, nullptr, nullptr, X1B, F.in[I_G2], 3 * D, 4 * D, F.H);
#endif
    xcd_barrier(bar);
    PHASE_BEGIN();
    { pg8::Gemm g{F.H, F.WGU, MPAD, N_GU, D}; pg8::StaticOrder S; S.init(MPAD, N_GU, F.G, F.bid);
      EpiGU E{F.PROJ};
      pg8::gemm_phase<EpiGU, true, true>(F.lds, g, S, E);
      drain_weights<1>(F); }
    xcd_barrier(bar);
    PHASE_BEGIN();
    { pg8::Gemm g{F.PROJ, F.WDN, MP, D, DFF}; pg8::StaticOrder S; S.init(MP, D, F.G, F.bid); S.fatk = 1;
      EpiRes<1> E{nullptr, X1B, nullptr, X1B, F.MOD, 5 * D};
      pg8::gemm_phase<EpiRes<1>, true, true>(F.lds, g, S, E); }
    { pg8::Gemm g{F.PROJ, F.WDN, MPAD, D, DFF}; pg8::SplitOrder S{F.G, F.bid, MP / 256, DFF / 128};
      EpiPart E{(float*)F.H};
      pg8::gemm_phase<EpiPart, true, true, pg8::SplitOrder, true>(F.lds, g, S, E); }
    xcd_barrier(bar);
    PHASE_BEGIN();
    skinny_reduce<1>(F, (const float*)F.H, nullptr, X1B, 5 * D);
    xcd_barrier(bar);
    PHASE_BEGIN();
    p10_final(F, X1B);
#if DBG_CHECK
    xcd_barrier(bar);
    dbg_final(F);
#endif
}

extern "C" void kernel_launch(void* const* d_in, const int* in_sizes, int n_in, void* d_out, int out_size, void* d_ws, size_t ws_size, hipStream_t stream) {
    static int grid = 0;
    if (grid == 0) {
        int dev = 0, cus = 0, per_cu = 0;
        if (n_in != 20 || out_size != (int)OUT_TOTAL || ws_size < WS_END + 32 * MiB) { fprintf(stderr, "kernel_launch: unexpected sizes n_in %d out %d ws %zu (need %zu); nothing launched\n", n_in, out_size, ws_size, (size_t)WS_END); grid = -1; return; }
        if (hipGetDevice(&dev) != hipSuccess || hipDeviceGetAttribute(&cus, hipDeviceAttributeMultiprocessorCount, dev) != hipSuccess) { fprintf(stderr, "kernel_launch: device query failed\n"); grid = -1; return; }
        if (hipFuncSetAttribute((const void*)mega_fwd, hipFuncAttributeMaxDynamicSharedMemorySize, LDS_BYTES) != hipSuccess) { fprintf(stderr, "kernel_launch: hipFuncSetAttribute failed\n"); grid = -1; return; }
        if (hipOccupancyMaxActiveBlocksPerMultiprocessor(&per_cu, (const void*)mega_fwd, NTHR, LDS_BYTES) != hipSuccess || per_cu < 1)
            fprintf(stderr, "kernel_launch: occupancy query reports %d blocks per CU\n", per_cu);
        (void)hipGetLastError();
        grid = cus;
    }
    if (grid < 0) return;
    if (hipMemsetAsync((char*)d_ws + WS_CTL, 0, CTL_ZERO_BYTES, stream) != hipSuccess) { fprintf(stderr, "kernel_launch: memset failed\n"); return; }
    Args a{};
    for (int i = 0; i < 20; ++i) a.in[i] = (const float*)d_in[i];
    a.out = (float*)d_out; a.ws = (unsigned char*)d_ws;
    hipLaunchKernelGGL(mega_fwd, dim3(grid), dim3(NTHR), LDS_BYTES, stream, a);
}
```
